# Optimizing an MI355X kernel written in HIP

```python
import math
import jax
import jax.numpy as jnp
from jax import lax
import numpy as np

D_MODEL = 1024
BATCH = 8
SEQ = 2048
DEPTH = 4

GRID_W = 64
CTX_LEN = 256
BLK = 128
WINDOW = 128
ROPE_BASE = 10000.0
EPS = 1e-6

HD_A = 64
N_HA = 6
N_KVA = 2
G_A = N_HA // N_KVA
D_INNER = 384
HD_S = 64
N_HS = D_INNER // HD_S
N_GROUPS = 2
D_STATE = 128
CONV_K = 5
CONV_DIM = D_INNER + 2 * N_GROUPS * D_STATE
CHUNK = 128
N_HC = 4
HD_C = 32
D_C = N_HC * 2 * HD_C

D_MIX = N_HA * HD_A + D_INNER + D_C
IN_SPLITS = (N_HA * HD_A, N_KVA * HD_A, N_KVA * HD_A, D_INNER, CONV_DIM, N_HS, N_HS, D_C, D_C, D_C)
D_IN = sum(IN_SPLITS)
IN_OFFSETS = tuple(int(o) for o in np.cumsum(IN_SPLITS)[:-1])

D_FF = 2816
N_EXP = 8
TOP_K = 2
N_DENSE = (DEPTH + 1) // 2
N_MOE = DEPTH // 2
ALPHA = (2 * DEPTH) ** 0.25
BETA = (8 * DEPTH) ** -0.25

kernel_name = "hymba_style_hybrid_dit_block"


def _layernorm(x):
    xf = x.astype(jnp.float32)
    mu = jnp.mean(xf, -1, keepdims=True)
    var = jnp.mean(jnp.square(xf - mu), -1, keepdims=True)
    return ((xf - mu) * lax.rsqrt(var + EPS)).astype(x.dtype)


def _rmsnorm(x, w):
    xf = x.astype(jnp.float32)
    return (xf * lax.rsqrt(jnp.mean(xf * xf, -1, keepdims=True) + EPS)).astype(x.dtype) * w


def _modulate(x, shift, scale):
    return _layernorm(x) * (1 + scale) + shift


def _post_ln(x, g, b):
    return _layernorm(x) * g + b


def _axial_rope(rows, cols, dim, dtype):
    quarter = dim // 4
    inv = ROPE_BASE ** (-jnp.arange(quarter, dtype=jnp.float32) / quarter)
    ang = jnp.concatenate([rows[:, None] * inv, cols[:, None] * inv], axis=-1)
    return jnp.cos(ang).astype(dtype), jnp.sin(ang).astype(dtype)


def _rope(x, cos, sin):
    x1, x2 = jnp.split(x, 2, axis=-1)
    c, s = cos[:, None, :], sin[:, None, :]
    return jnp.concatenate([x1 * c - x2 * s, x1 * s + x2 * c], axis=-1)


def _window_gqa(q, k, v, qc, kc, vc, sink, cos, sin, with_ctx_out):
    B, S, _ = q.shape
    nb = S // BLK
    scale = HD_A ** -0.5
    q = _rope(q.reshape(B, S, N_HA, HD_A), cos, sin)
    k = _rope(k.reshape(B, S, N_KVA, HD_A), cos, sin)
    v = v.reshape(B, S, N_KVA, HD_A)
    kc = kc.reshape(B, -1, N_KVA, HD_A)
    vc = vc.reshape(B, -1, N_KVA, HD_A)
    n_ctx = kc.shape[1]
    sink_f = sink.astype(jnp.float32).reshape(N_KVA, G_A)
    qb = q.reshape(B, nb, BLK, N_KVA, G_A, HD_A)
    pad = ((0, 0), (BLK, BLK), (0, 0), (0, 0))
    kp, vp = jnp.pad(k, pad), jnp.pad(v, pad)
    kw = jnp.concatenate([kp[:, j * BLK:j * BLK + S].reshape(B, nb, BLK, N_KVA, HD_A) for j in range(3)], axis=2)
    vw = jnp.concatenate([vp[:, j * BLK:j * BLK + S].reshape(B, nb, BLK, N_KVA, HD_A) for j in range(3)], axis=2)
    s_loc = jnp.einsum('bnqhgd,bnkhd->bnhgqk', qb, kw).astype(jnp.float32) * scale
    s_ctx = jnp.einsum('bnqhgd,bkhd->bnhgqk', qb, kc).astype(jnp.float32) * scale
    qpos = jnp.arange(S).reshape(nb, BLK)[:, :, None]
    kpos = (jnp.arange(nb)[:, None] * BLK - BLK + jnp.arange(3 * BLK)[None, :])[:, None, :]
    valid = (jnp.abs(qpos - kpos) <= WINDOW) & (kpos >= 0) & (kpos < S)
    s_loc = jnp.where(valid[None, :, None, None], s_loc, -jnp.inf)
    s_sink = jnp.broadcast_to(sink_f[None, None, :, :, None, None], s_loc.shape[:-1] + (1,))
    p = jax.nn.softmax(jnp.concatenate([s_loc, s_ctx, s_sink], axis=-1), axis=-1).astype(v.dtype)
    y = (jnp.einsum('bnhgqk,bnkhd->bnqhgd', p[..., :3 * BLK], vw)
         + jnp.einsum('bnhgqk,bkhd->bnqhgd', p[..., 3 * BLK:3 * BLK + n_ctx], vc)).reshape(B, S, N_HA * HD_A)
    yc = None
    if with_ctx_out:
        qc = qc.reshape(B, n_ctx, N_KVA, G_A, HD_A)
        sc = jnp.einsum('bqhgd,bkhd->bhgqk', qc, kc).astype(jnp.float32) * scale
        sc_sink = jnp.broadcast_to(sink_f[None, :, :, None, None], sc.shape[:-1] + (1,))
        pc = jax.nn.softmax(jnp.concatenate([sc, sc_sink], axis=-1), axis=-1)[..., :n_ctx].astype(vc.dtype)
        yc = jnp.einsum('bhgqk,bkhd->bqhgd', pc, vc).reshape(B, n_ctx, N_HA * HD_A)
    return y, yc


def _segsum(a):
    T = a.shape[-1]
    cs = jnp.cumsum(a, axis=-1)
    diff = cs[..., :, None] - cs[..., None, :]
    return jnp.where(jnp.tril(jnp.ones((T, T), dtype=bool)), diff, -jnp.inf)


def _ssd_chunked(x, a, b, c, h0):
    Bsz, L, H, P = x.shape
    nc = L // CHUNK
    x = x.reshape(Bsz, nc, CHUNK, H, P)
    b = b.reshape(Bsz, nc, CHUNK, H, -1)
    c = c.reshape(Bsz, nc, CHUNK, H, -1)
    a = jnp.transpose(a.reshape(Bsz, nc, CHUNK, H), (0, 3, 1, 2))
    a_cum = jnp.cumsum(a, axis=-1)
    scores = jnp.einsum('bclhn,bcshn->bhcls', c, b) * jnp.exp(_segsum(a))
    y_diag = jnp.einsum('bhcls,bcshp->bclhp', scores, x)
    decay_states = jnp.exp(a_cum[..., -1:] - a_cum)
    states = jnp.einsum('bclhn,bhcl,bclhp->bchpn', b, decay_states, x)
    states = jnp.concatenate([h0[:, None], states], axis=1)
    chunk_tot = jnp.pad(a_cum[..., -1], ((0, 0), (0, 0), (1, 0)))
    decay_chunk = jnp.exp(_segsum(chunk_tot))
    new_states = jnp.einsum('bhzc,bchpn->bzhpn', decay_chunk, states)
    y_off = jnp.einsum('bclhn,bchpn,bhcl->bclhp', c, new_states[:, :-1], jnp.exp(a_cum))
    return (y_diag + y_off).reshape(Bsz, L, H, P), new_states[:, -1]


def _ssd_final_state(x, a, b):
    a_cum = jnp.cumsum(a, axis=1)
    w = jnp.exp(a_cum[:, -1:] - a_cum)
    return jnp.einsum('blhn,blh,blhp->bhpn', b, w, x)


def _dwconv(u, w, bias):
    out = lax.conv_general_dilated(u, w[:, None, :], (1,), ((CONV_K // 2, CONV_K // 2),),
                                   dimension_numbers=('NWC', 'WIO', 'NWC'), feature_group_count=CONV_DIM)
    return out + bias


def _ssd_inputs(xbc, conv_w, conv_b):
    B, L, _ = xbc.shape
    u = jax.nn.silu(_dwconv(xbc, conv_w, conv_b)).astype(jnp.float32)
    xs, bm, cm = jnp.split(u, [D_INNER, D_INNER + N_GROUPS * D_STATE], axis=-1)
    rep = N_HS // N_GROUPS
    bm = jnp.repeat(bm.reshape(B, L, N_GROUPS, D_STATE), rep, axis=2)
    cm = jnp.repeat(cm.reshape(B, L, N_GROUPS, D_STATE), rep, axis=2)
    return xs.reshape(B, L, N_HS, HD_S), bm, cm


def _ssd_direction(lat, ctx_in, dt_raw, dt_raw_c, dt_bias, a_log, reverse, with_ctx_out):
    xs, bm, cm = lat
    xs_c, bm_c, cm_c = ctx_in
    A = -jnp.exp(a_log.astype(jnp.float32))

    def prep(u, d):
        dt = jax.nn.softplus(d.astype(jnp.float32) + dt_bias.astype(jnp.float32))
        return u * dt[..., None], dt * A

    flip = (lambda t: jnp.flip(t, axis=1)) if reverse else (lambda t: t)
    xc_in, ac = prep(xs_c, dt_raw_c)
    xc_in, ac, bc, cc = flip(xc_in), flip(ac), flip(bm_c), flip(cm_c)
    yc = None
    if with_ctx_out:
        h0 = jnp.zeros((xs_c.shape[0], N_HS, HD_S, D_STATE), jnp.float32)
        yc, h_ctx = _ssd_chunked(xc_in, ac, bc, cc, h0)
        yc = flip(yc)
    else:
        h_ctx = _ssd_final_state(xc_in, ac, bc)
    x_in, a = prep(xs, dt_raw)
    y, _ = _ssd_chunked(flip(x_in), flip(a), flip(bm), flip(cm), h_ctx)
    return flip(y), yc


def _ssd_mixer(z, xbc, dtf, dtb, zc, xbcc, dtfc, dtbc, conv_w, conv_b, dt_bias, a_log, d_skip, norm_w,
               with_ctx_out):
    lat = _ssd_inputs(xbc, conv_w, conv_b)
    ctx_in = _ssd_inputs(xbcc, conv_w, conv_b)
    yf, yfc = _ssd_direction(lat, ctx_in, dtf, dtfc, dt_bias[0], a_log[0], False, with_ctx_out)
    yb, ybc = _ssd_direction(lat, ctx_in, dtb, dtbc, dt_bias[1], a_log[1], True, with_ctx_out)
    d = d_skip.astype(jnp.float32)[:, None]

    def finish(y_sum, xs, zz):
        y = (y_sum + d * xs).reshape(zz.shape).astype(zz.dtype)
        return _rmsnorm(y * jax.nn.silu(zz), norm_w)

    y = finish(yf + yb, lat[0], z)
    yc = finish(yfc + ybc, ctx_in[0], zc) if with_ctx_out else None
    return y, yc


def _diff_core(q, k, v, lam):
    s = jnp.einsum('bqhid,bkhid->bhiqk', q, k).astype(jnp.float32) * HD_C ** -0.5
    p = jax.nn.softmax(s, axis=-1)
    a = (p[:, :, 0] - lam * p[:, :, 1]).astype(v.dtype)
    return jnp.einsum('bhqk,bkhe->bqhe', a, v)


def _diff_attn(q, k, v, qc, kc, vc, lam_q, lam_k, lam_init, norm_w, cos, sin, with_ctx_out):
    B, S, _ = q.shape
    nb = S // BLK
    lq = lam_q.astype(jnp.float32)
    lk = lam_k.astype(jnp.float32)
    lam = jnp.exp(jnp.sum(lq[0] * lk[0])) - jnp.exp(jnp.sum(lq[1] * lk[1])) + lam_init
    q = _rope(q.reshape(B, S, N_HC * 2, HD_C), cos, sin).reshape(B, S, N_HC, 2, HD_C)
    k = _rope(k.reshape(B, S, N_HC * 2, HD_C), cos, sin).reshape(B, S, N_HC, 2, HD_C)
    v = v.reshape(B, S, N_HC, 2 * HD_C)
    n_ctx = kc.shape[1]
    kc = kc.reshape(B, n_ctx, N_HC, 2, HD_C)
    vc = vc.reshape(B, n_ctx, N_HC, 2 * HD_C)
    k_all = jnp.concatenate([k, kc], axis=1)
    v_all = jnp.concatenate([v, vc], axis=1)
    qb = jnp.moveaxis(q.reshape(B, nb, BLK, N_HC, 2, HD_C), 1, 0)
    o = lax.map(lambda qblk: _diff_core(qblk, k_all, v_all, lam), qb)
    o = jnp.moveaxis(o, 0, 1).reshape(B, S, N_HC, 2 * HD_C)
    y = (_rmsnorm(o, norm_w) * (1 - lam_init)).reshape(B, S, D_C)
    yc = None
    if with_ctx_out:
        oc = _diff_core(qc.reshape(B, n_ctx, N_HC, 2, HD_C), kc, vc, lam)
        yc = (_rmsnorm(oc, norm_w) * (1 - lam_init)).reshape(B, n_ctx, D_C)
    return y, yc


def _swiglu(h, w_gu, w_down):
    g, u = jnp.split(h @ w_gu, 2, axis=-1)
    return (jax.nn.silu(g) * u) @ w_down


def _moe(h, w_r, b_r, we_gu, we_down):
    logits = (h @ w_r + b_r).astype(jnp.float32)
    top_v, top_i = lax.top_k(logits, TOP_K)
    top_w = jax.nn.softmax(top_v, axis=-1)
    gates = jnp.sum(jax.nn.one_hot(top_i, N_EXP, dtype=jnp.float32) * top_w[..., None], axis=-2).astype(h.dtype)
    y = jnp.zeros_like(h)
    for e in range(N_EXP):
        y = y + gates[..., e:e + 1] * _swiglu(h, we_gu[e], we_down[e])
    return y


def setup_inputs(seed: int = 0) -> dict:
    key = jax.random.key(seed)
    ks = jax.random.split(key, 28)
    f32 = jnp.float32

    def nrm(i, shape, scale):
        return jax.random.normal(ks[i], shape, f32) * scale

    dt0 = jnp.exp(jax.random.uniform(ks[10], (DEPTH, 2, N_HS), f32, math.log(1e-3), math.log(1e-1)))
    return {
        "x": nrm(0, (BATCH, SEQ, D_MODEL), 1.0),
        "c": nrm(1, (BATCH, D_MODEL), 1.0),
        "ctx": nrm(2, (BATCH, CTX_LEN, D_MODEL), 1.0),
        "c_ctx": nrm(3, (D_MODEL,), 1.0),
        "w_ada": nrm(4, (DEPTH, D_MODEL, 6 * D_MODEL), D_MODEL ** -0.5),
        "b_ada": nrm(5, (DEPTH, 6 * D_MODEL), 0.02),
        "w_in": nrm(6, (DEPTH, D_MODEL, D_IN), D_MODEL ** -0.5),
        "attn_sink": nrm(7, (DEPTH, N_HA), 0.5),
        "conv_w": nrm(8, (DEPTH, CONV_K, CONV_DIM), CONV_K ** -0.5),
        "conv_b": nrm(9, (DEPTH, CONV_DIM), 0.02),
        "dt_bias": dt0 + jnp.log(-jnp.expm1(-dt0)),
        "a_log": jnp.log(jax.random.uniform(ks[11], (DEPTH, 2, N_HS), f32, 1.0, 16.0)),
        "d_skip": 1.0 + nrm(12, (DEPTH, N_HS), 0.1),
        "ssm_norm_w": 1.0 + nrm(13, (DEPTH, D_INNER), 0.02),
        "lam_q": nrm(14, (DEPTH, 2, HD_C), 0.1),
        "lam_k": nrm(15, (DEPTH, 2, HD_C), 0.1),
        "diff_norm_w": 1.0 + nrm(16, (DEPTH, 2 * HD_C), 0.02),
        "w_out": nrm(17, (DEPTH, D_MIX, D_MODEL), D_MIX ** -0.5 * BETA),
        "ln1_g": 1.0 + nrm(18, (DEPTH, D_MODEL), 0.02),
        "ln1_b": nrm(19, (DEPTH, D_MODEL), 0.02),
        "ln2_g": 1.0 + nrm(20, (DEPTH, D_MODEL), 0.02),
        "ln2_b": nrm(21, (DEPTH, D_MODEL), 0.02),
        "ffn_w_gu": nrm(22, (N_DENSE, D_MODEL, 2 * D_FF), D_MODEL ** -0.5),
        "ffn_w_down": nrm(23, (N_DENSE, D_FF, D_MODEL), D_FF ** -0.5 * BETA),
        "router_w": nrm(24, (N_MOE, D_MODEL, N_EXP), D_MODEL ** -0.5),
        "router_b": nrm(25, (N_MOE, N_EXP), 0.01),
        "exp_w_gu": nrm(26, (N_MOE, N_EXP, D_MODEL, 2 * D_FF), D_MODEL ** -0.5),
        "exp_w_down": nrm(27, (N_MOE, N_EXP, D_FF, D_MODEL), D_FF ** -0.5 * BETA),
    }


def reference(x, c, ctx, c_ctx, w_ada, b_ada, w_in, attn_sink, conv_w, conv_b, dt_bias, a_log, d_skip,
              ssm_norm_w, lam_q, lam_k, diff_norm_w, w_out, ln1_g, ln1_b, ln2_g, ln2_b, ffn_w_gu, ffn_w_down,
              router_w, router_b, exp_w_gu, exp_w_down):
    B, S, _ = x.shape
    rows_n = S // GRID_W
    t_row = jnp.repeat(jnp.arange(rows_n, dtype=jnp.float32), GRID_W)
    t_col = jnp.tile(jnp.arange(GRID_W, dtype=jnp.float32), rows_n)
    cos_a, sin_a = _axial_rope(t_row, t_col, HD_A, x.dtype)
    cos_c, sin_c = _axial_rope(t_row, t_col, HD_C, x.dtype)
    c_act = jax.nn.silu(c)
    cc_act = jax.nn.silu(c_ctx)

    for li in range(DEPTH):
        ctx_out = li < DEPTH - 1
        lam_init = 0.8 - 0.6 * math.exp(-0.3 * li)
        if li % 2 == 0:
            ffn = lambda h, j=li // 2: _swiglu(h, ffn_w_gu[j], ffn_w_down[j])
        else:
            ffn = lambda h, j=li // 2: _moe(h, router_w[j], router_b[j], exp_w_gu[j], exp_w_down[j])

        sh1, sc1, g1, sh2, sc2, g2 = jnp.split((c_act @ w_ada[li] + b_ada[li])[:, None, :], 6, axis=-1)
        sh1c, sc1c, g1c, sh2c, sc2c, g2c = jnp.split(cc_act @ w_ada[li] + b_ada[li], 6, axis=-1)

        p = jnp.split(_modulate(x, sh1, sc1) @ w_in[li], IN_OFFSETS, axis=-1)
        pc = jnp.split(_modulate(ctx, sh1c, sc1c) @ w_in[li], IN_OFFSETS, axis=-1)
        ya, yac = _window_gqa(p[0], p[1], p[2], pc[0], pc[1], pc[2], attn_sink[li], cos_a, sin_a, ctx_out)
        yb, ybc = _ssd_mixer(p[3], p[4], p[5], p[6], pc[3], pc[4], pc[5], pc[6], conv_w[li], conv_b[li],
                             dt_bias[li], a_log[li], d_skip[li], ssm_norm_w[li], ctx_out)
        yd, ydc = _diff_attn(p[7], p[8], p[9], pc[7], pc[8], pc[9], lam_q[li], lam_k[li], lam_init,
                             diff_norm_w[li], cos_c, sin_c, ctx_out)
        mix = jnp.concatenate([ya, yb, yd], axis=-1) @ w_out[li]
        x = _post_ln(ALPHA * x + g1 * mix, ln1_g[li], ln1_b[li])
        x = _post_ln(ALPHA * x + g2 * ffn(_modulate(x, sh2, sc2)), ln2_g[li], ln2_b[li])

        if ctx_out:
            mix_c = jnp.concatenate([yac, ybc, ydc], axis=-1) @ w_out[li]
            ctx = _post_ln(ALPHA * ctx + g1c * mix_c, ln1_g[li], ln1_b[li])
            ctx = _post_ln(ALPHA * ctx + g2c * ffn(_modulate(ctx, sh2c, sc2c)), ln2_g[li], ln2_b[li])
    return x
```

```cpp
#include <hip/hip_runtime.h>
#include <cstdio>
#include <cstdint>
#include <cstddef>

#define LAS __attribute__((address_space(3)))
typedef unsigned short bf16_t;
typedef short bf16x8 __attribute__((ext_vector_type(8)));
typedef float f32x4 __attribute__((ext_vector_type(4)));
typedef float f32x2 __attribute__((ext_vector_type(2)));
typedef unsigned u32x4 __attribute__((ext_vector_type(4)));
typedef unsigned u32x2 __attribute__((ext_vector_type(2)));

constexpr int NB = 8, SEQ = 2048, NCTX = 256, TB = NCTX + SEQ  , T = NB * TB  , D = 1024, DEPTH = 4;
constexpr int NCH = TB / 128  ;
constexpr int D_IN = 2700, LDP = 2816, DFF = 2816, NEXP = 8, D_INNER = 384, CONV_DIM = 896;
constexpr int PC_QA = 0, PC_KA = 384, PC_VA = 512, PC_Z = 640, PC_XBC = 1024, PC_QC = 1920, PC_KC = 2176, PC_VC = 2432, PC_DT = 2688;
constexpr float LN_EPS = 1e-6f;
constexpr float ALPHA_RES = 1.6817928305074290f;
constexpr float LOG2E = 1.4426950408889634f;
constexpr int MOE_CAP = T;
constexpr int MAX_SLOT_ROWS = 2 * T + NEXP * 256;

constexpr size_t al256(size_t x) { return (x + 255) & ~(size_t)255; }
constexpr size_t WS_CTL = 0;
constexpr size_t CTL_BYTES = 65536;
constexpr size_t CTL_CNT_OFF = 16384;
constexpr size_t WS_MOD = WS_CTL + CTL_BYTES;
constexpr size_t WS_ROPE = WS_MOD + al256((size_t)DEPTH * 9 * 6144 * 4);
constexpr size_t WS_WIN = WS_ROPE + (size_t)2048 * 96 * 4;
constexpr size_t WS_WOUT = WS_WIN + (size_t)DEPTH * LDP * D * 2;
constexpr size_t WS_WGU = WS_WOUT + (size_t)DEPTH * D * D * 2;
constexpr size_t WS_WD = WS_WGU + (size_t)2 * 2 * DFF * D * 2;
constexpr size_t WS_WGUE = WS_WD + (size_t)2 * D * DFF * 2;
constexpr size_t WS_WDE = WS_WGUE + (size_t)16 * 2 * DFF * D * 2;
constexpr size_t WS_X = WS_WDE + (size_t)16 * D * DFF * 2;
constexpr size_t WS_H = WS_X + (size_t)T * D * 4;
constexpr size_t WS_P = WS_H + (size_t)T * D * 2;
constexpr size_t WS_DT = WS_P + (size_t)T * LDP * 2;
constexpr size_t WS_U = WS_DT + (size_t)T * 16 * 4;
constexpr size_t WS_DTV = WS_U + (size_t)T * CONV_DIM * 2;
constexpr size_t WS_ACUM = WS_DTV + (size_t)T * 12 * 4;
constexpr size_t WS_CHS = WS_ACUM + (size_t)T * 12 * 4;
constexpr size_t WS_CHT = WS_CHS + (size_t)NB * NCH * 12 * 8192 * 4;
constexpr size_t WS_YG = WS_CHT + 8192;
constexpr size_t WS_MIX = WS_YG + (size_t)T * D_INNER * 4;
constexpr size_t WS_O = WS_MIX + (size_t)T * D * 2;
constexpr size_t WS_ACT = WS_O + (size_t)T * D * 4;
constexpr size_t WS_HP = WS_ACT + (size_t)MAX_SLOT_ROWS * DFF * 2;
constexpr size_t WS_TOK = WS_HP + (size_t)NEXP * MOE_CAP * D * 2;
constexpr size_t WS_END = WS_TOK + (size_t)T * 32;

constexpr int LDS_BYTES = 147456;

struct Args { const float* in[28]; float* out; unsigned char* ws; int ph_lo, ph_hi, use_bar, pad; };
enum { I_X = 0, I_C, I_CTX, I_CCTX, I_WADA, I_BADA, I_WIN, I_SINK, I_CONVW, I_CONVB, I_DTBIAS, I_ALOG, I_DSKIP, I_SSMNW, I_LAMQ, I_LAMK, I_DIFFNW, I_WOUT,
       I_LN1G, I_LN1B, I_LN2G, I_LN2B, I_FFNGU, I_FFND, I_RW, I_RB, I_EGU, I_ED };

__device__ __forceinline__ float bf2f(bf16_t v) { return __uint_as_float(((unsigned)v) << 16); }
__device__ __forceinline__ bf16_t f2bf(float f) { unsigned u = __float_as_uint(f); u += 0x7FFFu + ((u >> 16) & 1u); return (bf16_t)(u >> 16); }
__device__ __forceinline__ unsigned pk_bf16(float lo, float hi) { unsigned r; asm volatile("v_cvt_pk_bf16_f32 %0, %1, %2" : "=v"(r) : "v"(lo), "v"(hi)); return r; }
__device__ __forceinline__ float fast_exp2(float x) { return __builtin_amdgcn_exp2f(x); }
__device__ __forceinline__ float silu_f(float x) { return x * __builtin_amdgcn_rcpf(1.0f + __expf(-x)); }
__device__ __forceinline__ float wave_sum(float v) {
#pragma unroll
    for (int o = 32; o >= 1; o >>= 1) v += __shfl_xor(v, o);
    return v;
}
#define XB_TMO      128
#define XB_XCNT(j)  (256  + 64 * (j))
#define XB_XSUB(j)  (1280 + 64 * (j))
#define XB_XGEN(j)  (2304 + 64 * (j))
#define XB_TOP      3328
#define XB_TOPGEN   3392
#define XCD_BAR_WORDS 3456
#define XB_SPIN_CAP (1u << 18)
#define LAS __attribute__((address_space(3)))

__device__ __forceinline__ unsigned xb_ld(unsigned* p)              { return __hip_atomic_load(p, __ATOMIC_RELAXED, __HIP_MEMORY_SCOPE_AGENT); }
__device__ __forceinline__ unsigned xb_add(unsigned* p, unsigned v) { return __hip_atomic_fetch_add(p, v, __ATOMIC_RELAXED, __HIP_MEMORY_SCOPE_AGENT); }
__device__ __forceinline__ unsigned xb_xcc_id() { return (unsigned)__builtin_amdgcn_s_getreg((3 << 11) | 20) & 0xFu; }
#define XB_SPIN(cond, bar) do { unsigned _sp = 0; while (cond) { __builtin_amdgcn_s_sleep(1); \
    if ((++_sp & 255u) == 0u) { if (xb_ld(&(bar)[XB_TMO])) break; if (_sp > XB_SPIN_CAP) { atomicAdd(&(bar)[XB_TMO], 1u); break; } } } } while (0)

struct XcdBarrier {
    unsigned* bar; unsigned x;
    volatile LAS unsigned* st;
};

__device__ __forceinline__ XcdBarrier xcd_barrier_post(unsigned* bar, volatile LAS unsigned* st) {
    XcdBarrier b; b.bar = bar; b.x = xb_xcc_id(); b.st = st;
    if (threadIdx.x == 0) (void)xb_add(&bar[XB_XCNT(b.x)], 1u);
    return b;
}
__device__ __forceinline__ void xcd_barrier_complete(unsigned* bar, unsigned x, unsigned& nloc, unsigned& nx) {
    const unsigned G = gridDim.x * gridDim.y * gridDim.z;
    unsigned sum, cnt, mine, sp = 0u;
    for (;;) {
        sum = 0u; cnt = 0u; mine = 0u;
#pragma unroll
        for (unsigned j = 0; j < 16; ++j) { const unsigned c = xb_ld(&bar[XB_XCNT(j)]); sum += c; cnt += (c > 0u) ? 1u : 0u; mine = (j == x) ? c : mine; }
        if (sum == G) break;
        __builtin_amdgcn_s_sleep(1);
        if ((++sp & 255u) == 0u) { if (xb_ld(&bar[XB_TMO])) break; if (sp > XB_SPIN_CAP) { atomicAdd(&bar[XB_TMO], 1u); break; } }
    }
    nloc = mine > 0u ? mine : 1u; nx = cnt > 0u ? cnt : 1u;
}

__device__ __forceinline__ void xcd_barrier(const XcdBarrier& b) {
    asm volatile("s_waitcnt vmcnt(0)" ::: "memory");
    __syncthreads();
    if (threadIdx.x == 0) {
        unsigned* bar = b.bar;
        __builtin_amdgcn_s_waitcnt(0);
        unsigned nloc = b.st[0], nx = b.st[1];
        if (nloc == 0u) { xcd_barrier_complete(bar, b.x, nloc, nx); b.st[0] = nloc; b.st[1] = nx; }
        const unsigned old = xb_add(&bar[XB_XSUB(b.x)], 1u);
        const unsigned gen = old / nloc;
        if (old + 1u == (gen + 1u) * nloc) {
            __builtin_amdgcn_fence(__ATOMIC_RELEASE, "agent");
            asm volatile("s_waitcnt vmcnt(0)" ::: "memory");
            const unsigned og = xb_add(&bar[XB_TOP], 1u);
            const unsigned tg = og / nx;
            if (og + 1u == (tg + 1u) * nx) xb_add(&bar[XB_TOPGEN], 1u);
            else XB_SPIN(xb_ld(&bar[XB_TOPGEN]) == tg, bar);
            __builtin_amdgcn_fence(__ATOMIC_ACQUIRE, "agent");
            xb_add(&bar[XB_XGEN(b.x)], 1u);
            asm volatile("s_waitcnt vmcnt(0)" ::: "memory");
        } else {
            XB_SPIN(xb_ld(&bar[XB_XGEN(b.x)]) == gen, bar);
            __builtin_amdgcn_fence(__ATOMIC_ACQUIRE, "agent");
            asm volatile("s_waitcnt vmcnt(0)" ::: "memory");
        }
    }
    __syncthreads();
}


namespace pg8 {
#define PG8_LAS __attribute__((address_space(3)))
constexpr int BM = 256, BK = 64, HALF = 128, HTB = HALF * BK * 2  , STAGE_BYTES = 8 * HTB, NXCD = 8, WGM = 8;

__host__ __device__ __forceinline__ int lds_byte(int r, int c) { const int st = (r >> 4) * 2 + (c >> 5), rr = r & 15, cc = c & 31, ob = rr * 64 + cc * 2; return st * 1024 + (ob ^ (((ob >> 9) & 1) << 5)); }
__host__ __device__ __forceinline__ void stage_rc(int b, int& R, int& C) { const int st = b / 1024, sb = b % 1024, swz = sb ^ (((sb >> 9) & 1) << 5); R = (st >> 1) * 16 + swz / 64; C = (st & 1) * 32 + (swz % 64) / 2; }
__host__ __device__ __forceinline__ int perm32(int rho) { const int n = rho >> 4, i = rho & 15; return 8 * (i >> 2) + 4 * n + (i & 3); }

struct Unit { int pm, pn, po, pc; };
struct Gemm { const bf16_t* A; const bf16_t* Bt; int M, N, K; };

struct StaticOrder {
    int nM, nN, nwg, G, c;
    __host__ __device__ void init(int M, int N, int G_, int c_) { nM = M / BM; nN = N / BM; nwg = nM * nN; G = G_; c = c_; }
    __host__ __device__ bool next(int i, Unit& u) const {
        const long L = (long)i * G + c; if (L >= nwg) return false;
        int wgid = (int)L; { const int q = nwg / NXCD, r = nwg % NXCD, xcd = wgid % NXCD, off = wgid / NXCD; wgid = (xcd < r ? xcd * (q + 1) : r * (q + 1) + (xcd - r) * q) + off; }
        const int nig = WGM * nN, gid = wgid / nig, fm = gid * WGM, gsz = (nM - fm) < WGM ? (nM - fm) : WGM;
        u.pm = fm + ((wgid % nig) % gsz); u.pn = (wgid % nig) / gsz; u.po = u.pm; u.pc = u.pn; return true;
    }
    __device__ __forceinline__ void a_ready(const Unit&) const {}
    __device__ __forceinline__ void done(const Unit&) const {}
};
template <int MODE> struct GroupedOrder {
    int t1, t2, t3, t4, t5, t6, t7, t8, nN, capTiles, G, c;
    __device__ __forceinline__ bool next(int i, Unit& u) const {
        const int L = i * G + c; if (L >= t8 * nN) return false;
        const int rt = L / nN, pn = L - rt * nN;
        int e = 0, base = 0;
        if (rt >= t1) { e = 1; base = t1; } if (rt >= t2) { e = 2; base = t2; } if (rt >= t3) { e = 3; base = t3; } if (rt >= t4) { e = 4; base = t4; }
        if (rt >= t5) { e = 5; base = t5; } if (rt >= t6) { e = 6; base = t6; } if (rt >= t7) { e = 7; base = t7; }
        u.pm = (MODE == 0) ? e * capTiles + (rt - base) : rt; u.pn = e * nN + pn; u.po = rt; u.pc = pn; return true;
    }
    __device__ __forceinline__ void a_ready(const Unit&) const {}
    __device__ __forceinline__ void done(const Unit&) const {}
};

struct EpiF32 {
    static constexpr bool PERM = false, AFTER_DRAIN = false;
    float* C; int ldc;
    __device__ __forceinline__ void operator()(const f32x4 (&acc)[2][2][4][2], const Unit& u, int wr, int wc, int fr, int fq) const {
        const int row0 = u.po * BM + wr * 64 + fr, col0 = u.pc * BM + wc * 32 + 4 * fq;
#pragma unroll
        for (int ai = 0; ai < 2; ++ai)
#pragma unroll
            for (int m = 0; m < 4; ++m) { float* rowp = C + (size_t)(row0 + ai * HALF + m * 16) * ldc + col0;
#pragma unroll
                for (int bj = 0; bj < 2; ++bj)
#pragma unroll
                    for (int n = 0; n < 2; ++n) *(f32x4*)(rowp + bj * HALF + n * 16) = acc[ai][bj][m][n]; }
    }
};
struct EpiInProj {
    static constexpr bool PERM = true, AFTER_DRAIN = false;
    bf16_t* P; float* DT; const float* cosA; const float* sinA; const float* cosC; const float* sinC;
    __device__ __forceinline__ void operator()(const f32x4 (&acc)[2][2][4][2], const Unit& u, int wr, int wc, int fr, int fq) const {
        const int pt = u.po % 9; const bool latent = pt != 0;
        const int row0 = u.po * BM + wr * 64 + fr, pos0 = (pt - 1) * 256 + wr * 64 + fr;
#pragma unroll
        for (int ai = 0; ai < 2; ++ai)
#pragma unroll
            for (int m = 0; m < 4; ++m) {
                const int row = row0 + ai * HALF + m * 16, pos = pos0 + ai * HALF + m * 16;
#pragma unroll
                for (int bj = 0; bj < 2; ++bj) {
                    const int c0 = u.pc * BM + bj * HALF + wc * 32 + 8 * fq;
                    f32x4 v0 = acc[ai][bj][m][0], v1 = acc[ai][bj][m][1];
                    if (latent) {
                        if (c0 < PC_VA) { const int j = (c0 & 63) >> 3; const f32x4 cs = *(const f32x4*)(cosA + pos * 32 + 4 * j), sn = *(const f32x4*)(sinA + pos * 32 + 4 * j);
                            const f32x4 a = v0 * cs - v1 * sn, b = v0 * sn + v1 * cs; v0 = a; v1 = b; }
                        else if (c0 >= PC_QC && c0 < PC_VC) { const int j = (c0 & 31) >> 3; const f32x4 cs = *(const f32x4*)(cosC + pos * 16 + 4 * j), sn = *(const f32x4*)(sinC + pos * 16 + 4 * j);
                            const f32x4 a = v0 * cs - v1 * sn, b = v0 * sn + v1 * cs; v0 = a; v1 = b; }
                    }
                    u32x4 w; w.x = pk_bf16(v0[0], v0[1]); w.y = pk_bf16(v0[2], v0[3]); w.z = pk_bf16(v1[0], v1[1]); w.w = pk_bf16(v1[2], v1[3]);
                    *(u32x4*)(P + (size_t)row * LDP + c0) = w;
                    if (c0 >= PC_DT && c0 < PC_DT + 16) { float* d = DT + (size_t)row * 16 + (c0 - PC_DT); *(f32x4*)d = v0; *(f32x4*)(d + 4) = v1; }
                }
            }
    }
};
struct EpiSwiGLU {
    static constexpr bool PERM = true, AFTER_DRAIN = false;
    bf16_t* O;
    __device__ __forceinline__ void operator()(const f32x4 (&acc)[2][2][4][2], const Unit& u, int wr, int wc, int fr, int fq) const {
        const int row0 = u.po * BM + wr * 64 + fr, col0 = u.pc * HALF + wc * 32 + 8 * fq;
#pragma unroll
        for (int ai = 0; ai < 2; ++ai)
#pragma unroll
            for (int m = 0; m < 4; ++m) {
                const f32x4 g0 = acc[ai][0][m][0], g1 = acc[ai][0][m][1], u0 = acc[ai][1][m][0], u1 = acc[ai][1][m][1];
                float r[8];
#pragma unroll
                for (int j = 0; j < 4; ++j) { r[j] = silu_f(g0[j]) * u0[j]; r[4 + j] = silu_f(g1[j]) * u1[j]; }
                u32x4 w; w.x = pk_bf16(r[0], r[1]); w.y = pk_bf16(r[2], r[3]); w.z = pk_bf16(r[4], r[5]); w.w = pk_bf16(r[6], r[7]);
                *(u32x4*)(O + (size_t)(row0 + ai * HALF + m * 16) * DFF + col0) = w;
            }
    }
};


template <class Epi, class Sched, bool STAMP = false>
__device__ __forceinline__ void gemm_phase(PG8_LAS unsigned char* lds, const Gemm g, const Sched& S, const Epi& E, unsigned long long* stamps) {
    int tid_ = threadIdx.x; asm volatile("" : "+v"(tid_));
    const int tid = tid_, wid = __builtin_amdgcn_readfirstlane(tid >> 6), lane = tid & 63, wr = wid >> 2, wc = wid & 3, fr = lane & 15, fq = lane >> 4;
    const int K = g.K, nt = K / BK;
    int ts_lo = 0, ts_hi = 0, nts = 0; const unsigned long long rt_entry = STAMP ? (unsigned long long)wall_clock64() : 0ull;
#define PG8_STAMP() do { if (STAMP && wid == 0 && nts < 64) { const unsigned long long _c = (unsigned long long)clock64(); \
        ts_lo = (lane == nts) ? (int)(unsigned)_c : ts_lo; ts_hi = (lane == nts) ? (int)(unsigned)(_c >> 32) : ts_hi; ++nts; } } while (0)
    PG8_STAMP();
    unsigned voffA[2], voffB[2];
#pragma unroll
    for (int i = 0; i < 2; ++i) { int R, C; stage_rc(tid * 16 + i * 8192, R, C); const int Rb = Epi::PERM ? ((R & ~31) + perm32(R & 31)) : R;
        voffA[i] = (unsigned)(R * K + C) * 2u; voffB[i] = (unsigned)(Rb * K + C) * 2u; }
    const size_t kstep = (size_t)(BK * 2);
    const size_t hstep = (size_t)HALF * K * 2;
    const size_t tstep = 2 * hstep;
    const unsigned ldsw = (unsigned)wid * 1024u;
    const int aoff = lds_byte(wr * 64 + fr, fq * 8), boff = lds_byte(wc * 32 + fr, fq * 8);
#define PG8_SA(b, h) (((b) * 2 + (h)) * HTB)
#define PG8_SB(b, h) ((4 + (b) * 2 + (h)) * HTB)
#define PG8_STAGE(bufoff, gbase, voff) do { _Pragma("unroll") for (int _i = 0; _i < 2; ++_i) \
        __builtin_amdgcn_global_load_lds((const unsigned*)((const char*)(gbase) + (voff)[_i]), (PG8_LAS unsigned*)(lds + (bufoff) + ldsw + _i * 8192), 16, 0, 0); } while (0)
#define PG8_LDA(dst, b, h) do { _Pragma("unroll") for (int m = 0; m < 4; ++m) _Pragma("unroll") for (int k = 0; k < 2; ++k) dst[m][k] = *(const PG8_LAS bf16x8*)(lds + PG8_SA(b, h) + aoff + m * 2048 + k * 1024); } while (0)
#define PG8_LDB(dst, b, h) do { _Pragma("unroll") for (int n = 0; n < 2; ++n) _Pragma("unroll") for (int k = 0; k < 2; ++k) dst[n][k] = *(const PG8_LAS bf16x8*)(lds + PG8_SB(b, h) + boff + n * 2048 + k * 1024); } while (0)
#define PG8_MMA(ai, bj, At, Bt) do { __builtin_amdgcn_s_setprio(1); _Pragma("unroll") for (int m = 0; m < 4; ++m) _Pragma("unroll") for (int n = 0; n < 2; ++n) _Pragma("unroll") for (int k = 0; k < 2; ++k) \
        acc[ai][bj][m][n] = __builtin_amdgcn_mfma_f32_16x16x32_bf16(Bt[n][k], At[m][k], acc[ai][bj][m][n], 0, 0, 0); __builtin_amdgcn_s_setprio(0); } while (0)
#define PG8_WAIT_V(n) asm volatile("s_waitcnt vmcnt(" #n ")" ::: "memory")
#define PG8_WAIT_L(n) asm volatile("s_waitcnt lgkmcnt(" #n ")" ::: "memory")
#define PG8_BAR __builtin_amdgcn_s_barrier()
#define PG8_SCHED __builtin_amdgcn_sched_barrier(0)
    Unit cur, nxt; int ui = 0;
    if (!S.next(0, cur)) return;
    f32x4 acc[2][2][4][2];
#pragma unroll
    for (int a = 0; a < 2; ++a)
#pragma unroll
        for (int b = 0; b < 2; ++b)
#pragma unroll
            for (int m = 0; m < 4; ++m)
#pragma unroll
                for (int n = 0; n < 2; ++n) acc[a][b][m][n] = (f32x4){0.f, 0.f, 0.f, 0.f};
    bf16x8 At[4][2], B0[2][2], B1[2][2];
    const char* cA = (const char*)g.A + (size_t)cur.pm * tstep; const char* cB = (const char*)g.Bt + (size_t)cur.pn * tstep;
    S.a_ready(cur);
    PG8_STAGE(PG8_SB(0, 0), cB, voffB); PG8_STAGE(PG8_SA(0, 0), cA, voffA); PG8_STAGE(PG8_SB(0, 1), cB + hstep, voffB); PG8_STAGE(PG8_SA(0, 1), cA + hstep, voffA);
    if (wr == 1) PG8_BAR;
    PG8_WAIT_V(4); PG8_BAR;
    PG8_STAGE(PG8_SB(1, 0), cB + kstep, voffB); PG8_STAGE(PG8_SA(1, 0), cA + kstep, voffA); PG8_STAGE(PG8_SB(1, 1), cB + hstep + kstep, voffB);
    PG8_WAIT_V(6); PG8_BAR;
    PG8_STAMP();
    for (;;) {
        const bool has_next = S.next(ui + 1, nxt);
        const char* nA = has_next ? (const char*)g.A + (size_t)nxt.pm * tstep : cA; const char* nB = has_next ? (const char*)g.Bt + (size_t)nxt.pn * tstep : cB;
        for (int t = 0; t < nt; t += 2) {
            const bool last = (t == nt - 2);
            const char* a1 = cA + (size_t)(t + 1) * kstep;
            const char* a2 = last ? nA : cA + (size_t)(t + 2) * kstep; const char* b2 = last ? nB : cB + (size_t)(t + 2) * kstep;
            const char* a3 = a2 + kstep; const char* b3 = b2 + kstep;
            if (last && has_next) S.a_ready(nxt);
            PG8_LDB(B0, 0, 0); PG8_SCHED; PG8_LDA(At, 0, 0); PG8_STAGE(PG8_SA(1, 1), a1 + hstep, voffA);
            PG8_WAIT_L(8); PG8_BAR; PG8_WAIT_L(0); PG8_MMA(0, 0, At, B0); PG8_BAR; PG8_SCHED;
            PG8_LDB(B1, 0, 1); PG8_STAGE(PG8_SB(0, 0), b2, voffB);
            PG8_BAR; PG8_WAIT_L(0); PG8_MMA(0, 1, At, B1); PG8_BAR;
            PG8_LDA(At, 0, 1); PG8_STAGE(PG8_SA(0, 0), a2, voffA);
            PG8_BAR; PG8_WAIT_L(0); PG8_MMA(1, 0, At, B0); PG8_BAR; PG8_SCHED;
            PG8_STAGE(PG8_SB(0, 1), b2 + hstep, voffB);
            PG8_WAIT_V(6); PG8_BAR; PG8_MMA(1, 1, At, B1); PG8_BAR;
            PG8_LDB(B0, 1, 0); PG8_SCHED; PG8_LDA(At, 1, 0); PG8_STAGE(PG8_SA(0, 1), a2 + hstep, voffA);
            PG8_WAIT_L(8); PG8_BAR; PG8_WAIT_L(0); PG8_MMA(0, 0, At, B0); PG8_BAR; PG8_SCHED;
            PG8_LDB(B1, 1, 1); PG8_STAGE(PG8_SB(1, 0), b3, voffB);
            PG8_BAR; PG8_WAIT_L(0); PG8_MMA(0, 1, At, B1); PG8_BAR;
            PG8_LDA(At, 1, 1); PG8_STAGE(PG8_SA(1, 0), a3, voffA);
            PG8_BAR; PG8_WAIT_L(0); PG8_MMA(1, 0, At, B0); PG8_BAR; PG8_SCHED;
            PG8_STAGE(PG8_SB(1, 1), b3 + hstep, voffB);
            PG8_WAIT_V(6); PG8_BAR; PG8_MMA(1, 1, At, B1); PG8_BAR;
        }
        PG8_STAMP();
        if constexpr (!Epi::AFTER_DRAIN) { E(acc, cur, wr, wc, fr, fq); S.done(cur); }
        PG8_STAMP();
        if (!has_next) break;
#pragma unroll
        for (int a = 0; a < 2; ++a)
#pragma unroll
            for (int b = 0; b < 2; ++b)
#pragma unroll
                for (int m = 0; m < 4; ++m)
#pragma unroll
                    for (int n = 0; n < 2; ++n) acc[a][b][m][n] = (f32x4){0.f, 0.f, 0.f, 0.f};
        cur = nxt; cA = nA; cB = nB; ++ui;
    }
    PG8_WAIT_V(0);
    if (wr == 0) PG8_BAR;
    PG8_BAR;
    if constexpr (Epi::AFTER_DRAIN) { E.fused(acc, cur, wr, wc, fr, fq, lds, wid, lane); S.done(cur); }
    PG8_STAMP();
    if (STAMP && wid == 0) { stamps[lane] = lane < nts ? (((unsigned long long)(unsigned)ts_hi << 32) | (unsigned)ts_lo) : 0ull;
        if (lane == 62) stamps[62] = rt_entry; if (lane == 63) stamps[63] = (unsigned long long)wall_clock64(); }
#undef PG8_STAMP
#undef PG8_SA
#undef PG8_SB
#undef PG8_STAGE
#undef PG8_LDA
#undef PG8_LDB
#undef PG8_MMA
#undef PG8_WAIT_V
#undef PG8_WAIT_L
#undef PG8_BAR
#undef PG8_SCHED
}
}

typedef const __attribute__((address_space(4))) Args* KArgs;
struct Frame {
    LAS unsigned char* lds; int tid, lane, wave, G, bid;
    KArgs ka;
};
#define PH_ARGS() KArgs A_ = F.ka; asm volatile("" : "+s"(A_)); unsigned char* const ws_ = A_->ws; (void)ws_
#define WSP(T_, off) ((T_*)(ws_ + (off)))

__device__ __forceinline__ int ropeperm64(int s) { const int j = s >> 3, i = s & 7; return i < 4 ? 4 * j + i : 32 + 4 * j + (i - 4); }
__device__ __forceinline__ int ropeperm32(int s) { const int j = s >> 3, i = s & 7; return i < 4 ? 4 * j + i : 16 + 4 * j + (i - 4); }
__device__ __forceinline__ int inproj_src(int n) {
    if (n < 384) return (n & ~63) + ropeperm64(n & 63);
    if (n < 512) return 384 + ((n - 384) & ~63) + ropeperm64((n - 384) & 63);
    if (n < 1920) return n;
    if (n < 2176) { const int m = n - 1920; return 1932 + (m & ~31) + ropeperm32(m & 31); }
    if (n < 2432) { const int m = n - 2176; return 2188 + (m & ~31) + ropeperm32(m & 31); }
    if (n < 2688) return 2444 + (n - 2432);
    if (n < 2700) return 1920 + (n - 2688);
    return -1;
}
__device__ __forceinline__ int gu_src(int n) { const int tile = n >> 8, r = n & 255; return r < 128 ? tile * 128 + r : DFF + tile * 128 + (r - 128); }

constexpr int CV_T0 = DEPTH * 44 * 16;
constexpr int CV_T1 = CV_T0 + DEPTH * 16 * 16;
constexpr int CV_T2 = CV_T1 + 2 * 88 * 16;
constexpr int CV_T3 = CV_T2 + 2 * 16 * 44;
constexpr int CV_T4 = CV_T3 + 16 * 88 * 16;
constexpr int CV_T5 = CV_T4 + 16 * 16 * 44;
constexpr int PA_MODJOBS = DEPTH * 96;
constexpr int PA_JOBS = CV_T5 + PA_MODJOBS + 1;

__device__ __forceinline__ void conv_tile(const Frame& F, const float* W, int Nsrc, bf16_t* dst, int K, int kind, int rt, int kt) {
    LAS float* tile = (LAS float*)F.lds;
    const int n = F.tid & 63, kk0 = F.tid >> 6;
    const int nd = rt * 64 + n;
    const int sc = kind == 0 ? inproj_src(nd) : (kind == 2 ? gu_src(nd) : nd);
#pragma unroll
    for (int i = 0; i < 8; ++i) { const int kk = kk0 + 8 * i; tile[kk * 65 + n] = sc >= 0 ? W[(size_t)(kt * 64 + kk) * Nsrc + sc] : 0.f; }
    __syncthreads();
    { const int nn = F.tid >> 3, kq = F.tid & 7; float v[8];
#pragma unroll
      for (int j = 0; j < 8; ++j) v[j] = tile[(kq * 8 + j) * 65 + nn];
      u32x4 w; w.x = pk_bf16(v[0], v[1]); w.y = pk_bf16(v[2], v[3]); w.z = pk_bf16(v[4], v[5]); w.w = pk_bf16(v[6], v[7]);
      *(u32x4*)(dst + (size_t)(rt * 64 + nn) * K + kt * 64 + kq * 8) = w; }
    __syncthreads();
}

__device__ void phase_pre_a(const Frame& F) {
    PH_ARGS();
    for (int job = F.bid; job < PA_JOBS; job += F.G) {
        if (job < CV_T5) {
            if (job < CV_T0) { const int m = job / 704, r = job % 704; conv_tile(F, A_->in[I_WIN] + (size_t)m * D * D_IN, D_IN, WSP(bf16_t, WS_WIN) + (size_t)m * LDP * D, D, 0, r / 16, r % 16); }
            else if (job < CV_T1) { const int q = job - CV_T0, m = q / 256, r = q % 256; conv_tile(F, A_->in[I_WOUT] + (size_t)m * D * D, D, WSP(bf16_t, WS_WOUT) + (size_t)m * D * D, D, 1, r / 16, r % 16); }
            else if (job < CV_T2) { const int q = job - CV_T1, m = q / 1408, r = q % 1408; conv_tile(F, A_->in[I_FFNGU] + (size_t)m * D * 2 * DFF, 2 * DFF, WSP(bf16_t, WS_WGU) + (size_t)m * 2 * DFF * D, D, 2, r / 16, r % 16); }
            else if (job < CV_T3) { const int q = job - CV_T2, m = q / 704, r = q % 704; conv_tile(F, A_->in[I_FFND] + (size_t)m * DFF * D, D, WSP(bf16_t, WS_WD) + (size_t)m * D * DFF, DFF, 1, r / 44, r % 44); }
            else if (job < CV_T4) { const int q = job - CV_T3, m = q / 1408, r = q % 1408; conv_tile(F, A_->in[I_EGU] + (size_t)m * D * 2 * DFF, 2 * DFF, WSP(bf16_t, WS_WGUE) + (size_t)m * 2 * DFF * D, D, 2, r / 16, r % 16); }
            else { const int q = job - CV_T4, m = q / 704, r = q % 704; conv_tile(F, A_->in[I_ED] + (size_t)m * DFF * D, D, WSP(bf16_t, WS_WDE) + (size_t)m * D * DFF, DFF, 1, r / 44, r % 44); }
        } else if (job < CV_T5 + PA_MODJOBS) {
            const int q = job - CV_T5, li = q / 96, cb = q % 96;
            LAS float* act = (LAS float*)F.lds;
            LAS float* part = act + 9 * 1024;
            for (int i = F.tid; i < 9 * 1024; i += 512) { const int r = i >> 10, k = i & 1023; const float cv = r < 8 ? A_->in[I_C][r * 1024 + k] : A_->in[I_CCTX][k]; act[i] = cv / (1.0f + expf(-cv)); }
            __syncthreads();
            float acc[9];
#pragma unroll
            for (int r = 0; r < 9; ++r) acc[r] = 0.f;
            const float* wp = A_->in[I_WADA] + (size_t)li * D * 6144 + cb * 64 + F.lane;
            for (int k = F.wave * 128; k < F.wave * 128 + 128; ++k) { const float wv = wp[(size_t)k * 6144];
#pragma unroll
                for (int r = 0; r < 9; ++r) acc[r] += act[r * 1024 + k] * wv; }
#pragma unroll
            for (int r = 0; r < 9; ++r) part[(F.wave * 9 + r) * 64 + F.lane] = acc[r];
            __syncthreads();
            for (int i = F.tid; i < 9 * 64; i += 512) { const int r = i >> 6, l = i & 63; float s = A_->in[I_BADA][li * 6144 + cb * 64 + l];
#pragma unroll
                for (int w = 0; w < 8; ++w) s += part[(w * 9 + r) * 64 + l];
                WSP(float, WS_MOD)[(size_t)(li * 9 + r) * 6144 + cb * 64 + l] = s; }
            __syncthreads();
        } else {
            float* cA = WSP(float, WS_ROPE); float* sA = cA + 2048 * 32; float* cC = sA + 2048 * 32; float* sC = cC + 2048 * 16;
            for (int idx = F.tid; idx < 2048 * 48; idx += 512) {
                const int pos = idx / 48, p = idx % 48; const float rowf = (float)(pos >> 6), colf = (float)(pos & 63);
                if (p < 32) { const int i = p & 15; const float inv = exp2f(-(float)i * (13.287712379549449f / 16.0f)); const float ang = (p < 16 ? rowf : colf) * inv; cA[pos * 32 + p] = __cosf(ang); sA[pos * 32 + p] = __sinf(ang); }
                else { const int pp = p - 32, i = pp & 7; const float inv = exp2f(-(float)i * (13.287712379549449f / 8.0f)); const float ang = (pp < 8 ? rowf : colf) * inv; cC[pos * 16 + pp] = __cosf(ang); sC[pos * 16 + pp] = __sinf(ang); }
            }
        }
    }
}

__device__ __forceinline__ void row_load(float (&v)[16], const float* p, int lane) {
#pragma unroll
    for (int i = 0; i < 4; ++i) { const f32x4 x = *(const f32x4*)(p + 256 * i + 4 * lane); v[4 * i] = x[0]; v[4 * i + 1] = x[1]; v[4 * i + 2] = x[2]; v[4 * i + 3] = x[3]; }
}
__device__ __forceinline__ void row_store(const float (&v)[16], float* p, int lane) {
#pragma unroll
    for (int i = 0; i < 4; ++i) *(f32x4*)(p + 256 * i + 4 * lane) = (f32x4){v[4 * i], v[4 * i + 1], v[4 * i + 2], v[4 * i + 3]};
}
__device__ __forceinline__ void row_store_bf16(const float (&v)[16], bf16_t* p, int lane) {
#pragma unroll
    for (int i = 0; i < 4; ++i) { u32x2 w; w.x = pk_bf16(v[4 * i], v[4 * i + 1]); w.y = pk_bf16(v[4 * i + 2], v[4 * i + 3]); *(u32x2*)(p + 256 * i + 4 * lane) = w; }
}
__device__ __forceinline__ void row_ln(float (&v)[16]) {
    float s = 0.f;
#pragma unroll
    for (int i = 0; i < 16; ++i) s += v[i];
    const float mean = wave_sum(s) * (1.0f / 1024.0f);
    float q = 0.f;
#pragma unroll
    for (int i = 0; i < 16; ++i) { v[i] -= mean; q += v[i] * v[i]; }
    const float rstd = rsqrtf(wave_sum(q) * (1.0f / 1024.0f) + LN_EPS);
#pragma unroll
    for (int i = 0; i < 16; ++i) v[i] *= rstd;
}
__device__ __forceinline__ void row_modulate(const float (&v)[16], float (&h)[16], const float* shift, const float* scale, int lane) {
    float sh[16], sc[16]; row_load(sh, shift, lane); row_load(sc, scale, lane);
#pragma unroll
    for (int i = 0; i < 16; ++i) h[i] = v[i] * (1.0f + sc[i]) + sh[i];
}
__device__ __forceinline__ const float* mod_row(unsigned char* ws_, int li, int row) { const int b = row / TB, t = row - b * TB; return WSP(float, WS_MOD) + (size_t)(li * 9 + (t < NCTX ? 8 : b)) * 6144; }

__device__ void phase_pre_b(const Frame& F) {
    PH_ARGS();
    for (int row = F.bid * 8 + F.wave; row < T; row += F.G * 8) {
        const int b = row / TB, t = row - b * TB;
        const float* src = t < NCTX ? A_->in[I_CTX] + (size_t)(b * NCTX + t) * D : A_->in[I_X] + (size_t)(b * SEQ + (t - NCTX)) * D;
        float v[16], h[16]; row_load(v, src, F.lane); row_store(v, WSP(float, WS_X) + (size_t)row * D, F.lane);
        row_ln(v); const float* md = mod_row(ws_, 0, row); row_modulate(v, h, md, md + 1024, F.lane);
        row_store_bf16(h, WSP(bf16_t, WS_H) + (size_t)row * D, F.lane);
    }
}

__device__ void phase_post_mixer(const Frame& F, int li) {
    PH_ARGS(); const bool moe = li & 1; const int jm = li >> 1;
    const bool skip_ctx = li == DEPTH - 1;
    LAS float* wr = (LAS float*)F.lds;
    if (moe) { for (int i = F.tid; i < 1024 * 8; i += 512) wr[i] = A_->in[I_RW][(size_t)jm * 8192 + i]; __syncthreads(); }
    unsigned* cnt = (unsigned*)(ws_ + WS_CTL + CTL_CNT_OFF);
    for (int row = F.bid * 8 + F.wave; row < T; row += F.G * 8) {
        const int b = row / TB, t = row - b * TB;
        if (skip_ctx && t < NCTX) continue;
        const float* md = mod_row(ws_, li, row);
        float v[16], o[16], g[16];
        row_load(v, WSP(float, WS_X) + (size_t)row * D, F.lane); row_load(o, WSP(float, WS_O) + (size_t)row * D, F.lane); row_load(g, md + 2048, F.lane);
#pragma unroll
        for (int i = 0; i < 16; ++i) v[i] = ALPHA_RES * v[i] + g[i] * o[i];
        row_ln(v);
        row_load(o, A_->in[I_LN1G] + li * D, F.lane); row_load(g, A_->in[I_LN1B] + li * D, F.lane);
#pragma unroll
        for (int i = 0; i < 16; ++i) v[i] = v[i] * o[i] + g[i];
        row_store(v, WSP(float, WS_X) + (size_t)row * D, F.lane);
        row_ln(v);
        float h[16]; row_modulate(v, h, md + 3072, md + 4096, F.lane);
        if (!moe) { row_store_bf16(h, WSP(bf16_t, WS_H) + (size_t)row * D, F.lane); continue; }
        float lg[8];
#pragma unroll
        for (int e = 0; e < 8; ++e) lg[e] = 0.f;
#pragma unroll
        for (int i = 0; i < 4; ++i)
#pragma unroll
            for (int j = 0; j < 4; ++j) { const int c = 256 * i + 4 * F.lane + j; const f32x4 w0 = *(const LAS f32x4*)(wr + c * 8), w1 = *(const LAS f32x4*)(wr + c * 8 + 4); const float hv = h[4 * i + j];
                lg[0] += hv * w0[0]; lg[1] += hv * w0[1]; lg[2] += hv * w0[2]; lg[3] += hv * w0[3]; lg[4] += hv * w1[0]; lg[5] += hv * w1[1]; lg[6] += hv * w1[2]; lg[7] += hv * w1[3]; }
#pragma unroll
        for (int e = 0; e < 8; ++e) lg[e] = wave_sum(lg[e]) + A_->in[I_RB][jm * 8 + e];
        int e1 = 0; float v1 = lg[0];
#pragma unroll
        for (int e = 1; e < 8; ++e) if (lg[e] > v1) { v1 = lg[e]; e1 = e; }
        int e2 = -1; float v2 = -3.0e38f;
#pragma unroll
        for (int e = 0; e < 8; ++e) if (e != e1 && lg[e] > v2) { v2 = lg[e]; e2 = e; }
        const float w2 = 1.0f / (1.0f + expf(v1 - v2)), w1 = 1.0f - w2;
        unsigned p1 = 0, p2 = 0;
        if (F.lane == 0) { p1 = atomicAdd(&cnt[(jm * 8 + e1) * 64], 1u); p2 = atomicAdd(&cnt[(jm * 8 + e2) * 64], 1u); }
        p1 = __shfl(p1, 0); p2 = __shfl(p2, 0);
        row_store_bf16(h, WSP(bf16_t, WS_HP) + ((size_t)e1 * MOE_CAP + p1) * D, F.lane);
        row_store_bf16(h, WSP(bf16_t, WS_HP) + ((size_t)e2 * MOE_CAP + p2) * D, F.lane);
        if (F.lane == 0) { unsigned* tk = WSP(unsigned, WS_TOK) + (size_t)row * 8; tk[0] = e1; tk[1] = p1; tk[2] = e2; tk[3] = p2; tk[4] = __float_as_uint(w1); tk[5] = __float_as_uint(w2); }
    }
}

__device__ void phase_post_ffn(const Frame& F, int li) {
    PH_ARGS(); const bool moe = li & 1; const int jm = li >> 1; const bool last = li == DEPTH - 1;
    int tb[8];
    if (moe) { const unsigned* cnt = (const unsigned*)(ws_ + WS_CTL + CTL_CNT_OFF); int acc = 0;
#pragma unroll
        for (int e = 0; e < 8; ++e) { tb[e] = acc; acc += ((int)cnt[(jm * 8 + e) * 64] + 255) >> 8; } }
    for (int row = F.bid * 8 + F.wave; row < T; row += F.G * 8) {
        const int b = row / TB, t = row - b * TB;
        if (last && t < NCTX) continue;
        const float* md = mod_row(ws_, li, row);
        float v[16], f[16], g[16];
        row_load(v, WSP(float, WS_X) + (size_t)row * D, F.lane); row_load(g, md + 5120, F.lane);
        if (!moe) row_load(f, WSP(float, WS_O) + (size_t)row * D, F.lane);
        else {
            const unsigned* tk = WSP(unsigned, WS_TOK) + (size_t)row * 8;
            const int e1 = tk[0], p1 = tk[1], e2 = tk[2], p2 = tk[3]; const float w1 = __uint_as_float(tk[4]), w2 = __uint_as_float(tk[5]);
            int b1 = 0, b2 = 0;
#pragma unroll
            for (int e = 0; e < 8; ++e) { b1 = e1 == e ? tb[e] : b1; b2 = e2 == e ? tb[e] : b2; }
            float f2[16];
            row_load(f, WSP(float, WS_HP) + ((size_t)b1 * 256 + p1) * D, F.lane); row_load(f2, WSP(float, WS_HP) + ((size_t)b2 * 256 + p2) * D, F.lane);
#pragma unroll
            for (int i = 0; i < 16; ++i) f[i] = w1 * f[i] + w2 * f2[i];
        }
#pragma unroll
        for (int i = 0; i < 16; ++i) v[i] = ALPHA_RES * v[i] + g[i] * f[i];
        row_ln(v);
        row_load(f, A_->in[I_LN2G] + li * D, F.lane); row_load(g, A_->in[I_LN2B] + li * D, F.lane);
#pragma unroll
        for (int i = 0; i < 16; ++i) v[i] = v[i] * f[i] + g[i];
        if (last) { row_store(v, A_->out + (size_t)(b * SEQ + (t - NCTX)) * D, F.lane); continue; }
        row_store(v, WSP(float, WS_X) + (size_t)row * D, F.lane);
        row_ln(v);
        const float* mdn = mod_row(ws_, li + 1, row);
        float h[16]; row_modulate(v, h, mdn, mdn + 1024, F.lane);
        row_store_bf16(h, WSP(bf16_t, WS_H) + (size_t)row * D, F.lane);
    }
}

__device__ __forceinline__ bf16x8 lds_frag(const LAS bf16_t* base, int ld, int row0, int k0, int lane) {
    return *(const LAS bf16x8*)(base + (row0 + (lane & 15)) * ld + k0 + 8 * (lane >> 4));
}
#define MFMA16(a, b, c) __builtin_amdgcn_mfma_f32_16x16x32_bf16((a), (b), (c), 0, 0, 0)

constexpr int LDT = 136;
__device__ void ssd_m1_item(const Frame& F, int li, int item) {
    PH_ARGS();
    const int b = item / NCH, c = item % NCH, r0 = b * TB + c * 128;
    const int seg_lo = c < 2 ? b * TB : b * TB + NCTX, seg_hi = c < 2 ? b * TB + NCTX : (b + 1) * TB;
    LAS float* s_dt = (LAS float*)F.lds;
    LAS float* s_ac = s_dt + 12 * 128;
    LAS float* s_sc = s_ac + 12 * 128;
    LAS bf16_t* xT = (LAS bf16_t*)(s_sc + 12 * 128);
    LAS bf16_t* bT = xT + 192 * LDT;
    __syncthreads();
    for (int i = F.tid; i < 128 * 12; i += 512) {
        const int l = i / 12, hd = i % 12;
        const float raw = WSP(float, WS_DT)[(size_t)(r0 + l) * 16 + hd] + A_->in[I_DTBIAS][li * 12 + hd];
        const float dtv = raw > 20.f ? raw : log1pf(expf(raw));
        s_dt[hd * 128 + l] = dtv; s_ac[hd * 128 + l] = -dtv * expf(A_->in[I_ALOG][li * 12 + hd]);
        WSP(float, WS_DTV)[(size_t)(r0 + l) * 12 + hd] = dtv;
    }
    __syncthreads();
    for (int hd = F.wave; hd < 12; hd += 8) {
        const bool bw = hd >= 6;
        const int l0 = bw ? 127 - 2 * F.lane : 2 * F.lane, l1 = bw ? 126 - 2 * F.lane : 2 * F.lane + 1;
        const float v0 = s_ac[hd * 128 + l0], v1 = s_ac[hd * 128 + l1];
        float inc = v0 + v1;
#pragma unroll
        for (int o = 1; o < 64; o <<= 1) { const float up = __shfl_up(inc, o); if (F.lane >= o) inc += up; }
        const float exc = inc - (v0 + v1), tot = __shfl(inc, 63);
        const float a0 = exc + v0, a1 = exc + v0 + v1;
        s_ac[hd * 128 + l0] = a0; s_ac[hd * 128 + l1] = a1;
        s_sc[hd * 128 + l0] = s_dt[hd * 128 + l0] * expf(tot - a0); s_sc[hd * 128 + l1] = s_dt[hd * 128 + l1] * expf(tot - a1);
        WSP(float, WS_ACUM)[(size_t)(r0 + l0) * 12 + hd] = a0; WSP(float, WS_ACUM)[(size_t)(r0 + l1) * 12 + hd] = a1;
        if (F.lane == 0) WSP(float, WS_CHT)[(size_t)item * 12 + hd] = tot;
    }
    __syncthreads();
    for (int g = 0; g < 2; ++g) {
        if (F.tid < 448) {
            const int half = F.tid / 224, idx = F.tid % 224;
            const int ucol = idx < 96 ? g * 192 + 2 * idx : (idx < 160 ? 384 + g * 128 + 2 * (idx - 96) : 640 + g * 128 + 2 * (idx - 160));
            float w0[5], w1[5];
#pragma unroll
            for (int k = 0; k < 5; ++k) { w0[k] = A_->in[I_CONVW][(size_t)(li * 5 + k) * CONV_DIM + ucol]; w1[k] = A_->in[I_CONVW][(size_t)(li * 5 + k) * CONV_DIM + ucol + 1]; }
            const float cb0 = A_->in[I_CONVB][li * CONV_DIM + ucol], cb1 = A_->in[I_CONVB][li * CONV_DIM + ucol + 1];
            const bf16_t* Pp = WSP(bf16_t, WS_P) + PC_XBC + ucol;
            float xa[5], xb[5];
            const int lbase = half * 64;
#pragma unroll
            for (int k = 0; k < 4; ++k) { const int r = r0 + lbase + k - 2; unsigned pv = 0u; if (r >= seg_lo && r < seg_hi) pv = *(const unsigned*)(Pp + (size_t)r * LDP); xa[k + 1] = __uint_as_float(pv << 16); xb[k + 1] = __uint_as_float(pv & 0xffff0000u); }
#pragma unroll 4
            for (int l = lbase; l < lbase + 64; ++l) {
#pragma unroll
                for (int k = 0; k < 4; ++k) { xa[k] = xa[k + 1]; xb[k] = xb[k + 1]; }
                { const int r = r0 + l + 2; unsigned pv = 0u; if (r >= seg_lo && r < seg_hi) pv = *(const unsigned*)(Pp + (size_t)r * LDP); xa[4] = __uint_as_float(pv << 16); xb[4] = __uint_as_float(pv & 0xffff0000u); }
                float ya = cb0, yb = cb1;
#pragma unroll
                for (int k = 0; k < 5; ++k) { ya += w0[k] * xa[k]; yb += w1[k] * xb[k]; }
                ya = silu_f(ya); yb = silu_f(yb);
                const unsigned pk = pk_bf16(ya, yb);
                *(unsigned*)(WSP(bf16_t, WS_U) + (size_t)(r0 + l) * CONV_DIM + ucol) = pk;
                if (idx < 96) { xT[(2 * idx) * LDT + l] = (bf16_t)(pk & 0xffffu); xT[(2 * idx + 1) * LDT + l] = (bf16_t)(pk >> 16); }
                else if (idx < 160) { bT[(2 * (idx - 96)) * LDT + l] = (bf16_t)(pk & 0xffffu); bT[(2 * (idx - 96) + 1) * LDT + l] = (bf16_t)(pk >> 16); }
            }
        }
        __syncthreads();
        for (int q = F.wave; q < 24; q += 8) {
            const int hd6 = q >> 2, ptile = q & 3, hl = hd6 % 3, dir = hd6 / 3, hd = dir * 6 + g * 3 + hl;
            bf16x8 af[4];
#pragma unroll
            for (int kt = 0; kt < 4; ++kt) {
                const bf16x8 xr = lds_frag(xT, LDT, hl * 64 + ptile * 16, kt * 32, F.lane);
                const LAS float* sp = s_sc + hd * 128 + kt * 32 + 8 * (F.lane >> 4);
                const f32x4 s0 = *(const LAS f32x4*)sp, s1 = *(const LAS f32x4*)(sp + 4);
                u32x4 w;
                w.x = pk_bf16(bf2f((bf16_t)xr[0]) * s0[0], bf2f((bf16_t)xr[1]) * s0[1]); w.y = pk_bf16(bf2f((bf16_t)xr[2]) * s0[2], bf2f((bf16_t)xr[3]) * s0[3]);
                w.z = pk_bf16(bf2f((bf16_t)xr[4]) * s1[0], bf2f((bf16_t)xr[5]) * s1[1]); w.w = pk_bf16(bf2f((bf16_t)xr[6]) * s1[2], bf2f((bf16_t)xr[7]) * s1[3]);
                af[kt] = __builtin_bit_cast(bf16x8, w);
            }
            float* outp = WSP(float, WS_CHS) + ((size_t)item * 12 + hd) * 8192 + (size_t)(ptile * 16 + 4 * (F.lane >> 4)) * 128 + (F.lane & 15);
#pragma unroll 2
            for (int nt = 0; nt < 8; ++nt) {
                f32x4 acc = {0.f, 0.f, 0.f, 0.f};
#pragma unroll
                for (int kt = 0; kt < 4; ++kt) acc = MFMA16(af[kt], lds_frag(bT, LDT, nt * 16, kt * 32, F.lane), acc);
#pragma unroll
                for (int j = 0; j < 4; ++j) outp[j * 128 + nt * 16] = acc[j];
            }
        }
        __syncthreads();
    }
}

__device__ void phase_ssd_scan(const Frame& F) {
    PH_ARGS();
    float* chs = WSP(float, WS_CHS); const float* cht = WSP(float, WS_CHT);
    for (int idx = F.bid * 512 + F.tid; idx < NB * 12 * 8192; idx += F.G * 512) {
        const int e = idx & 8191, bh = idx >> 13, hd = bh % 12, b = bh / 12;
        float h = 0.f;
        for (int s = 0; s < NCH; ++s) {
            const int c = hd < 6 ? s : (s < 2 ? 1 - s : NCH + 1 - s);
            const size_t o = ((size_t)(b * NCH + c) * 12 + hd) * 8192 + e;
            const float st = chs[o]; chs[o] = h;
            h = expf(cht[(size_t)(b * NCH + c) * 12 + hd]) * h + st;
        }
    }
}

__device__ void ssd_m3_item(const Frame& F, int li, int item) {
    PH_ARGS();
    const int b = item / NCH, c = item % NCH, r0 = b * TB + c * 128;
    LAS float* s_dt = (LAS float*)F.lds;
    LAS float* s_ac = s_dt + 12 * 128;
    LAS float* s_ss = s_ac + 12 * 128;
    LAS bf16_t* cN = (LAS bf16_t*)(s_ss + 128 * 8);
    LAS bf16_t* bN = cN + 128 * LDT;
    LAS bf16_t* xT = bN + 128 * LDT;
    LAS bf16_t* gd = xT + 64 * LDT;
    const int w = F.wave, r = F.lane & 15, gq = F.lane >> 4;
    LAS bf16_t* gdw = gd + w * 16 * LDT;
    __syncthreads();
    for (int i = F.tid; i < 128 * 12; i += 512) { const int l = i / 12, hd = i % 12; s_dt[hd * 128 + l] = WSP(float, WS_DTV)[(size_t)(r0 + l) * 12 + hd]; s_ac[hd * 128 + l] = WSP(float, WS_ACUM)[(size_t)(r0 + l) * 12 + hd]; }
    const bf16_t* U = WSP(bf16_t, WS_U);
    for (int g = 0; g < 2; ++g) {
        __syncthreads();
        for (int i = F.tid; i < 128 * 16; i += 512) { const int l = i >> 4, cc = i & 15;
            *(LAS u32x4*)(cN + l * LDT + cc * 8) = *(const u32x4*)(U + (size_t)(r0 + l) * CONV_DIM + 640 + g * 128 + cc * 8);
            *(LAS u32x4*)(bN + l * LDT + cc * 8) = *(const u32x4*)(U + (size_t)(r0 + l) * CONV_DIM + 384 + g * 128 + cc * 8); }
        __syncthreads();
        f32x4 G[8];
        { bf16x8 cf[4];
#pragma unroll
          for (int kt = 0; kt < 4; ++kt) cf[kt] = lds_frag(cN, LDT, 16 * w, kt * 32, F.lane);
#pragma unroll
          for (int st = 0; st < 8; ++st) { f32x4 acc = {0.f, 0.f, 0.f, 0.f};
#pragma unroll
              for (int kt = 0; kt < 4; ++kt) acc = MFMA16(cf[kt], lds_frag(bN, LDT, st * 16, kt * 32, F.lane), acc);
              G[st] = acc; } }
        for (int hl = 0; hl < 3; ++hl) {
            const int h = g * 3 + hl;
            __syncthreads();
            for (int i = F.tid; i < 128 * 8; i += 512) { const int l = i >> 3, cc = i & 7; const u32x4 v = *(const u32x4*)(U + (size_t)(r0 + l) * CONV_DIM + h * 64 + cc * 8);
                const unsigned vv[4] = {v.x, v.y, v.z, v.w};
#pragma unroll
                for (int e = 0; e < 4; ++e) { xT[(cc * 8 + 2 * e) * LDT + l] = (bf16_t)(vv[e] & 0xffffu); xT[(cc * 8 + 2 * e + 1) * LDT + l] = (bf16_t)(vv[e] >> 16); } }
#pragma unroll
            for (int dir = 0; dir < 2; ++dir) { const float* hs = WSP(float, WS_CHS) + ((size_t)item * 12 + dir * 6 + h) * 8192; LAS bf16_t* hb = bN + dir * 64 * LDT;
                for (int i = F.tid; i < 64 * 32; i += 512) { const int p = i >> 5, q4 = i & 31; const f32x4 v = *(const f32x4*)(hs + p * 128 + q4 * 4); u32x2 pw; pw.x = pk_bf16(v[0], v[1]); pw.y = pk_bf16(v[2], v[3]); *(LAS u32x2*)(hb + p * LDT + q4 * 4) = pw; } }
            __syncthreads();
            f32x4 y[4];
#pragma unroll
            for (int pt = 0; pt < 4; ++pt) y[pt] = (f32x4){0.f, 0.f, 0.f, 0.f};
#pragma unroll
            for (int dir = 0; dir < 2; ++dir) {
                const int hd = dir * 6 + h;
                float acl[4];
#pragma unroll
                for (int j = 0; j < 4; ++j) acl[j] = s_ac[hd * 128 + 16 * w + 4 * gq + j];
#pragma unroll
                for (int st = 0; st < 8; ++st) { const int s = 16 * st + r; const float acs = s_ac[hd * 128 + s], dts = s_dt[hd * 128 + s];
#pragma unroll
                    for (int j = 0; j < 4; ++j) { const int l = 16 * w + 4 * gq + j; const bool ok = dir == 0 ? (s <= l) : (s >= l);
                        const float val = ok ? G[st][j] * __expf(acl[j] - acs) * dts : 0.f; gdw[(4 * gq + j) * LDT + s] = f2bf(val); } }
                asm volatile("s_waitcnt lgkmcnt(0)" ::: "memory");
                bf16x8 gf[4];
#pragma unroll
                for (int kt = 0; kt < 4; ++kt) gf[kt] = lds_frag(gdw, LDT, 0, kt * 32, F.lane);
                bf16x8 cf[4];
#pragma unroll
                for (int kt = 0; kt < 4; ++kt) cf[kt] = lds_frag(cN, LDT, 16 * w, kt * 32, F.lane);
                const LAS bf16_t* hb = bN + dir * 64 * LDT;
#pragma unroll
                for (int pt = 0; pt < 4; ++pt) {
                    f32x4 t = {0.f, 0.f, 0.f, 0.f};
#pragma unroll
                    for (int kt = 0; kt < 4; ++kt) { y[pt] = MFMA16(gf[kt], lds_frag(xT, LDT, pt * 16, kt * 32, F.lane), y[pt]); t = MFMA16(cf[kt], lds_frag(hb, LDT, pt * 16, kt * 32, F.lane), t); }
#pragma unroll
                    for (int j = 0; j < 4; ++j) y[pt][j] += __expf(acl[j]) * t[j];
                }
                asm volatile("s_waitcnt lgkmcnt(0)" ::: "memory");
            }
            const float dsk = A_->in[I_DSKIP][li * 6 + h];
            float ss[4] = {0.f, 0.f, 0.f, 0.f};
#pragma unroll
            for (int pt = 0; pt < 4; ++pt)
#pragma unroll
                for (int j = 0; j < 4; ++j) { const int l = 16 * w + 4 * gq + j, p = pt * 16 + r;
                    const float xv = bf2f(xT[p * LDT + l]); const float zv = bf2f(WSP(bf16_t, WS_P)[(size_t)(r0 + l) * LDP + PC_Z + h * 64 + p]);
                    const float gv = (y[pt][j] + dsk * xv) * silu_f(zv);
                    WSP(float, WS_YG)[(size_t)(r0 + l) * D_INNER + h * 64 + p] = gv; ss[j] += gv * gv; }
#pragma unroll
            for (int j = 0; j < 4; ++j) { float s = ss[j]; s += __shfl_xor(s, 1); s += __shfl_xor(s, 2); s += __shfl_xor(s, 4); s += __shfl_xor(s, 8); if (r == 0) s_ss[(16 * w + 4 * gq + j) * 8 + h] = s; }
        }
    }
    __syncthreads();
    for (int i = F.tid; i < 128 * 96; i += 512) { const int l = i / 96, c4 = i % 96;
        const LAS float* sp = s_ss + l * 8; const float tot = (sp[0] + sp[1] + sp[2]) + (sp[3] + sp[4] + sp[5]);
        const float rstd = rsqrtf(tot * (1.0f / 384.0f) + LN_EPS);
        const f32x4 v = *(const f32x4*)(WSP(float, WS_YG) + (size_t)(r0 + l) * D_INNER + c4 * 4); const f32x4 nw = *(const f32x4*)(A_->in[I_SSMNW] + li * D_INNER + c4 * 4);
        u32x2 pw; pw.x = pk_bf16(v[0] * rstd * nw[0], v[1] * rstd * nw[1]); pw.y = pk_bf16(v[2] * rstd * nw[2], v[3] * rstd * nw[3]);
        *(u32x2*)(WSP(bf16_t, WS_MIX) + (size_t)(r0 + l) * D + 384 + c4 * 4) = pw; }
}

constexpr int LDK = 72;
constexpr int ATT_KT_OFF = 0, ATT_VT_OFF = 128 * LDK * 2  , ATT_PW_OFF = ATT_VT_OFF + 64 * LDT * 2  , ATT_END = ATT_PW_OFF + 8 * 16 * LDT * 2  ;

__device__ __forceinline__ void attn_stage(const Frame& F, const bf16_t* P, int rbase, int kcol, int vcol) {
    LAS bf16_t* Kt = (LAS bf16_t*)(F.lds + ATT_KT_OFF); LAS bf16_t* Vt = (LAS bf16_t*)(F.lds + ATT_VT_OFF);
#pragma unroll
    for (int i = 0; i < 2; ++i) { const int id = F.tid + 512 * i, row = id >> 3, cc = id & 7;
        const u32x4 kv = *(const u32x4*)(P + (size_t)(rbase + row) * LDP + kcol + cc * 8);
        *(LAS u32x4*)(Kt + row * LDK + cc * 8) = kv;
        const u32x4 vv = *(const u32x4*)(P + (size_t)(rbase + row) * LDP + vcol + cc * 8);
        const unsigned va[4] = {vv.x, vv.y, vv.z, vv.w};
#pragma unroll
        for (int e = 0; e < 4; ++e) { Vt[(cc * 8 + 2 * e) * LDT + row] = (bf16_t)(va[e] & 0xffffu); Vt[(cc * 8 + 2 * e + 1) * LDT + row] = (bf16_t)(va[e] >> 16); } }
}

template <int NKT  >
__device__ __forceinline__ void attn_tile(const Frame& F, const bf16x8 (&qf)[NKT], int kcoff, float (&m)[4], float (&l)[4], f32x4 (&O)[4], float c2, bool masked, int tq0, int tk0) {
    const LAS bf16_t* Kt = (const LAS bf16_t*)(F.lds + ATT_KT_OFF); const LAS bf16_t* Vt = (const LAS bf16_t*)(F.lds + ATT_VT_OFF);
    LAS bf16_t* Pw = (LAS bf16_t*)(F.lds + ATT_PW_OFF) + F.wave * 16 * LDT;
    const int r = F.lane & 15, g = F.lane >> 4;
    f32x4 s[8];
#pragma unroll
    for (int nt = 0; nt < 8; ++nt) { f32x4 acc = {0.f, 0.f, 0.f, 0.f};
#pragma unroll
        for (int kt = 0; kt < NKT; ++kt) acc = MFMA16(qf[kt], lds_frag(Kt, LDK, nt * 16, kcoff + kt * 32, F.lane), acc);
        s[nt] = acc * c2; }
    if (masked) {
#pragma unroll
        for (int nt = 0; nt < 8; ++nt)
#pragma unroll
            for (int j = 0; j < 4; ++j) { const int d = (tq0 + 4 * g + j) - (tk0 + 16 * nt + r); if (d > 128 || d < -128) s[nt][j] = -1.0e30f; }
    }
    float mx[4];
#pragma unroll
    for (int j = 0; j < 4; ++j) { float v = s[0][j];
#pragma unroll
        for (int nt = 1; nt < 8; ++nt) v = fmaxf(v, s[nt][j]);
        v = fmaxf(v, __shfl_xor(v, 1)); v = fmaxf(v, __shfl_xor(v, 2)); v = fmaxf(v, __shfl_xor(v, 4)); v = fmaxf(v, __shfl_xor(v, 8));
        mx[j] = fmaxf(m[j], v); }
#pragma unroll
    for (int j = 0; j < 4; ++j) { const float al = fast_exp2(m[j] - mx[j]); m[j] = mx[j]; l[j] *= al;
#pragma unroll
        for (int dt = 0; dt < 4; ++dt) O[dt][j] *= al; }
#pragma unroll
    for (int nt = 0; nt < 8; ++nt)
#pragma unroll
        for (int j = 0; j < 4; ++j) { const float p = fast_exp2(s[nt][j] - mx[j]); l[j] += p; Pw[(4 * g + j) * LDT + 16 * nt + r] = f2bf(p); }
    asm volatile("s_waitcnt lgkmcnt(0)" ::: "memory");
    bf16x8 pf[4];
#pragma unroll
    for (int kt = 0; kt < 4; ++kt) pf[kt] = lds_frag(Pw, LDT, 0, kt * 32, F.lane);
#pragma unroll
    for (int dt = 0; dt < 4; ++dt)
#pragma unroll
        for (int kt = 0; kt < 4; ++kt) O[dt] = MFMA16(pf[kt], lds_frag(Vt, LDT, dt * 16, kt * 32, F.lane), O[dt]);
    asm volatile("s_waitcnt lgkmcnt(0)" ::: "memory");
}
__device__ __forceinline__ float rowsum16(float v) { v += __shfl_xor(v, 1); v += __shfl_xor(v, 2); v += __shfl_xor(v, 4); v += __shfl_xor(v, 8); return v; }

__device__ void attn_a_item(const Frame& F, int li, int item) {
    PH_ARGS();
    const int qt = item % NCH, hq = (item / NCH) % 6, b = item / (6 * NCH), kvh = hq / 3;
    const int rb = b * TB, r = F.lane & 15, g = F.lane >> 4;
    const float c2 = 0.125f * LOG2E;
    const bf16_t* P = WSP(bf16_t, WS_P);
    const int qrow = rb + 128 * qt + 16 * F.wave;
    float m[4], l[4]; f32x4 O[4]; bf16x8 qf[2];
#pragma unroll
    for (int kt = 0; kt < 2; ++kt) qf[kt] = *(const bf16x8*)(P + (size_t)(qrow + r) * LDP + PC_QA + hq * 64 + kt * 32 + 8 * g);
#pragma unroll
    for (int j = 0; j < 4; ++j) { m[j] = -1.0e30f; l[j] = 0.f; }
#pragma unroll
    for (int dt = 0; dt < 4; ++dt) O[dt] = (f32x4){0.f, 0.f, 0.f, 0.f};
    for (int ti = 0; ti < 5; ++ti) {
        int tt; bool masked;
        if (ti < 2) { tt = ti; masked = false; } else { tt = qt - 3 + ti; masked = true; if (qt < 2 || tt < 2 || tt >= NCH) continue; }
        __syncthreads();
        attn_stage(F, P, rb + 128 * tt, PC_KA + kvh * 64, PC_VA + kvh * 64);
        __syncthreads();
        attn_tile<2>(F, qf, 0, m, l, O, c2, masked, 128 * qt + 16 * F.wave, 128 * tt);
    }
    const float sk = A_->in[I_SINK][li * 6 + hq] * LOG2E;
    float inv[4];
#pragma unroll
    for (int j = 0; j < 4; ++j) inv[j] = 1.0f / (rowsum16(l[j]) + fast_exp2(sk - m[j]));
#pragma unroll
    for (int dt = 0; dt < 4; ++dt)
#pragma unroll
        for (int j = 0; j < 4; ++j) WSP(bf16_t, WS_MIX)[(size_t)(qrow + 4 * g + j) * D + hq * 64 + dt * 16 + r] = f2bf(O[dt][j] * inv[j]);
}

__device__ void attn_c_item(const Frame& F, int li, int item) {
    PH_ARGS();
    const int qt = item % NCH, h = (item / NCH) & 3, b = item / (4 * NCH);
    const int rb = b * TB, r = F.lane & 15, g = F.lane >> 4;
    const float c2 = 0.17677669529663687f * LOG2E;
    const float lam_init = 0.8f - 0.6f * expf(-0.3f * (float)li);
    float d0 = 0.f, d1 = 0.f;
    if (F.lane < 32) { d0 = A_->in[I_LAMQ][li * 64 + F.lane] * A_->in[I_LAMK][li * 64 + F.lane]; d1 = A_->in[I_LAMQ][li * 64 + 32 + F.lane] * A_->in[I_LAMK][li * 64 + 32 + F.lane]; }
    const float lam = expf(wave_sum(d0)) - expf(wave_sum(d1)) + lam_init;
    const bf16_t* P = WSP(bf16_t, WS_P);
    const int qrow = rb + 128 * qt + 16 * F.wave;
    float m[2][4], l[2][4]; f32x4 O[2][4]; bf16x8 qf[2][1];
#pragma unroll
    for (int i = 0; i < 2; ++i) { qf[i][0] = *(const bf16x8*)(P + (size_t)(qrow + r) * LDP + PC_QC + (2 * h + i) * 32 + 8 * g);
#pragma unroll
        for (int j = 0; j < 4; ++j) { m[i][j] = -1.0e30f; l[i][j] = 0.f; }
#pragma unroll
        for (int dt = 0; dt < 4; ++dt) O[i][dt] = (f32x4){0.f, 0.f, 0.f, 0.f}; }
    const int ntiles = qt < 2 ? 2 : NCH;
    for (int tt = 0; tt < ntiles; ++tt) {
        __syncthreads();
        attn_stage(F, P, rb + 128 * tt, PC_KC + h * 64, PC_VC + h * 64);
        __syncthreads();
#pragma unroll
        for (int i = 0; i < 2; ++i) attn_tile<1>(F, qf[i], 32 * i, m[i], l[i], O[i], c2, false, 0, 0);
    }
    float inv0[4], inv1[4];
#pragma unroll
    for (int j = 0; j < 4; ++j) { inv0[j] = 1.0f / rowsum16(l[0][j]); inv1[j] = lam / rowsum16(l[1][j]); }
    float ss[4] = {0.f, 0.f, 0.f, 0.f};
#pragma unroll
    for (int dt = 0; dt < 4; ++dt)
#pragma unroll
        for (int j = 0; j < 4; ++j) { const float o = O[0][dt][j] * inv0[j] - O[1][dt][j] * inv1[j]; O[0][dt][j] = o; ss[j] += o * o; }
#pragma unroll
    for (int j = 0; j < 4; ++j) ss[j] = rsqrtf(rowsum16(ss[j]) * (1.0f / 64.0f) + LN_EPS) * (1.0f - lam_init);
#pragma unroll
    for (int dt = 0; dt < 4; ++dt) { const float nw = A_->in[I_DIFFNW][li * 64 + dt * 16 + r];
#pragma unroll
        for (int j = 0; j < 4; ++j) WSP(bf16_t, WS_MIX)[(size_t)(qrow + 4 * g + j) * D + 768 + h * 64 + dt * 16 + r] = f2bf(O[0][dt][j] * ss[j] * nw); }
}

#ifndef ONE_LAUNCH
#define ONE_LAUNCH 0
#endif
constexpr int PH_PER_LAYER = 9, PH_TOTAL = 2 + DEPTH * PH_PER_LAYER;

__global__ void __launch_bounds__(512, 2) hybrid_fwd(Args args) {
    extern __shared__ __attribute__((aligned(16))) unsigned char lds_raw[];
    volatile LAS unsigned* bst = (volatile LAS unsigned*)((LAS unsigned char*)lds_raw + LDS_BYTES - 16);
    if (threadIdx.x < 4) bst[threadIdx.x] = 0u;
    __syncthreads();
    XcdBarrier bar; bar.bar = (unsigned*)(args.ws + WS_CTL); bar.x = 0; bar.st = bst;
    if (args.use_bar) bar = xcd_barrier_post((unsigned*)(args.ws + WS_CTL), bst);
    const int lo = args.ph_lo, hi = args.ph_hi;
#ifndef PMASK
#define PMASK 0xFFFF
#endif
#define PM(b) ((PMASK >> (b)) & 1)
#define IN(k) (lo <= (k) && (k) < hi)
#define SEAM(k) do { if (args.use_bar && (k) + 1 < hi) xcd_barrier(bar); else __syncthreads(); } while (0)
    LAS unsigned char* glds = (LAS unsigned char*)lds_raw;
#define MKFRAME() Frame F; { int t_ = threadIdx.x; asm volatile("" : "+v"(t_)); F.lds = (LAS unsigned char*)lds_raw; F.tid = t_; F.lane = t_ & 63; F.wave = __builtin_amdgcn_readfirstlane(t_ >> 6); \
        F.G = gridDim.x; F.bid = blockIdx.x; F.ka = (KArgs)__builtin_amdgcn_kernarg_segment_ptr(); }

    if (PM(0) && IN(0)) { MKFRAME(); phase_pre_a(F); SEAM(0); }
    if (PM(1) && IN(1)) { MKFRAME(); phase_pre_b(F); SEAM(1); }

    for (int li = 0; li < DEPTH; ++li) {
        const int pb = 2 + li * PH_PER_LAYER; const bool moe = li & 1; const int jm = li >> 1; const bool last = li == DEPTH - 1;
        if (PM(2) && IN(pb + 0)) {
            MKFRAME(); PH_ARGS();
            pg8::Gemm g{WSP(bf16_t, WS_H), WSP(bf16_t, WS_WIN) + (size_t)li * LDP * D, T, LDP, D}; pg8::StaticOrder S; S.init(T, LDP, F.G, F.bid);
            const float* rp = WSP(float, WS_ROPE);
            pg8::EpiInProj E{WSP(bf16_t, WS_P), WSP(float, WS_DT), rp, rp + 2048 * 32, rp + 2 * 2048 * 32, rp + 2 * 2048 * 32 + 2048 * 16};
            pg8::gemm_phase<pg8::EpiInProj, pg8::StaticOrder>(glds, g, S, E, nullptr);
            SEAM(pb + 0);
        }
        if (PM(3) && IN(pb + 1)) {
            MKFRAME();
            const int nitems = NB * NCH + NB * 6 * NCH;
            for (int it = F.bid; it < nitems; it += F.G) {
                if (it < NB * NCH) ssd_m1_item(F, li, it);
                else { const int ia = it - NB * NCH; if (last && (ia % NCH) < 2) continue; __syncthreads(); attn_a_item(F, li, ia); }
            }
            SEAM(pb + 1);
        }
        if (PM(4) && IN(pb + 2)) {
            MKFRAME();
            phase_ssd_scan(F);
            for (int it = F.bid; it < NB * 4 * NCH; it += F.G) { if (last && (it % NCH) < 2) continue; __syncthreads(); attn_c_item(F, li, it); }
            SEAM(pb + 2);
        }
        if (PM(5) && IN(pb + 3)) {
            MKFRAME();
            for (int it = F.bid; it < NB * NCH; it += F.G) { if (last && (it % NCH) < 2) continue; ssd_m3_item(F, li, it); }
            SEAM(pb + 3);
        }
        if (PM(6) && IN(pb + 4)) {
            MKFRAME(); PH_ARGS();
            pg8::Gemm g{WSP(bf16_t, WS_MIX), WSP(bf16_t, WS_WOUT) + (size_t)li * D * D, T, D, D}; pg8::StaticOrder S; S.init(T, D, F.G, F.bid);
            pg8::EpiF32 E{WSP(float, WS_O), D};
            pg8::gemm_phase<pg8::EpiF32, pg8::StaticOrder>(glds, g, S, E, nullptr);
            SEAM(pb + 4);
        }
        if (PM(7) && IN(pb + 5)) { MKFRAME(); phase_post_mixer(F, li); SEAM(pb + 5); }
        if (PM(8) && IN(pb + 6)) {
            MKFRAME(); PH_ARGS();
            pg8::EpiSwiGLU E{WSP(bf16_t, WS_ACT)};
            if (!moe) {
                pg8::Gemm g{WSP(bf16_t, WS_H), WSP(bf16_t, WS_WGU) + (size_t)jm * 2 * DFF * D, T, 2 * DFF, D}; pg8::StaticOrder S; S.init(T, 2 * DFF, F.G, F.bid);
                pg8::gemm_phase<pg8::EpiSwiGLU, pg8::StaticOrder>(glds, g, S, E, nullptr);
            } else {
                const unsigned* cnt = (const unsigned*)(ws_ + WS_CTL + CTL_CNT_OFF) + jm * 8 * 64;
                pg8::GroupedOrder<0> S; int acc = 0;
                acc += ((int)cnt[0 * 64] + 255) >> 8; S.t1 = acc; acc += ((int)cnt[1 * 64] + 255) >> 8; S.t2 = acc; acc += ((int)cnt[2 * 64] + 255) >> 8; S.t3 = acc; acc += ((int)cnt[3 * 64] + 255) >> 8; S.t4 = acc;
                acc += ((int)cnt[4 * 64] + 255) >> 8; S.t5 = acc; acc += ((int)cnt[5 * 64] + 255) >> 8; S.t6 = acc; acc += ((int)cnt[6 * 64] + 255) >> 8; S.t7 = acc; acc += ((int)cnt[7 * 64] + 255) >> 8; S.t8 = acc;
                S.nN = 2 * DFF / 256; S.capTiles = MOE_CAP / 256; S.G = F.G; S.c = F.bid;
                pg8::Gemm g{WSP(bf16_t, WS_HP), WSP(bf16_t, WS_WGUE) + (size_t)jm * 8 * 2 * DFF * D, NEXP * MOE_CAP, NEXP * 2 * DFF, D};
                pg8::gemm_phase<pg8::EpiSwiGLU, pg8::GroupedOrder<0>>(glds, g, S, E, nullptr);
            }
            SEAM(pb + 6);
        }
        if (PM(9) && IN(pb + 7)) {
            MKFRAME(); PH_ARGS();
            if (!moe) {
                pg8::Gemm g{WSP(bf16_t, WS_ACT), WSP(bf16_t, WS_WD) + (size_t)jm * D * DFF, T, D, DFF}; pg8::StaticOrder S; S.init(T, D, F.G, F.bid);
                pg8::EpiF32 E{WSP(float, WS_O), D};
                pg8::gemm_phase<pg8::EpiF32, pg8::StaticOrder>(glds, g, S, E, nullptr);
            } else {
                const unsigned* cnt = (const unsigned*)(ws_ + WS_CTL + CTL_CNT_OFF) + jm * 8 * 64;
                pg8::GroupedOrder<1> S; int acc = 0;
                acc += ((int)cnt[0 * 64] + 255) >> 8; S.t1 = acc; acc += ((int)cnt[1 * 64] + 255) >> 8; S.t2 = acc; acc += ((int)cnt[2 * 64] + 255) >> 8; S.t3 = acc; acc += ((int)cnt[3 * 64] + 255) >> 8; S.t4 = acc;
                acc += ((int)cnt[4 * 64] + 255) >> 8; S.t5 = acc; acc += ((int)cnt[5 * 64] + 255) >> 8; S.t6 = acc; acc += ((int)cnt[6 * 64] + 255) >> 8; S.t7 = acc; acc += ((int)cnt[7 * 64] + 255) >> 8; S.t8 = acc;
                S.nN = D / 256; S.capTiles = MOE_CAP / 256; S.G = F.G; S.c = F.bid;
                pg8::Gemm g{WSP(bf16_t, WS_ACT), WSP(bf16_t, WS_WDE) + (size_t)jm * 8 * D * DFF, MAX_SLOT_ROWS, NEXP * D, DFF};
                pg8::EpiF32 E{WSP(float, WS_HP), D};
                pg8::gemm_phase<pg8::EpiF32, pg8::GroupedOrder<1>>(glds, g, S, E, nullptr);
            }
            SEAM(pb + 7);
        }
        if (PM(10) && IN(pb + 8)) { MKFRAME(); phase_post_ffn(F, li); SEAM(pb + 8); }
    }
#undef IN
#undef SEAM
}

extern "C" void kernel_launch(void* const* d_in, const int* in_sizes, int n_in, void* d_out, int out_size, void* d_ws, size_t ws_size, hipStream_t stream) {
    static int grid = 0;
    if (grid == 0) {
        if (n_in != 28 || out_size != NB * SEQ * D || ws_size < WS_END) { fprintf(stderr, "kernel_launch: unexpected shapes (n_in %d, out %d, ws %zu, need %zu); nothing launched\n", n_in, out_size, ws_size, (size_t)WS_END); grid = -1; return; }
        int dev = 0, cus = 0, per_cu = 0;
        if (hipGetDevice(&dev) != hipSuccess || hipDeviceGetAttribute(&cus, hipDeviceAttributeMultiprocessorCount, dev) != hipSuccess) { grid = -1; return; }
        if (hipFuncSetAttribute((const void*)hybrid_fwd, hipFuncAttributeMaxDynamicSharedMemorySize, LDS_BYTES) != hipSuccess) { fprintf(stderr, "kernel_launch: hipFuncSetAttribute failed\n"); grid = -1; return; }
        if (hipOccupancyMaxActiveBlocksPerMultiprocessor(&per_cu, (const void*)hybrid_fwd, 512, LDS_BYTES) != hipSuccess || per_cu < 1) { fprintf(stderr, "kernel_launch: occupancy query says %d blocks per CU\n", per_cu); per_cu = 1; }
        (void)hipGetLastError();
        grid = cus;
    }
    if (grid < 0) return;
    (void)hipMemsetAsync((char*)d_ws + WS_CTL, 0, CTL_BYTES, stream);
    Args a{};
    for (int i = 0; i < 28; ++i) a.in[i] = (const float*)d_in[i];
    a.out = (float*)d_out; a.ws = (unsigned char*)d_ws; a.pad = 0;
#if ONE_LAUNCH
    a.ph_lo = 0; a.ph_hi = PH_TOTAL; a.use_bar = 1;
    hipLaunchKernelGGL(hybrid_fwd, dim3(grid), dim3(512), LDS_BYTES, stream, a);
#else
    for (int p = 0; p < PH_TOTAL; ++p) { a.ph_lo = p; a.ph_hi = p + 1; a.use_bar = 0; hipLaunchKernelGGL(hybrid_fwd, dim3(grid), dim3(512), LDS_BYTES, stream, a); }
#endif
}
```

```cpp
#include <hip/hip_runtime.h>
#include <cstdio>
#include <cstdint>
#include <cstddef>

#ifndef SPINMASK
#define SPINMASK 0
#endif
#define LAS __attribute__((address_space(3)))
typedef unsigned short bf16_t;
typedef short bf16x8 __attribute__((ext_vector_type(8)));
typedef float f32x4 __attribute__((ext_vector_type(4)));
typedef float f32x2 __attribute__((ext_vector_type(2)));
typedef unsigned u32x4 __attribute__((ext_vector_type(4)));
typedef unsigned u32x2 __attribute__((ext_vector_type(2)));

constexpr int NB = 8, SEQ = 2048, NCTX = 256, TB = NCTX + SEQ  , T = NB * TB  , D = 1024, DEPTH = 4;
constexpr int NCH = TB / 128  ;
constexpr int D_IN = 2700, LDP = 2816, DFF = 2816, NEXP = 8, D_INNER = 384, CONV_DIM = 896;
constexpr int PC_QA = 0, PC_KA = 384, PC_VA = 512, PC_Z = 640, PC_XBC = 1024, PC_QC = 1920, PC_KC = 2176, PC_VC = 2432, PC_DT = 2688;
constexpr float LN_EPS = 1e-6f;
constexpr float ALPHA_RES = 1.6817928305074290f;
constexpr float LOG2E = 1.4426950408889634f;
constexpr int MOE_CAP = T;
constexpr int MAX_SLOT_ROWS = 2 * T + NEXP * 256;

constexpr size_t al256(size_t x) { return (x + 255) & ~(size_t)255; }
constexpr size_t WS_CTL = 0;
constexpr size_t CTL_BYTES = 65536;
constexpr size_t CTL_Q_OFF = 32768;
constexpr size_t CTL_CNT_OFF = 16384;
constexpr size_t WS_MOD = WS_CTL + CTL_BYTES;
constexpr size_t WS_ROPE = WS_MOD + al256((size_t)DEPTH * 9 * 6144 * 4);
constexpr size_t WS_WIN = WS_ROPE + (size_t)2048 * 96 * 4;
constexpr size_t WS_WOUT = WS_WIN + (size_t)DEPTH * LDP * D * 2;
constexpr size_t WS_WGU = WS_WOUT + (size_t)DEPTH * D * D * 2;
constexpr size_t WS_WD = WS_WGU + (size_t)2 * 2 * DFF * D * 2;
constexpr size_t WS_WGUE = WS_WD + (size_t)2 * D * DFF * 2;
constexpr size_t WS_WDE = WS_WGUE + (size_t)16 * 2 * DFF * D * 2;
constexpr size_t WS_X = WS_WDE + (size_t)16 * D * DFF * 2;
constexpr size_t WS_H = WS_X + (size_t)T * D * 4;
constexpr size_t WS_P = WS_H + (size_t)T * D * 2;
constexpr size_t WS_DT = WS_P + (size_t)T * LDP * 2;
constexpr size_t WS_U = WS_DT + (size_t)T * 16 * 4;
constexpr size_t WS_DTV = WS_U + (size_t)T * CONV_DIM * 2;
constexpr size_t WS_ACUM = WS_DTV + (size_t)T * 12 * 4;
constexpr size_t WS_CHS = WS_ACUM + (size_t)T * 12 * 4;
constexpr size_t WS_CHT = WS_CHS + (size_t)NB * NCH * 12 * 8192 * 4;
constexpr size_t WS_YG = WS_CHT + 8192;
constexpr size_t WS_MIX = WS_YG + (size_t)T * D_INNER * 4;
constexpr size_t WS_O = WS_MIX + (size_t)T * D * 2;
constexpr size_t WS_ACT = WS_O + (size_t)T * D * 4;
constexpr size_t WS_HP = WS_ACT + (size_t)MAX_SLOT_ROWS * DFF * 2;
constexpr size_t WS_TOK = WS_HP + (size_t)NEXP * MOE_CAP * D * 2;
constexpr size_t WS_VTA = WS_TOK + (size_t)T * 32;
constexpr size_t WS_VTC = WS_VTA + (size_t)NB * 2 * 64 * TB * 2;
constexpr size_t WS_XT = WS_VTC + (size_t)NB * 4 * 64 * TB * 2;
constexpr size_t WS_H0B = WS_XT + (size_t)NB * NCH * D_INNER * 128 * 2;
constexpr size_t WS_WSC = WS_H0B + (size_t)NB * NCH * 12 * 8192 * 2;
constexpr size_t WS_RSC = WS_WSC + (size_t)(18 * 2 * DFF + DEPTH * LDP) * 4;
constexpr size_t WS_HPS = WS_RSC + (size_t)T * 4;
constexpr size_t WS_END = WS_HPS + (size_t)NEXP * MOE_CAP * 4;

constexpr int LDS_BYTES = 147456;

struct Args { const float* in[28]; float* out; unsigned char* ws; int ph_lo, ph_hi, use_bar, pad; };
enum { I_X = 0, I_C, I_CTX, I_CCTX, I_WADA, I_BADA, I_WIN, I_SINK, I_CONVW, I_CONVB, I_DTBIAS, I_ALOG, I_DSKIP, I_SSMNW, I_LAMQ, I_LAMK, I_DIFFNW, I_WOUT,
       I_LN1G, I_LN1B, I_LN2G, I_LN2B, I_FFNGU, I_FFND, I_RW, I_RB, I_EGU, I_ED };

__device__ __forceinline__ float bf2f(bf16_t v) { return __uint_as_float(((unsigned)v) << 16); }
__device__ __forceinline__ bf16_t f2bf(float f) { unsigned u = __float_as_uint(f); u += 0x7FFFu + ((u >> 16) & 1u); return (bf16_t)(u >> 16); }
__device__ __forceinline__ unsigned pk_bf16(float lo, float hi) { unsigned r; asm("v_cvt_pk_bf16_f32 %0, %1, %2" : "=v"(r) : "v"(lo), "v"(hi)); return r; }
__device__ __forceinline__ float fast_exp2(float x) { return __builtin_amdgcn_exp2f(x); }
__device__ __forceinline__ float silu_f(float x) { return x * __builtin_amdgcn_rcpf(1.0f + __expf(-x)); }
__device__ __forceinline__ float wave_sum(float v) {
#pragma unroll
    for (int o = 32; o >= 1; o >>= 1) v += __shfl_xor(v, o);
    return v;
}
#define XB_TMO      128
#define XB_XCNT(j)  (256  + 64 * (j))
#define XB_XSUB(j)  (1280 + 64 * (j))
#define XB_XGEN(j)  (2304 + 64 * (j))
#define XB_TOP      3328
#define XB_TOPGEN   3392
#define XCD_BAR_WORDS 3456
#define XB_SPIN_CAP (1u << 18)
#define LAS __attribute__((address_space(3)))

__device__ __forceinline__ unsigned xb_ld(unsigned* p)              { return __hip_atomic_load(p, __ATOMIC_RELAXED, __HIP_MEMORY_SCOPE_AGENT); }
__device__ __forceinline__ unsigned xb_add(unsigned* p, unsigned v) { return __hip_atomic_fetch_add(p, v, __ATOMIC_RELAXED, __HIP_MEMORY_SCOPE_AGENT); }
__device__ __forceinline__ unsigned xb_xcc_id() { return (unsigned)__builtin_amdgcn_s_getreg((3 << 11) | 20) & 0xFu; }
#define XB_SPIN(cond, bar) do { unsigned _sp = 0; while (cond) { __builtin_amdgcn_s_sleep(1); \
    if ((++_sp & 255u) == 0u) { if (xb_ld(&(bar)[XB_TMO])) break; if (_sp > XB_SPIN_CAP) { atomicAdd(&(bar)[XB_TMO], 1u); break; } } } } while (0)

struct XcdBarrier {
    unsigned* bar; unsigned x;
    volatile LAS unsigned* st;
};

__device__ __forceinline__ XcdBarrier xcd_barrier_post(unsigned* bar, volatile LAS unsigned* st) {
    XcdBarrier b; b.bar = bar; b.x = xb_xcc_id(); b.st = st;
    if (threadIdx.x == 0) (void)xb_add(&bar[XB_XCNT(b.x)], 1u);
    return b;
}
__device__ __forceinline__ void xcd_barrier_complete(unsigned* bar, unsigned x, unsigned& nloc, unsigned& nx) {
    const unsigned G = gridDim.x * gridDim.y * gridDim.z;
    unsigned sum, cnt, mine, sp = 0u;
    for (;;) {
        sum = 0u; cnt = 0u; mine = 0u;
#pragma unroll
        for (unsigned j = 0; j < 16; ++j) { const unsigned c = xb_ld(&bar[XB_XCNT(j)]); sum += c; cnt += (c > 0u) ? 1u : 0u; mine = (j == x) ? c : mine; }
        if (sum == G) break;
        __builtin_amdgcn_s_sleep(1);
        if ((++sp & 255u) == 0u) { if (xb_ld(&bar[XB_TMO])) break; if (sp > XB_SPIN_CAP) { atomicAdd(&bar[XB_TMO], 1u); break; } }
    }
    nloc = mine > 0u ? mine : 1u; nx = cnt > 0u ? cnt : 1u;
}

__device__ __forceinline__ void xcd_barrier(const XcdBarrier& b) {
    asm volatile("s_waitcnt vmcnt(0)" ::: "memory");
    __syncthreads();
    if (threadIdx.x == 0) {
        unsigned* bar = b.bar;
        __builtin_amdgcn_s_waitcnt(0);
        unsigned nloc = b.st[0], nx = b.st[1];
        if (nloc == 0u) { xcd_barrier_complete(bar, b.x, nloc, nx); b.st[0] = nloc; b.st[1] = nx; }
        const unsigned old = xb_add(&bar[XB_XSUB(b.x)], 1u);
        const unsigned gen = old / nloc;
        if (old + 1u == (gen + 1u) * nloc) {
            __builtin_amdgcn_fence(__ATOMIC_RELEASE, "agent");
            asm volatile("s_waitcnt vmcnt(0)" ::: "memory");
            const unsigned og = xb_add(&bar[XB_TOP], 1u);
            const unsigned tg = og / nx;
            if (og + 1u == (tg + 1u) * nx) xb_add(&bar[XB_TOPGEN], 1u);
            else XB_SPIN(xb_ld(&bar[XB_TOPGEN]) == tg, bar);
            __builtin_amdgcn_fence(__ATOMIC_ACQUIRE, "agent");
            xb_add(&bar[XB_XGEN(b.x)], 1u);
            asm volatile("s_waitcnt vmcnt(0)" ::: "memory");
        } else {
            XB_SPIN(xb_ld(&bar[XB_XGEN(b.x)]) == gen, bar);
            __builtin_amdgcn_fence(__ATOMIC_ACQUIRE, "agent");
            asm volatile("s_waitcnt vmcnt(0)" ::: "memory");
        }
    }
    __syncthreads();
}


namespace pg8 {
#define PG8_LAS __attribute__((address_space(3)))
typedef int v4i32 __attribute__((ext_vector_type(4)));
typedef int v8i32 __attribute__((ext_vector_type(8)));
template <bool I> struct AccSel { typedef f32x4 T; };
template <> struct AccSel<true> { typedef v4i32 T; };
constexpr int BM = 256, BK = 64, HALF = 128, HTB = HALF * BK * 2  , STAGE_BYTES = 8 * HTB, NXCD = 8, WGM = 8;

__host__ __device__ __forceinline__ int lds_byte(int r, int c) { const int st = (r >> 4) * 2 + (c >> 5), rr = r & 15, cc = c & 31, ob = rr * 64 + cc * 2; return st * 1024 + (ob ^ (((ob >> 9) & 1) << 5)); }
__host__ __device__ __forceinline__ void stage_rc(int b, int& R, int& C) { const int st = b / 1024, sb = b % 1024, swz = sb ^ (((sb >> 9) & 1) << 5); R = (st >> 1) * 16 + swz / 64; C = (st & 1) * 32 + (swz % 64) / 2; }
__host__ __device__ __forceinline__ int perm32(int rho) { const int n = rho >> 4, i = rho & 15; return 8 * (i >> 2) + 4 * n + (i & 3); }

struct Unit { int pm, pn, po, pc; };
struct Gemm { const bf16_t* A; const bf16_t* Bt; int M, N, K; };

struct StaticOrder {
    int nM, nN, nwg, G, c, skipctx, skipcol;
    __host__ __device__ void init(int M, int N, int G_, int c_, int skipctx_ = 0, int skipcol_ = -1) { nM = M / BM; nN = N / BM; nwg = nM * nN; G = G_; c = c_; skipctx = skipctx_; skipcol = skipcol_; }
    __host__ __device__ bool next(int i, Unit& u) const {
        const long L = (long)i * G + c; if (L >= nwg) return false;
        int wgid = (int)L; { const int q = nwg / NXCD, r = nwg % NXCD, xcd = wgid % NXCD, off = wgid / NXCD; wgid = (xcd < r ? xcd * (q + 1) : r * (q + 1) + (xcd - r) * q) + off; }
        const int nig = WGM * nN, gid = wgid / nig, fm = gid * WGM, gsz = (nM - fm) < WGM ? (nM - fm) : WGM;
        u.pm = fm + ((wgid % nig) % gsz); if (skipctx) u.pm += (u.pm >> 3) + 1;
        u.pn = (wgid % nig) / gsz; if (skipcol >= 0 && u.pn >= skipcol) ++u.pn;
        u.po = u.pm; u.pc = u.pn; return true;
    }
    __device__ __forceinline__ void a_ready(const Unit&) const {}
    __device__ __forceinline__ void done(const Unit&) const {}
};
struct OneUnit {
    int pm, pn;
    __device__ __forceinline__ bool next(int i, Unit& u) const { if (i) return false; u.pm = pm; u.pn = pn; u.po = pm; u.pc = pn; return true; }
    __device__ __forceinline__ void a_ready(const Unit&) const {}
    __device__ __forceinline__ void done(const Unit&) const {}
};
template <int MODE> struct GroupedOrder {
    int t1, t2, t3, t4, t5, t6, t7, t8, nN, capTiles, G, c;
    __device__ __forceinline__ bool next(int i, Unit& u) const {
        const int nwg = t8 * nN, L = i * G + c; if (L >= nwg) return false;
        int wgid = L; { const int q = nwg / NXCD, r = nwg % NXCD, xcd = wgid % NXCD, off = wgid / NXCD; wgid = (xcd < r ? xcd * (q + 1) : r * (q + 1) + (xcd - r) * q) + off; }
        const int nig = WGM * nN, gid = wgid / nig, fm = gid * WGM, gsz = (t8 - fm) < WGM ? (t8 - fm) : WGM;
        const int rt = fm + ((wgid % nig) % gsz), pn = (wgid % nig) / gsz;
        int e = 0, base = 0;
        if (rt >= t1) { e = 1; base = t1; } if (rt >= t2) { e = 2; base = t2; } if (rt >= t3) { e = 3; base = t3; } if (rt >= t4) { e = 4; base = t4; }
        if (rt >= t5) { e = 5; base = t5; } if (rt >= t6) { e = 6; base = t6; } if (rt >= t7) { e = 7; base = t7; }
        u.pm = (MODE == 0) ? e * capTiles + (rt - base) : rt; u.pn = e * nN + pn; u.po = rt; u.pc = pn; return true;
    }
    __device__ __forceinline__ void a_ready(const Unit&) const {}
    __device__ __forceinline__ void done(const Unit&) const {}
};

struct EpiF32 {
    static constexpr bool PERM = false, AFTER_DRAIN = false;
    float* C; int ldc;
    __device__ __forceinline__ void operator()(const f32x4 (&acc)[2][2][4][2], const Unit& u, int wr, int wc, int fr, int fq) const {
        const int row0 = u.po * BM + wr * 64 + fr, col0 = u.pc * BM + wc * 32 + 4 * fq;
#pragma unroll
        for (int ai = 0; ai < 2; ++ai)
#pragma unroll
            for (int m = 0; m < 4; ++m) { float* rowp = C + (size_t)(row0 + ai * HALF + m * 16) * ldc + col0;
#pragma unroll
                for (int bj = 0; bj < 2; ++bj)
#pragma unroll
                    for (int n = 0; n < 2; ++n) *(f32x4*)(rowp + bj * HALF + n * 16) = acc[ai][bj][m][n]; }
    }
};
struct EpiBf16 {
    static constexpr bool PERM = true, AFTER_DRAIN = false;
    bf16_t* O; int ldc; float scale;
    __device__ __forceinline__ void operator()(const f32x4 (&acc)[2][2][4][2], const Unit& u, int wr, int wc, int fr, int fq) const {
        const int row0 = u.po * BM + wr * 64 + fr, col0 = u.pc * BM + wc * 32 + 8 * fq;
#pragma unroll
        for (int ai = 0; ai < 2; ++ai)
#pragma unroll
            for (int m = 0; m < 4; ++m) { bf16_t* rowp = O + (size_t)(row0 + ai * HALF + m * 16) * ldc + col0;
#pragma unroll
                for (int bj = 0; bj < 2; ++bj) { const f32x4 v0 = acc[ai][bj][m][0] * scale, v1 = acc[ai][bj][m][1] * scale;
                    u32x4 w; w.x = pk_bf16(v0[0], v0[1]); w.y = pk_bf16(v0[2], v0[3]); w.z = pk_bf16(v1[0], v1[1]); w.w = pk_bf16(v1[2], v1[3]);
                    *(u32x4*)(rowp + bj * HALF) = w; } }
    }
};
struct EpiInProj {
    static constexpr bool PERM = true, AFTER_DRAIN = false;
    bf16_t* P; float* DT; const float* cosA; const float* sinA; const float* cosC; const float* sinC; bf16_t* VTA; bf16_t* VTC; const float* rsc; const float* wsc;
    __device__ __forceinline__ void operator()(const v4i32 (&acc)[2][2][4][2], const Unit& u, int wr, int wc, int fr, int fq) const {
        const int pt = u.po % 9; const bool latent = pt != 0;
        const int row0 = u.po * BM + wr * 64 + fr, pos0 = (pt - 1) * 256 + wr * 64 + fr;
        const float* wq = wsc + (size_t)u.pn * BM + wc * 32 + 8 * fq; asm volatile("" : "+v"(wq));
        const f32x4 ws0[2] = {*(const f32x4*)wq, *(const f32x4*)(wq + HALF)}, ws1[2] = {*(const f32x4*)(wq + 4), *(const f32x4*)(wq + HALF + 4)};
        float sav[2][4];
#pragma unroll
        for (int ai = 0; ai < 2; ++ai)
#pragma unroll
            for (int m = 0; m < 4; ++m) sav[ai][m] = rsc[row0 + ai * HALF + m * 16];
#pragma unroll
        for (int ai = 0; ai < 2; ++ai)
#pragma unroll
            for (int m = 0; m < 4; ++m) {
                const int row = row0 + ai * HALF + m * 16, pos = pos0 + ai * HALF + m * 16;
#pragma unroll
                for (int bj = 0; bj < 2; ++bj) {
                    const int c0 = u.pc * BM + bj * HALF + wc * 32 + 8 * fq;
                    const v4i32 i0 = acc[ai][bj][m][0], i1 = acc[ai][bj][m][1]; const float sa = sav[ai][m];
                    f32x4 v0 = {(float)i0[0], (float)i0[1], (float)i0[2], (float)i0[3]}, v1 = {(float)i1[0], (float)i1[1], (float)i1[2], (float)i1[3]};
                    v0 *= ws0[bj] * sa; v1 *= ws1[bj] * sa;
                    if (latent) {
                        if (c0 < PC_VA) { const int j = (c0 & 63) >> 3; const f32x4 cs = *(const f32x4*)(cosA + pos * 32 + 4 * j), sn = *(const f32x4*)(sinA + pos * 32 + 4 * j);
                            const f32x4 a = v0 * cs - v1 * sn, b = v0 * sn + v1 * cs; v0 = a; v1 = b; }
                        else if (c0 >= PC_QC && c0 < PC_VC) { const int j = (c0 & 31) >> 3; const f32x4 cs = *(const f32x4*)(cosC + pos * 16 + 4 * j), sn = *(const f32x4*)(sinC + pos * 16 + 4 * j);
                            const f32x4 a = v0 * cs - v1 * sn, b = v0 * sn + v1 * cs; v0 = a; v1 = b; }
                    }
                    u32x4 w; w.x = pk_bf16(v0[0], v0[1]); w.y = pk_bf16(v0[2], v0[3]); w.z = pk_bf16(v1[0], v1[1]); w.w = pk_bf16(v1[2], v1[3]);
                    *(u32x4*)(P + (size_t)row * LDP + c0) = w;
                    if ((c0 >= PC_VA && c0 < PC_Z) || (c0 >= PC_VC && c0 < PC_DT)) {
                        const int bb = u.po / 9, tpos = pt * 256 + ai * HALF + wr * 64 + m * 16 + (8 * ((fr >> 2) & 1) + 4 * (fr >> 3) + (fr & 3));
                        bf16_t* vt = (c0 < PC_Z) ? VTA + ((size_t)(bb * 128 + (c0 - PC_VA)) * TB + tpos) : VTC + ((size_t)(bb * 256 + (c0 - PC_VC)) * TB + tpos);
                        vt[0] = (bf16_t)(w.x & 0xffffu); vt[TB] = (bf16_t)(w.x >> 16); vt[2 * TB] = (bf16_t)(w.y & 0xffffu); vt[3 * TB] = (bf16_t)(w.y >> 16);
                        vt[4 * TB] = (bf16_t)(w.z & 0xffffu); vt[5 * TB] = (bf16_t)(w.z >> 16); vt[6 * TB] = (bf16_t)(w.w & 0xffffu); vt[7 * TB] = (bf16_t)(w.w >> 16); }
                    if (c0 >= PC_DT && c0 < PC_DT + 16) { float* d = DT + (size_t)row * 16 + (c0 - PC_DT); *(f32x4*)d = v0; *(f32x4*)(d + 4) = v1; }
                }
            }
    }
};
struct EpiSwiGLUI8 {
    static constexpr bool PERM = true, AFTER_DRAIN = false;
    unsigned char* O; const float* rsc; const float* wsc;
    __device__ __forceinline__ void operator()(const v4i32 (&acc)[2][2][4][2], const Unit& u, int wr, int wc, int fr, int fq) const {
        const int row0 = u.po * BM + wr * 64 + fr, arow0 = u.pm * BM + wr * 64 + fr, col0 = u.pc * HALF + wc * 32 + 8 * fq;
        const float* wq = wsc + (size_t)u.pn * BM + wc * 32 + 8 * fq; asm volatile("" : "+v"(wq));
        const f32x4 wg0 = *(const f32x4*)wq, wg1 = *(const f32x4*)(wq + 4), wu0 = *(const f32x4*)(wq + HALF), wu1 = *(const f32x4*)(wq + HALF + 4);
        float sav[2][4];
#pragma unroll
        for (int ai = 0; ai < 2; ++ai)
#pragma unroll
            for (int m = 0; m < 4; ++m) sav[ai][m] = rsc[arow0 + ai * HALF + m * 16];
#pragma unroll
        for (int ai = 0; ai < 2; ++ai)
#pragma unroll
            for (int m = 0; m < 4; ++m) {
                const float sa = sav[ai][m];
                const v4i32 g0 = acc[ai][0][m][0], g1 = acc[ai][0][m][1], u0 = acc[ai][1][m][0], u1 = acc[ai][1][m][1];
                float r[8];
#pragma unroll
                for (int j = 0; j < 4; ++j) { r[j] = __builtin_amdgcn_fmed3f(silu_f((float)g0[j] * (sa * wg0[j])) * ((float)u0[j] * (sa * wu0[j])), -448.f, 448.f);
                    r[4 + j] = __builtin_amdgcn_fmed3f(silu_f((float)g1[j] * (sa * wg1[j])) * ((float)u1[j] * (sa * wu1[j])), -448.f, 448.f); }
                int w0 = 0, w1 = 0;
                w0 = __builtin_amdgcn_cvt_pk_fp8_f32(r[0], r[1], w0, false); w0 = __builtin_amdgcn_cvt_pk_fp8_f32(r[2], r[3], w0, true);
                w1 = __builtin_amdgcn_cvt_pk_fp8_f32(r[4], r[5], w1, false); w1 = __builtin_amdgcn_cvt_pk_fp8_f32(r[6], r[7], w1, true);
                *(u32x2*)(O + (size_t)(row0 + ai * HALF + m * 16) * DFF + col0) = (u32x2){(unsigned)w0, (unsigned)w1};
            }
    }
};
struct EpiSwiGLU8 {
    static constexpr bool PERM = true, AFTER_DRAIN = false;
    unsigned char* O; float isc;
    __device__ __forceinline__ void operator()(const f32x4 (&acc)[2][2][4][2], const Unit& u, int wr, int wc, int fr, int fq) const {
        const int row0 = u.po * BM + wr * 64 + fr, col0 = u.pc * HALF + wc * 32 + 8 * fq;
#pragma unroll
        for (int ai = 0; ai < 2; ++ai)
#pragma unroll
            for (int m = 0; m < 4; ++m) {
                const f32x4 g0 = acc[ai][0][m][0], g1 = acc[ai][0][m][1], u0 = acc[ai][1][m][0], u1 = acc[ai][1][m][1];
                float r[8];
#pragma unroll
                for (int j = 0; j < 4; ++j) { r[j] = __builtin_amdgcn_fmed3f(silu_f(g0[j] * isc) * (u0[j] * isc), -448.f, 448.f); r[4 + j] = __builtin_amdgcn_fmed3f(silu_f(g1[j] * isc) * (u1[j] * isc), -448.f, 448.f); }
                int w0 = 0, w1 = 0;
                w0 = __builtin_amdgcn_cvt_pk_fp8_f32(r[0], r[1], w0, false); w0 = __builtin_amdgcn_cvt_pk_fp8_f32(r[2], r[3], w0, true);
                w1 = __builtin_amdgcn_cvt_pk_fp8_f32(r[4], r[5], w1, false); w1 = __builtin_amdgcn_cvt_pk_fp8_f32(r[6], r[7], w1, true);
                *(u32x2*)(O + (size_t)(row0 + ai * HALF + m * 16) * DFF + col0) = (u32x2){(unsigned)w0, (unsigned)w1};
            }
    }
};
struct EpiSwiGLU {
    static constexpr bool PERM = true, AFTER_DRAIN = false;
    bf16_t* O;
    __device__ __forceinline__ void operator()(const f32x4 (&acc)[2][2][4][2], const Unit& u, int wr, int wc, int fr, int fq) const {
        const int row0 = u.po * BM + wr * 64 + fr, col0 = u.pc * HALF + wc * 32 + 8 * fq;
#pragma unroll
        for (int ai = 0; ai < 2; ++ai)
#pragma unroll
            for (int m = 0; m < 4; ++m) {
                const f32x4 g0 = acc[ai][0][m][0], g1 = acc[ai][0][m][1], u0 = acc[ai][1][m][0], u1 = acc[ai][1][m][1];
                float r[8];
#pragma unroll
                for (int j = 0; j < 4; ++j) { r[j] = silu_f(g0[j]) * u0[j]; r[4 + j] = silu_f(g1[j]) * u1[j]; }
                u32x4 w; w.x = pk_bf16(r[0], r[1]); w.y = pk_bf16(r[2], r[3]); w.z = pk_bf16(r[4], r[5]); w.w = pk_bf16(r[6], r[7]);
                *(u32x4*)(O + (size_t)(row0 + ai * HALF + m * 16) * DFF + col0) = w;
            }
    }
};


template <class Epi, class Sched, int MODE = 0, bool STAMP = false>
__device__ __forceinline__ void gemm_phase(PG8_LAS unsigned char* lds, const Gemm g, const Sched& S, const Epi& E, unsigned long long* stamps) {
    int tid_ = threadIdx.x; asm volatile("" : "+v"(tid_));
    const int tid = tid_, wid = __builtin_amdgcn_readfirstlane(tid >> 6), lane = tid & 63, wr = wid >> 2, wc = wid & 3, fr = lane & 15, fq = lane >> 4;
    const int K = g.K, nt = K / BK;
    int ts_lo = 0, ts_hi = 0, nts = 0; const unsigned long long rt_entry = STAMP ? (unsigned long long)wall_clock64() : 0ull;
#define PG8_STAMP() do { if (STAMP && wid == 0 && nts < 64) { const unsigned long long _c = (unsigned long long)clock64(); \
        ts_lo = (lane == nts) ? (int)(unsigned)_c : ts_lo; ts_hi = (lane == nts) ? (int)(unsigned)(_c >> 32) : ts_hi; ++nts; } } while (0)
    PG8_STAMP();
    unsigned voffA[2], voffB[2];
#pragma unroll
    for (int i = 0; i < 2; ++i) { int R, C; stage_rc(tid * 16 + i * 8192, R, C); const int Rb = Epi::PERM ? ((R & ~31) + perm32(R & 31)) : R;
        voffA[i] = (unsigned)(R * K + C) * 2u; voffB[i] = (unsigned)(Rb * K + C) * 2u; }
    const size_t kstep = (size_t)(BK * 2);
    const size_t hstep = (size_t)HALF * K * 2;
    const size_t tstep = 2 * hstep;
    const unsigned ldsw = (unsigned)wid * 1024u;
    const int aoff = lds_byte(wr * 64 + fr, fq * 8), boff = lds_byte(wc * 32 + fr, fq * 8);
#define PG8_SA(b, h) (((b) * 2 + (h)) * HTB)
#define PG8_SB(b, h) ((4 + (b) * 2 + (h)) * HTB)
#define PG8_STAGE(bufoff, gbase, voff) do { _Pragma("unroll") for (int _i = 0; _i < 2; ++_i) \
        __builtin_amdgcn_global_load_lds((const unsigned*)((const char*)(gbase) + (voff)[_i]), (PG8_LAS unsigned*)(lds + (bufoff) + ldsw + _i * 8192), 16, 0, 0); } while (0)
#define PG8_LD8(p_) __builtin_shufflevector(*(const PG8_LAS v4i32*)(p_), *(const PG8_LAS v4i32*)((p_) + 1024), 0, 1, 2, 3, 4, 5, 6, 7)
#define PG8_LDA(dst, b, h) do { _Pragma("unroll") for (int m = 0; m < 4; ++m) dst[m] = PG8_LD8(lds + PG8_SA(b, h) + aoff + m * 2048); } while (0)
#define PG8_LDB(dst, b, h) do { _Pragma("unroll") for (int n = 0; n < 2; ++n) dst[n] = PG8_LD8(lds + PG8_SB(b, h) + boff + n * 2048); } while (0)
#define PG8_HALF(v_, k_) __builtin_bit_cast(bf16x8, __builtin_shufflevector(v_, v_, 4 * (k_), 4 * (k_) + 1, 4 * (k_) + 2, 4 * (k_) + 3))
#define PG8_HALFI(v_, k_) __builtin_shufflevector(v_, v_, 4 * (k_), 4 * (k_) + 1, 4 * (k_) + 2, 4 * (k_) + 3)
#define PG8_MMA(ai, bj, At, Bt) do { __builtin_amdgcn_s_setprio(1); \
        if constexpr (MODE == 1) { _Pragma("unroll") for (int m = 0; m < 4; ++m) _Pragma("unroll") for (int n = 0; n < 2; ++n) \
            asm volatile("v_mfma_f32_16x16x128_f8f6f4 %0, %1, %2, %0" : "+v"(acc[ai][bj][m][n]) : "v"(Bt[n]), "v"(At[m])); } \
        else if constexpr (MODE == 2) {   \
            _Pragma("unroll") for (int m = 0; m < 4; ++m) _Pragma("unroll") for (int n = 0; n < 2; ++n) \
                asm volatile("v_mfma_i32_16x16x64_i8 %0, %1, %2, %0" : "+v"(acc[ai][bj][m][n]) : "v"(PG8_HALFI(Bt[n], 0)), "v"(PG8_HALFI(At[m], 0))); \
            _Pragma("unroll") for (int m = 0; m < 4; ++m) _Pragma("unroll") for (int n = 0; n < 2; ++n) \
                asm volatile("v_mfma_i32_16x16x64_i8 %0, %1, %2, %0" : "+v"(acc[ai][bj][m][n]) : "v"(PG8_HALFI(Bt[n], 1)), "v"(PG8_HALFI(At[m], 1))); } \
        else { _Pragma("unroll") for (int m = 0; m < 4; ++m) _Pragma("unroll") for (int n = 0; n < 2; ++n) { \
            acc[ai][bj][m][n] = __builtin_amdgcn_mfma_f32_16x16x32_bf16(PG8_HALF(Bt[n], 0), PG8_HALF(At[m], 0), acc[ai][bj][m][n], 0, 0, 0); \
            acc[ai][bj][m][n] = __builtin_amdgcn_mfma_f32_16x16x32_bf16(PG8_HALF(Bt[n], 1), PG8_HALF(At[m], 1), acc[ai][bj][m][n], 0, 0, 0); } } \
        __builtin_amdgcn_s_setprio(0); } while (0)
#define PG8_WAIT_V(n) asm volatile("s_waitcnt vmcnt(" #n ")" ::: "memory")
#define PG8_WAIT_L(n) asm volatile("s_waitcnt lgkmcnt(" #n ")" ::: "memory")
#define PG8_BAR __builtin_amdgcn_s_barrier()
#define PG8_SCHED __builtin_amdgcn_sched_barrier(0)
    Unit cur, nxt; int ui = 0;
    if (!S.next(0, cur)) return;
    typename AccSel<MODE == 2>::T acc[2][2][4][2];
#pragma unroll
    for (int a = 0; a < 2; ++a)
#pragma unroll
        for (int b = 0; b < 2; ++b)
#pragma unroll
            for (int m = 0; m < 4; ++m)
#pragma unroll
                for (int n = 0; n < 2; ++n) acc[a][b][m][n] = typename AccSel<MODE == 2>::T{};
    v8i32 At[4], B0[2], B1[2];
    const char* cA = (const char*)g.A + (size_t)cur.pm * tstep; const char* cB = (const char*)g.Bt + (size_t)cur.pn * tstep;
    S.a_ready(cur);
    PG8_STAGE(PG8_SB(0, 0), cB, voffB); PG8_STAGE(PG8_SA(0, 0), cA, voffA); PG8_STAGE(PG8_SB(0, 1), cB + hstep, voffB); PG8_STAGE(PG8_SA(0, 1), cA + hstep, voffA);
    if (wr == 1) PG8_BAR;
    PG8_WAIT_V(4); PG8_BAR;
    PG8_STAGE(PG8_SB(1, 0), cB + kstep, voffB); PG8_STAGE(PG8_SA(1, 0), cA + kstep, voffA); PG8_STAGE(PG8_SB(1, 1), cB + hstep + kstep, voffB);
    PG8_WAIT_V(6); PG8_BAR;
    PG8_STAMP();
    for (;;) {
        const bool has_next = S.next(ui + 1, nxt);
        const char* nA = has_next ? (const char*)g.A + (size_t)nxt.pm * tstep : cA; const char* nB = has_next ? (const char*)g.Bt + (size_t)nxt.pn * tstep : cB;
        for (int t = 0; t < nt; t += 2) {
            const bool last = (t == nt - 2);
            const char* a1 = cA + (size_t)(t + 1) * kstep;
            const char* a2 = last ? nA : cA + (size_t)(t + 2) * kstep; const char* b2 = last ? nB : cB + (size_t)(t + 2) * kstep;
            const char* a3 = a2 + kstep; const char* b3 = b2 + kstep;
            if (last && has_next) S.a_ready(nxt);
            PG8_LDB(B0, 0, 0); PG8_SCHED; PG8_LDA(At, 0, 0); PG8_STAGE(PG8_SA(1, 1), a1 + hstep, voffA);
            PG8_WAIT_L(8); PG8_BAR; PG8_WAIT_L(0); PG8_MMA(0, 0, At, B0); PG8_BAR; PG8_SCHED;
            PG8_LDB(B1, 0, 1); PG8_STAGE(PG8_SB(0, 0), b2, voffB);
            PG8_BAR; PG8_WAIT_L(0); PG8_MMA(0, 1, At, B1); PG8_BAR;
            PG8_LDA(At, 0, 1); PG8_STAGE(PG8_SA(0, 0), a2, voffA);
            PG8_BAR; PG8_WAIT_L(0); PG8_MMA(1, 0, At, B0); PG8_BAR; PG8_SCHED;
            PG8_STAGE(PG8_SB(0, 1), b2 + hstep, voffB);
            PG8_WAIT_V(6); PG8_BAR; PG8_MMA(1, 1, At, B1); PG8_BAR;
            PG8_LDB(B0, 1, 0); PG8_SCHED; PG8_LDA(At, 1, 0); PG8_STAGE(PG8_SA(0, 1), a2 + hstep, voffA);
            PG8_WAIT_L(8); PG8_BAR; PG8_WAIT_L(0); PG8_MMA(0, 0, At, B0); PG8_BAR; PG8_SCHED;
            PG8_LDB(B1, 1, 1); PG8_STAGE(PG8_SB(1, 0), b3, voffB);
            PG8_BAR; PG8_WAIT_L(0); PG8_MMA(0, 1, At, B1); PG8_BAR;
            PG8_LDA(At, 1, 1); PG8_STAGE(PG8_SA(1, 0), a3, voffA);
            PG8_BAR; PG8_WAIT_L(0); PG8_MMA(1, 0, At, B0); PG8_BAR; PG8_SCHED;
            PG8_STAGE(PG8_SB(1, 1), b3 + hstep, voffB);
            PG8_WAIT_V(6); PG8_BAR; PG8_MMA(1, 1, At, B1); PG8_BAR;
        }
        PG8_STAMP();
        asm volatile("s_nop 15\n\ts_nop 15" ::: "memory");
        if constexpr (!Epi::AFTER_DRAIN) { E(acc, cur, wr, wc, fr, fq); S.done(cur); }
        PG8_STAMP();
        if (!has_next) break;
#pragma unroll
        for (int a = 0; a < 2; ++a)
#pragma unroll
            for (int b = 0; b < 2; ++b)
#pragma unroll
                for (int m = 0; m < 4; ++m)
#pragma unroll
                    for (int n = 0; n < 2; ++n) acc[a][b][m][n] = typename AccSel<MODE == 2>::T{};
        cur = nxt; cA = nA; cB = nB; ++ui;
    }
    PG8_WAIT_V(0);
    if (wr == 0) PG8_BAR;
    PG8_BAR;
    if constexpr (Epi::AFTER_DRAIN) { E.fused(acc, cur, wr, wc, fr, fq, lds, wid, lane); S.done(cur); }
    PG8_STAMP();
    if (STAMP && wid == 0) { stamps[lane] = lane < nts ? (((unsigned long long)(unsigned)ts_hi << 32) | (unsigned)ts_lo) : 0ull;
        if (lane == 62) stamps[62] = rt_entry; if (lane == 63) stamps[63] = (unsigned long long)wall_clock64(); }
#undef PG8_STAMP
#undef PG8_SA
#undef PG8_SB
#undef PG8_STAGE
#undef PG8_LDA
#undef PG8_LDB
#undef PG8_LD8
#undef PG8_HALF
#undef PG8_HALFI
#undef PG8_MMA
#undef PG8_WAIT_V
#undef PG8_WAIT_L
#undef PG8_BAR
#undef PG8_SCHED
}
}

typedef const __attribute__((address_space(4))) Args* KArgs;
struct Frame {
    LAS unsigned char* lds; int tid, lane, wave, G, bid;
    KArgs ka;
};
#define PH_ARGS() int z_ = 0; asm volatile("" : "+v"(z_)); KArgs A_ = (KArgs)((const __attribute__((address_space(4))) char*)F.ka + __builtin_amdgcn_readfirstlane(z_)); unsigned char* const ws_ = A_->ws; (void)ws_
#define WSP(T_, off) ((T_*)(ws_ + (off)))

__device__ __forceinline__ int ropeperm64(int s) { const int j = s >> 3, i = s & 7; return i < 4 ? 4 * j + i : 32 + 4 * j + (i - 4); }
__device__ __forceinline__ int ropeperm32(int s) { const int j = s >> 3, i = s & 7; return i < 4 ? 4 * j + i : 16 + 4 * j + (i - 4); }
__device__ __forceinline__ int inproj_src(int n) {
    if (n < 384) return (n & ~63) + ropeperm64(n & 63);
    if (n < 512) return 384 + ((n - 384) & ~63) + ropeperm64((n - 384) & 63);
    if (n < 1920) return n;
    if (n < 2176) { const int m = n - 1920; return 1932 + (m & ~31) + ropeperm32(m & 31); }
    if (n < 2432) { const int m = n - 2176; return 2188 + (m & ~31) + ropeperm32(m & 31); }
    if (n < 2688) return 2444 + (n - 2432);
    if (n < 2700) return 1920 + (n - 2688);
    return -1;
}
__device__ __forceinline__ int gu_src(int n) { const int tile = n >> 8, r = n & 255; return r < 128 ? tile * 128 + r : DFF + tile * 128 + (r - 128); }

constexpr int CV_T0 = DEPTH * 44 * 16;
constexpr int CV_T1 = CV_T0 + DEPTH * 16 * 16;
constexpr int CV_T2 = CV_T1 + 2 * 88 * 16;
constexpr int CV_T3 = CV_T2 + 2 * 16 * 44;
constexpr int CV_T4 = CV_T3 + 16 * 88 * 16;
constexpr int CV_T5 = CV_T4 + 16 * 16 * 44;
constexpr int PA_MODJOBS = DEPTH * 96;
constexpr int PA_JOBS = CV_T5 + PA_MODJOBS + 1;

constexpr int CJ_TOTAL = 2 * (768 + 4464);
struct ConvTile { const float* src; unsigned char* dst; int Nsrc, K, esz; bool zero, skip; };
__device__ __forceinline__ void conv_desc(const Frame& F, KArgs A_, unsigned char* ws_, int job, ConvTile& t) {
    const float* W; bf16_t* dst; int Nsrc, K, kind, rt, kt, esz = 2; bool skip = false;
    const int half = job / 5232, li0 = 2 * half; int j = job - half * 5232;
    if (j < 768) {
        const int li = li0, jd = half;
        if (j < 176) { W = A_->in[I_WIN] + (size_t)li * D * D_IN; Nsrc = D_IN; dst = WSP(bf16_t, WS_WIN) + (size_t)li * LDP * D; K = D; kind = 0; rt = j % 11; kt = j / 11; skip = true; }
        else if (j < 240) { const int r = j - 176; W = A_->in[I_WOUT] + (size_t)li * D * D; Nsrc = D; dst = WSP(bf16_t, WS_WOUT) + (size_t)li * D * D; K = D; kind = 1; rt = r % 4; kt = r / 4; }
        else if (j < 592) { const int r = j - 240; W = A_->in[I_FFNGU] + (size_t)jd * D * 2 * DFF; Nsrc = 2 * DFF; dst = WSP(bf16_t, WS_WGU) + (size_t)jd * 2 * DFF * D; K = D; kind = 2; rt = r % 22; kt = r / 22; skip = true; }
        else { const int r = j - 592; W = A_->in[I_FFND] + (size_t)jd * DFF * D; Nsrc = D; dst = WSP(bf16_t, WS_WD) + (size_t)jd * D * DFF; K = DFF; kind = 1; rt = r % 4; kt = r / 4; esz = 1; }
    } else {
        const int li = li0 + 1, jm = half; j -= 768;
        if (j < 176) { W = A_->in[I_WIN] + (size_t)li * D * D_IN; Nsrc = D_IN; dst = WSP(bf16_t, WS_WIN) + (size_t)li * LDP * D; K = D; kind = 0; rt = j % 11; kt = j / 11; skip = true; }
        else if (j < 240) { const int r = j - 176; W = A_->in[I_WOUT] + (size_t)li * D * D; Nsrc = D; dst = WSP(bf16_t, WS_WOUT) + (size_t)li * D * D; K = D; kind = 1; rt = r % 4; kt = r / 4; }
        else if (j < 240 + 8 * 352) { const int q = j - 240, e = q / 352, m = jm * 8 + e, r = q % 352; W = A_->in[I_EGU] + (size_t)m * D * 2 * DFF; Nsrc = 2 * DFF; dst = WSP(bf16_t, WS_WGUE) + (size_t)jm * 8 * 2 * DFF * D + (size_t)e * DFF * D; K = D; kind = 2; rt = r % 22; kt = r / 22; esz = 1; skip = true; }
        else { const int q = j - 240 - 8 * 352, e = q / 176, m = jm * 8 + e, r = q % 176; W = A_->in[I_ED] + (size_t)m * DFF * D; Nsrc = D; dst = WSP(bf16_t, WS_WDE) + (size_t)jm * 8 * D * DFF + (size_t)e * (D * DFF / 2); K = DFF; kind = 1; rt = r % 4; kt = r / 4; esz = 1; }
    }
    const int nd = rt * 256 + (F.tid & 255);
    const int sc = kind == 0 ? inproj_src(nd) : (kind == 2 ? gu_src(nd) : nd);
    t.src = W + (size_t)(kt * 64 + (F.tid >> 8)) * Nsrc + (sc >= 0 ? sc : 0);
    t.dst = (unsigned char*)dst + ((size_t)(rt * 256 + (F.tid >> 3)) * K + kt * 64 + (F.tid & 7) * 8) * esz;
    t.Nsrc = Nsrc; t.K = K; t.esz = esz; t.zero = sc < 0; t.skip = skip;
}
__device__ __forceinline__ void conv_load(const ConvTile& t, float (&v)[32]) {
    if (t.skip) return;
#pragma unroll
    for (int i = 0; i < 32; ++i) v[i] = __builtin_nontemporal_load(t.src + (size_t)(2 * i) * t.Nsrc);
}
__device__ __forceinline__ void conv_finish(const Frame& F, const ConvTile& t, const float (&v)[32]) {
    if (t.skip) return;
    LAS float* tile = (LAS float*)F.lds;
    const int n = F.tid & 255, kk0 = F.tid >> 8;
#pragma unroll
    for (int i = 0; i < 32; ++i) tile[(kk0 + 2 * i) * 257 + n] = t.zero ? 0.f : v[i];
    __syncthreads();
    { const int nn = F.tid >> 3, kq = F.tid & 7;
#pragma unroll
      for (int i = 0; i < 4; ++i) { float o[8];
#pragma unroll
          for (int j = 0; j < 8; ++j) o[j] = tile[(kq * 8 + j) * 257 + nn + 64 * i];
          if (t.esz == 2) { u32x4 w; w.x = pk_bf16(o[0], o[1]); w.y = pk_bf16(o[2], o[3]); w.z = pk_bf16(o[4], o[5]); w.w = pk_bf16(o[6], o[7]);
              __builtin_nontemporal_store(w, (u32x4*)(t.dst + (size_t)(64 * i) * t.K * 2)); }
          else { int w0 = 0, w1 = 0;
              w0 = __builtin_amdgcn_cvt_pk_fp8_f32(o[0] * 64.f, o[1] * 64.f, w0, false); w0 = __builtin_amdgcn_cvt_pk_fp8_f32(o[2] * 64.f, o[3] * 64.f, w0, true);
              w1 = __builtin_amdgcn_cvt_pk_fp8_f32(o[4] * 64.f, o[5] * 64.f, w1, false); w1 = __builtin_amdgcn_cvt_pk_fp8_f32(o[6] * 64.f, o[7] * 64.f, w1, true);
              __builtin_nontemporal_store((u32x2){(unsigned)w0, (unsigned)w1}, (u32x2*)(t.dst + (size_t)(64 * i) * t.K)); } } }
    __syncthreads();
}

constexpr int SJ_PER_MAT = 44, SJ_GU = 18 * SJ_PER_MAT, SJ_TOTAL = SJ_GU + DEPTH * 22;
__device__ __forceinline__ void strip_job(const Frame& F, KArgs A_, unsigned char* ws_, int job) {
    const bool isin = job >= SJ_GU;
    const int m = isin ? (job - SJ_GU) / 22 : job / SJ_PER_MAT, st = isin ? (job - SJ_GU) % 22 : job % SJ_PER_MAT;
    const float* W = isin ? A_->in[I_WIN] + (size_t)m * D * D_IN : (m < 2 ? A_->in[I_FFNGU] + (size_t)m * D * 2 * DFF : A_->in[I_EGU] + (size_t)(m - 2) * D * 2 * DFF);
    const int Nsrc = isin ? D_IN : 2 * DFF;
    unsigned char* dst = isin ? WSP(unsigned char, WS_WIN) + (size_t)m * LDP * D * 2
                       : (m < 2 ? WSP(unsigned char, WS_WGU) + (size_t)m * 2 * DFF * D * 2
                                : WSP(unsigned char, WS_WGUE) + (size_t)((m - 2) >> 3) * 8 * 2 * DFF * D * 2 + (size_t)((m - 2) & 7) * 2 * DFF * D);
    float* wsc = isin ? WSP(float, WS_WSC) + (size_t)18 * 2 * DFF + (size_t)m * LDP : WSP(float, WS_WSC) + (size_t)m * 2 * DFF;
    LAS float* pmx = (LAS float*)F.lds;
    const int cg = F.tid & 31, kq = F.tid >> 5;
    const int nd = st * 128 + 4 * cg, sc0 = isin ? inproj_src(nd) : gu_src(nd), sc = sc0 < 0 ? 0 : sc0;
    const float* wp = W + (size_t)(64 * kq) * Nsrc + sc;
    unsigned pk[4][32];
    float mx[4] = {0.f, 0.f, 0.f, 0.f};
#pragma unroll
    for (int i0 = 0; i0 < 64; i0 += 16) { f32x4 v[16];
#pragma unroll
        for (int i = 0; i < 16; ++i) { v[i] = __builtin_nontemporal_load((const f32x4*)(wp + (size_t)(i0 + i) * Nsrc)); if (sc0 < 0) v[i] = (f32x4){0.f, 0.f, 0.f, 0.f}; }
#pragma unroll
        for (int i = 0; i < 16; i += 2)
#pragma unroll
            for (int c = 0; c < 4; ++c) { mx[c] = fmaxf(mx[c], fmaxf(fabsf(v[i][c]), fabsf(v[i + 1][c]))); pk[c][(i0 + i) >> 1] = pk_bf16(v[i][c], v[i + 1][c]); } }
    __syncthreads();
#pragma unroll
    for (int c = 0; c < 4; ++c) pmx[kq * 128 + 4 * cg + c] = mx[c];
    __syncthreads();
    if (F.tid < 128) { float a = pmx[F.tid];
#pragma unroll
        for (int q = 1; q < 16; ++q) a = fmaxf(a, pmx[q * 128 + F.tid]);
        const float scl = a > 0.f ? a * (1.0f / 127.0f) : 1.0f;
        wsc[st * 128 + F.tid] = scl; pmx[2048 + F.tid] = 1.0f / scl; }
    __syncthreads();
#pragma unroll
    for (int c = 0; c < 4; ++c) { const float inv = pmx[2048 + 4 * cg + c];
        unsigned char* dp = dst + (size_t)(nd + c) * D + 64 * kq;
#pragma unroll
        for (int j = 0; j < 4; ++j) { unsigned o[4];
#pragma unroll
            for (int q = 0; q < 4; ++q) { const unsigned a = pk[c][8 * j + 2 * q], bq = pk[c][8 * j + 2 * q + 1];
                const int q0 = (int)rintf(__uint_as_float(a << 16) * inv), q1 = (int)rintf(__uint_as_float(a & 0xffff0000u) * inv), q2 = (int)rintf(__uint_as_float(bq << 16) * inv), q3 = (int)rintf(__uint_as_float(bq & 0xffff0000u) * inv);
                o[q] = (unsigned)(q0 & 0xff) | ((unsigned)(q1 & 0xff) << 8) | ((unsigned)(q2 & 0xff) << 16) | ((unsigned)(q3 & 0xff) << 24); }
            *(u32x4*)(dp + 16 * j) = (u32x4){o[0], o[1], o[2], o[3]}; } }
}

__device__ __forceinline__ void phase_pre_a(const Frame& F) {
    PH_ARGS();
    { ConvTile t0, t1; float v0[32], v1[32];
      int j = F.bid;
      if (j < CJ_TOTAL) { conv_desc(F, A_, ws_, j, t0); conv_load(t0, v0); }
      while (j < CJ_TOTAL) {
          const int jn = j + F.G;
          if (jn < CJ_TOTAL) { conv_desc(F, A_, ws_, jn, t1); conv_load(t1, v1); }
          conv_finish(F, t0, v0);
          t0 = t1;
#pragma unroll
          for (int i = 0; i < 32; ++i) v0[i] = v1[i];
          j = jn;
      } }
    for (int j = F.bid; j < SJ_TOTAL; j += F.G) strip_job(F, A_, ws_, j);
    __syncthreads();
    for (int job = CV_T5 + F.bid; job < PA_JOBS; job += F.G) {
        if (job < CV_T5) {
        } else if (job < CV_T5 + PA_MODJOBS) {

            const int q = job - CV_T5, li = q / 96, cb = q % 96;
            LAS float* act = (LAS float*)F.lds;
            LAS float* part = act + 9 * 1024;
            for (int i = F.tid; i < 9 * 1024; i += 512) { const int r = i >> 10, k = i & 1023; const float cv = r < 8 ? A_->in[I_C][r * 1024 + k] : A_->in[I_CCTX][k]; act[i] = cv / (1.0f + expf(-cv)); }
            __syncthreads();
            float acc[9];
#pragma unroll
            for (int r = 0; r < 9; ++r) acc[r] = 0.f;
            const float* wp = A_->in[I_WADA] + (size_t)li * D * 6144 + cb * 64 + F.lane;
            for (int k0 = F.wave * 128; k0 < F.wave * 128 + 128; k0 += 16) { float wv[16];
#pragma unroll
                for (int u = 0; u < 16; ++u) wv[u] = wp[(size_t)(k0 + u) * 6144];
#pragma unroll
                for (int u = 0; u < 16; ++u)
#pragma unroll
                    for (int r = 0; r < 9; ++r) acc[r] += act[r * 1024 + k0 + u] * wv[u]; }
#pragma unroll
            for (int r = 0; r < 9; ++r) part[(F.wave * 9 + r) * 64 + F.lane] = acc[r];
            __syncthreads();
            for (int i = F.tid; i < 9 * 64; i += 512) { const int r = i >> 6, l = i & 63; float s = A_->in[I_BADA][li * 6144 + cb * 64 + l];
#pragma unroll
                for (int w = 0; w < 8; ++w) s += part[(w * 9 + r) * 64 + l];
                WSP(float, WS_MOD)[(size_t)(li * 9 + r) * 6144 + cb * 64 + l] = s; }
            __syncthreads();
        } else {
            float* cA = WSP(float, WS_ROPE); float* sA = cA + 2048 * 32; float* cC = sA + 2048 * 32; float* sC = cC + 2048 * 16;
            for (int idx = F.tid; idx < 2048 * 48; idx += 512) {
                const int pos = idx / 48, p = idx % 48; const float rowf = (float)(pos >> 6), colf = (float)(pos & 63);
                if (p < 32) { const int i = p & 15; const float inv = exp2f(-(float)i * (13.287712379549449f / 16.0f)); const float ang = (p < 16 ? rowf : colf) * inv; cA[pos * 32 + p] = __cosf(ang); sA[pos * 32 + p] = __sinf(ang); }
                else { const int pp = p - 32, i = pp & 7; const float inv = exp2f(-(float)i * (13.287712379549449f / 8.0f)); const float ang = (pp < 8 ? rowf : colf) * inv; cC[pos * 16 + pp] = __cosf(ang); sC[pos * 16 + pp] = __sinf(ang); }
            }
        }
    }
}

__device__ __forceinline__ void row_load(float (&v)[16], const float* p, int lane) {
#pragma unroll
    for (int i = 0; i < 2; ++i) { const f32x4 x = *(const f32x4*)(p + 512 * i + 8 * lane), y = *(const f32x4*)(p + 512 * i + 8 * lane + 4);
        v[8 * i] = x[0]; v[8 * i + 1] = x[1]; v[8 * i + 2] = x[2]; v[8 * i + 3] = x[3]; v[8 * i + 4] = y[0]; v[8 * i + 5] = y[1]; v[8 * i + 6] = y[2]; v[8 * i + 7] = y[3]; }
}
__device__ __forceinline__ void row_load_bf16(float (&v)[16], const bf16_t* p, int lane) {
#pragma unroll
    for (int i = 0; i < 2; ++i) { const u32x4 x = *(const u32x4*)(p + 512 * i + 8 * lane);
        v[8 * i] = __uint_as_float(x.x << 16); v[8 * i + 1] = __uint_as_float(x.x & 0xffff0000u); v[8 * i + 2] = __uint_as_float(x.y << 16); v[8 * i + 3] = __uint_as_float(x.y & 0xffff0000u);
        v[8 * i + 4] = __uint_as_float(x.z << 16); v[8 * i + 5] = __uint_as_float(x.z & 0xffff0000u); v[8 * i + 6] = __uint_as_float(x.w << 16); v[8 * i + 7] = __uint_as_float(x.w & 0xffff0000u); }
}
__device__ __forceinline__ void row_store(const float (&v)[16], float* p, int lane) {
#pragma unroll
    for (int i = 0; i < 2; ++i) { *(f32x4*)(p + 512 * i + 8 * lane) = (f32x4){v[8 * i], v[8 * i + 1], v[8 * i + 2], v[8 * i + 3]}; *(f32x4*)(p + 512 * i + 8 * lane + 4) = (f32x4){v[8 * i + 4], v[8 * i + 5], v[8 * i + 6], v[8 * i + 7]}; }
}
__device__ __forceinline__ void row_store_bf16(const float (&v)[16], bf16_t* p, int lane) {
#pragma unroll
    for (int i = 0; i < 2; ++i) { u32x4 w; w.x = pk_bf16(v[8 * i], v[8 * i + 1]); w.y = pk_bf16(v[8 * i + 2], v[8 * i + 3]); w.z = pk_bf16(v[8 * i + 4], v[8 * i + 5]); w.w = pk_bf16(v[8 * i + 6], v[8 * i + 7]); *(u32x4*)(p + 512 * i + 8 * lane) = w; }
}
__device__ __forceinline__ void row_store_fp8(const float (&v)[16], unsigned char* p, int lane) {
#pragma unroll
    for (int i = 0; i < 2; ++i) { int w0 = 0, w1 = 0; float c[8];
#pragma unroll
        for (int j = 0; j < 8; ++j) c[j] = __builtin_amdgcn_fmed3f(v[8 * i + j], -448.f, 448.f);
        w0 = __builtin_amdgcn_cvt_pk_fp8_f32(c[0], c[1], w0, false); w0 = __builtin_amdgcn_cvt_pk_fp8_f32(c[2], c[3], w0, true);
        w1 = __builtin_amdgcn_cvt_pk_fp8_f32(c[4], c[5], w1, false); w1 = __builtin_amdgcn_cvt_pk_fp8_f32(c[6], c[7], w1, true);
        *(u32x2*)(p + 512 * i + 8 * lane) = (u32x2){(unsigned)w0, (unsigned)w1}; }
}
__device__ __forceinline__ float row_store_i8(const float (&v)[16], unsigned char* p, int lane) {
    float a = 0.f;
#pragma unroll
    for (int i = 0; i < 16; ++i) a = fmaxf(a, fabsf(v[i]));
#pragma unroll
    for (int o = 32; o >= 1; o >>= 1) a = fmaxf(a, __shfl_xor(a, o));
    const float scl = a > 0.f ? a * (1.0f / 127.0f) : 1.0f, inv = 1.0f / scl;
#pragma unroll
    for (int i = 0; i < 2; ++i) { unsigned w[2];
#pragma unroll
        for (int q = 0; q < 2; ++q) { const int q0 = (int)rintf(v[8 * i + 4 * q] * inv), q1 = (int)rintf(v[8 * i + 4 * q + 1] * inv), q2 = (int)rintf(v[8 * i + 4 * q + 2] * inv), q3 = (int)rintf(v[8 * i + 4 * q + 3] * inv);
            w[q] = (unsigned)(q0 & 0xff) | ((unsigned)(q1 & 0xff) << 8) | ((unsigned)(q2 & 0xff) << 16) | ((unsigned)(q3 & 0xff) << 24); }
        *(u32x2*)(p + 512 * i + 8 * lane) = (u32x2){w[0], w[1]}; }
    return scl;
}
__device__ __forceinline__ void row_ln(float (&v)[16]) {
    float s = 0.f;
#pragma unroll
    for (int i = 0; i < 16; ++i) s += v[i];
    const float mean = wave_sum(s) * (1.0f / 1024.0f);
    float q = 0.f;
#pragma unroll
    for (int i = 0; i < 16; ++i) { v[i] -= mean; q += v[i] * v[i]; }
    const float rstd = rsqrtf(wave_sum(q) * (1.0f / 1024.0f) + LN_EPS);
#pragma unroll
    for (int i = 0; i < 16; ++i) v[i] *= rstd;
}
__device__ __forceinline__ void row_modulate(const float (&v)[16], float (&h)[16], const float* shift, const float* scale, int lane) {
    float sh[16], sc[16]; row_load(sh, shift, lane); row_load(sc, scale, lane);
#pragma unroll
    for (int i = 0; i < 16; ++i) h[i] = v[i] * (1.0f + sc[i]) + sh[i];
}
__device__ __forceinline__ const float* mod_row(unsigned char* ws_, int li, int row) { const int b = row / TB, t = row - b * TB; return WSP(float, WS_MOD) + (size_t)(li * 9 + (t < NCTX ? 8 : b)) * 6144; }

__device__ __forceinline__ void phase_pre_b(const Frame& F) {
    PH_ARGS();
    const int stride = F.G * 8;
    int row = F.bid * 8 + F.wave;
    float cur[16], nxt[16];
#define PB_SRC(r_) ((r_) % TB < NCTX ? A_->in[I_CTX] + (size_t)(((r_) / TB) * NCTX + (r_) % TB) * D : A_->in[I_X] + (size_t)(((r_) / TB) * SEQ + ((r_) % TB - NCTX)) * D)
    if (row < T) row_load(cur, PB_SRC(row), F.lane);
    while (row < T) {
        const int nr = row + stride;
        if (nr < T) row_load(nxt, PB_SRC(nr), F.lane);
        float h[16]; row_store(cur, WSP(float, WS_X) + (size_t)row * D, F.lane);
        row_ln(cur); const float* md = mod_row(ws_, 0, row); row_modulate(cur, h, md, md + 1024, F.lane);
        { const float scl = row_store_i8(h, WSP(unsigned char, WS_H) + (size_t)row * D, F.lane); if (F.lane == 0) WSP(float, WS_RSC)[row] = scl; }
#pragma unroll
        for (int i = 0; i < 16; ++i) cur[i] = nxt[i];
        row = nr;
    }
#undef PB_SRC
}

__device__ __forceinline__ void phase_post_mixer(const Frame& F, int li) {
    PH_ARGS(); const bool moe = li & 1; const int jm = li >> 1;
    const bool skip_ctx = li == DEPTH - 1;
    LAS float* wr = (LAS float*)F.lds;
    if (moe) { for (int i = F.tid; i < 1024 * 8; i += 512) wr[(i & 7) * 1024 + (i >> 3)] = A_->in[I_RW][(size_t)jm * 8192 + i]; __syncthreads(); }
    unsigned* cnt = (unsigned*)(ws_ + WS_CTL + CTL_CNT_OFF);
    LAS unsigned* bcnt = (LAS unsigned*)(wr + 8192);
    LAS unsigned* rtab = bcnt + 16;
    LAS float* rwt = (LAS float*)(rtab + 8 * 16 * 4);
    if (moe) { if (F.tid < 16) bcnt[F.tid] = 0u; __syncthreads(); }
    const int stride = F.G * 8;
    int row = F.bid * 8 + F.wave, rix = 0;
    float v[16], o[16], vn[16], on[16];
#define PM_LIVE(r_) ((r_) < T && !(skip_ctx && (r_) % TB < NCTX))
    if (PM_LIVE(row)) { row_load(v, WSP(float, WS_X) + (size_t)row * D, F.lane); row_load_bf16(o, WSP(bf16_t, WS_O) + (size_t)row * D, F.lane); }
    while (row < T) {
        const int nr = row + stride;
        if (PM_LIVE(nr)) { row_load(vn, WSP(float, WS_X) + (size_t)nr * D, F.lane); row_load_bf16(on, WSP(bf16_t, WS_O) + (size_t)nr * D, F.lane); }
        if (PM_LIVE(row)) {
        const float* md = mod_row(ws_, li, row);
        float g[16], lg1[16], lb1[16];
        row_load(g, md + 2048, F.lane); row_load(lg1, A_->in[I_LN1G] + li * D, F.lane); row_load(lb1, A_->in[I_LN1B] + li * D, F.lane);
#pragma unroll
        for (int i = 0; i < 16; ++i) v[i] = ALPHA_RES * v[i] + g[i] * o[i];
        row_ln(v);
#pragma unroll
        for (int i = 0; i < 16; ++i) v[i] = v[i] * lg1[i] + lb1[i];
        row_store(v, WSP(float, WS_X) + (size_t)row * D, F.lane);
        row_ln(v);
        float h[16]; row_modulate(v, h, md + 3072, md + 4096, F.lane);
        if (!moe) { const float scl = row_store_i8(h, WSP(unsigned char, WS_H) + (size_t)row * D, F.lane); if (F.lane == 0) WSP(float, WS_RSC)[row] = scl; }
        else {
        float lg[8];
#pragma unroll
        for (int e = 0; e < 8; ++e) lg[e] = 0.f;
#pragma unroll
        for (int e = 0; e < 8; ++e)
#pragma unroll
            for (int i = 0; i < 2; ++i) { const f32x4 w0 = *(const LAS f32x4*)(wr + e * 1024 + 512 * i + 8 * F.lane), w1 = *(const LAS f32x4*)(wr + e * 1024 + 512 * i + 8 * F.lane + 4);
                lg[e] += (h[8 * i] * w0[0] + h[8 * i + 1] * w0[1]) + (h[8 * i + 2] * w0[2] + h[8 * i + 3] * w0[3]) + (h[8 * i + 4] * w1[0] + h[8 * i + 5] * w1[1]) + (h[8 * i + 6] * w1[2] + h[8 * i + 7] * w1[3]); }
#pragma unroll
        for (int e = 0; e < 8; ++e) lg[e] = wave_sum(lg[e]) + A_->in[I_RB][jm * 8 + e];
        int e1 = 0; float v1 = lg[0];
#pragma unroll
        for (int e = 1; e < 8; ++e) if (lg[e] > v1) { v1 = lg[e]; e1 = e; }
        int e2 = -1; float v2 = -3.0e38f;
#pragma unroll
        for (int e = 0; e < 8; ++e) if (e != e1 && lg[e] > v2) { v2 = lg[e]; e2 = e; }
        if (e2 < 0) { e2 = e1 == 0 ? 1 : 0; v2 = v1; }
        const float w2 = 1.0f / (1.0f + expf(v1 - v2)), w1 = 1.0f - w2;
        { const float scl = row_store_i8(h, WSP(unsigned char, WS_H) + (size_t)row * D, F.lane); if (F.lane == 0) WSP(float, WS_RSC)[row] = scl; }
        if (F.lane == 0) { const unsigned q1 = atomicAdd((unsigned*)(bcnt + e1), 1u), q2 = atomicAdd((unsigned*)(bcnt + e2), 1u);
            LAS unsigned* te = rtab + (F.wave * 16 + rix) * 4; te[0] = e1; te[1] = q1; te[2] = e2; te[3] = q2; rwt[(F.wave * 16 + rix) * 2] = w1; rwt[(F.wave * 16 + rix) * 2 + 1] = w2; }
        }
        }
        ++rix;
#pragma unroll
        for (int i = 0; i < 16; ++i) { v[i] = vn[i]; o[i] = on[i]; }
        row = nr;
    }
    if (moe) {
        __syncthreads();
        if (F.tid < 8) bcnt[8 + F.tid] = atomicAdd(&cnt[(jm * 8 + F.tid) * 64], bcnt[F.tid]);
        asm volatile("s_waitcnt vmcnt(0)" ::: "memory");
        __syncthreads();
        int r2 = F.bid * 8 + F.wave;
        for (int i = 0; i < rix; ++i, r2 += stride) {
            if (!PM_LIVE(r2)) continue;
            const LAS unsigned* te = rtab + (F.wave * 16 + i) * 4;
            const unsigned e1 = te[0], p1 = bcnt[8 + e1] + te[1], e2 = te[2], p2 = bcnt[8 + e2] + te[3];
            const unsigned char* src = WSP(unsigned char, WS_H) + (size_t)r2 * D + 16 * F.lane;
            const u32x4 hv = *(const u32x4*)src;
            *(u32x4*)(WSP(unsigned char, WS_HP) + ((size_t)e1 * MOE_CAP + p1) * D + 16 * F.lane) = hv;
            *(u32x4*)(WSP(unsigned char, WS_HP) + ((size_t)e2 * MOE_CAP + p2) * D + 16 * F.lane) = hv;
            if (F.lane == 0) { const float scl = WSP(float, WS_RSC)[r2]; WSP(float, WS_HPS)[(size_t)e1 * MOE_CAP + p1] = scl; WSP(float, WS_HPS)[(size_t)e2 * MOE_CAP + p2] = scl; }
            if (F.lane == 0) { unsigned* tk = WSP(unsigned, WS_TOK) + (size_t)r2 * 8; tk[0] = e1; tk[1] = p1; tk[2] = e2; tk[3] = p2; tk[4] = __float_as_uint(rwt[(F.wave * 16 + i) * 2]); tk[5] = __float_as_uint(rwt[(F.wave * 16 + i) * 2 + 1]); }
        }
    }
#undef PM_LIVE
}

__device__ __forceinline__ void phase_post_ffn(const Frame& F, int li) {
    PH_ARGS(); const bool moe = li & 1; const int jm = li >> 1; const bool last = li == DEPTH - 1;
    int tb[8];
    if (moe) { const unsigned* cnt = (const unsigned*)(ws_ + WS_CTL + CTL_CNT_OFF); int acc = 0;
#pragma unroll
        for (int e = 0; e < 8; ++e) { tb[e] = acc; acc += ((int)cnt[(jm * 8 + e) * 64] + 255) >> 8; } }
    const int stride = F.G * 8;
    int row = F.bid * 8 + F.wave;
    float v[16], f[16], vn[16], fn[16];
#define PF_LIVE(r_) ((r_) < T && !(last && (r_) % TB < NCTX))
#define PF_LOAD(r_, v_, f_) do { row_load(v_, WSP(float, WS_X) + (size_t)(r_) * D, F.lane); \
        if (!moe) row_load_bf16(f_, WSP(bf16_t, WS_O) + (size_t)(r_) * D, F.lane); \
        else { const unsigned* tk = WSP(unsigned, WS_TOK) + (size_t)(r_) * 8; \
            const int e1 = tk[0], p1 = tk[1], e2 = tk[2], p2 = tk[3]; const float w1 = __uint_as_float(tk[4]), w2 = __uint_as_float(tk[5]); \
            int b1 = 0, b2 = 0; \
            _Pragma("unroll") for (int e = 0; e < 8; ++e) { b1 = e1 == e ? tb[e] : b1; b2 = e2 == e ? tb[e] : b2; } \
            float f2[16]; \
            row_load_bf16(f_, WSP(bf16_t, WS_HP) + ((size_t)b1 * 256 + p1) * D, F.lane); row_load_bf16(f2, WSP(bf16_t, WS_HP) + ((size_t)b2 * 256 + p2) * D, F.lane); \
            _Pragma("unroll") for (int i = 0; i < 16; ++i) f_[i] = w1 * f_[i] + w2 * f2[i]; } } while (0)
    if (PF_LIVE(row)) PF_LOAD(row, v, f);
    while (row < T) {
        const int nr = row + stride;
        if (PF_LIVE(nr)) PF_LOAD(nr, vn, fn);
        if (PF_LIVE(row)) {
        const int b = row / TB, t = row - b * TB;
        const float* md = mod_row(ws_, li, row);
        float g[16], lg2[16], lb2[16];
        row_load(g, md + 5120, F.lane); row_load(lg2, A_->in[I_LN2G] + li * D, F.lane); row_load(lb2, A_->in[I_LN2B] + li * D, F.lane);
#pragma unroll
        for (int i = 0; i < 16; ++i) v[i] = ALPHA_RES * v[i] + g[i] * f[i];
        row_ln(v);
#pragma unroll
        for (int i = 0; i < 16; ++i) v[i] = v[i] * lg2[i] + lb2[i];
        if (last) row_store(v, A_->out + (size_t)(b * SEQ + (t - NCTX)) * D, F.lane);
        else {
        row_store(v, WSP(float, WS_X) + (size_t)row * D, F.lane);
        row_ln(v);
        const float* mdn = mod_row(ws_, li + 1, row);
        float h[16]; row_modulate(v, h, mdn, mdn + 1024, F.lane);
        { const float scl = row_store_i8(h, WSP(unsigned char, WS_H) + (size_t)row * D, F.lane); if (F.lane == 0) WSP(float, WS_RSC)[row] = scl; }
        }
        }
#pragma unroll
        for (int i = 0; i < 16; ++i) { v[i] = vn[i]; f[i] = fn[i]; }
        row = nr;
    }
#undef PF_LIVE
#undef PF_LOAD
}

__device__ __forceinline__ bf16x8 lds_frag(const LAS bf16_t* base, int ld, int row0, int k0, int lane) {
    return *(const LAS bf16x8*)(base + (row0 + (lane & 15)) * ld + k0 + 8 * (lane >> 4));
}
#define MFMA16(a, b, c) __builtin_amdgcn_mfma_f32_16x16x32_bf16((a), (b), (c), 0, 0, 0)

constexpr int LDT = 136;


typedef float f32x16 __attribute__((ext_vector_type(16)));
#define MFMA32(a, b, c) __builtin_amdgcn_mfma_f32_32x32x16_bf16((a), (b), (c), 0, 0, 0)
constexpr int LD2 = 72;
constexpr int AT2_TILE = 64 * LD2;
constexpr float M_INIT = -10000.0f;

template <int NMAP> struct At2State { float m[NMAP], l[NMAP]; f32x16 O[NMAP][2]; };

template <int NMAP, int DQK, bool WINDOW>
__device__ __forceinline__ void at2_step(const LAS bf16_t* Kt, const LAS bf16_t* Vt, const bf16x8 (&qf)[NMAP][DQK / 16], At2State<NMAP>& st, float c2, bool on0, bool on1, int tq, int tk0, int lane) {
    const int r = lane & 31, h = lane >> 5;
    bf16x8 kf[NMAP][2][DQK / 16];
#pragma unroll
    for (int mp = 0; mp < NMAP; ++mp)
#pragma unroll
        for (int t2 = 0; t2 < 2; ++t2)
#pragma unroll
            for (int sx = 0; sx < DQK / 16; ++sx) kf[mp][t2][sx] = *(const LAS bf16x8*)(Kt + (32 * t2 + r) * LD2 + mp * DQK + 16 * sx + 8 * h);
    __builtin_amdgcn_sched_barrier(0);
    f32x16 s[NMAP][2];
#pragma unroll
    for (int mp = 0; mp < NMAP; ++mp)
#pragma unroll
        for (int t2 = 0; t2 < 2; ++t2) {
            f32x16 acc;
#pragma unroll
            for (int i = 0; i < 16; ++i) acc[i] = 0.f;
#pragma unroll
            for (int sx = 0; sx < DQK / 16; ++sx) acc = MFMA32(kf[mp][t2][sx], qf[mp][sx], acc);
            s[mp][t2] = acc;
        }
    bf16x8 vf[2][4];
#pragma unroll
    for (int dt = 0; dt < 2; ++dt)
#pragma unroll
        for (int ks = 0; ks < 4; ++ks) vf[dt][ks] = *(const LAS bf16x8*)(Vt + (32 * dt + r) * LD2 + 16 * ks + 8 * h);
    bf16x8 pf[NMAP][4];
#pragma unroll
    for (int mp = 0; mp < NMAP; ++mp) {
#pragma unroll
        for (int t2 = 0; t2 < 2; ++t2) {
            const bool on = t2 ? on1 : on0;
            if (!on) {
#pragma unroll
                for (int i = 0; i < 16; ++i) s[mp][t2][i] = -1.0e30f;
            } else if (WINDOW) {
#pragma unroll
                for (int i = 0; i < 16; ++i) { const int d = tq - (tk0 + 32 * t2 + (i & 3) + 8 * (i >> 2) + 4 * h); if (d > 128 || d < -128) s[mp][t2][i] = -1.0e30f; }
            }
        }
        float mx = fmaxf(s[mp][0][0], s[mp][1][0]);
#pragma unroll
        for (int t2 = 0; t2 < 2; ++t2) {
            mx = fmaxf(mx, s[mp][t2][1]);
#pragma unroll
            for (int i = 2; i < 16; i += 2) mx = fmaxf(fmaxf(mx, s[mp][t2][i]), s[mp][t2][i + 1]);
        }
        mx = fmaxf(mx, __shfl_xor(mx, 32));
        const float mnew = fmaxf(st.m[mp], mx * c2), al = fast_exp2(st.m[mp] - mnew);
        st.m[mp] = mnew;
        float ls = 0.f;
#pragma unroll
        for (int t2 = 0; t2 < 2; ++t2)
#pragma unroll
            for (int i = 0; i < 16; ++i) { const float p = fast_exp2(fmaf(s[mp][t2][i], c2, -mnew)); ls += p; s[mp][t2][i] = p; }
        st.l[mp] = st.l[mp] * al + ls;
        if (__builtin_amdgcn_ballot_w64(al != 1.0f) != 0ull) {
#pragma unroll
            for (int dt = 0; dt < 2; ++dt)
#pragma unroll
                for (int i = 0; i < 16; ++i) st.O[mp][dt][i] *= al;
        }
#pragma unroll
        for (int ks = 0; ks < 4; ++ks) { const f32x16& sv = s[mp][ks >> 1]; const int o = 8 * (ks & 1); u32x4 w;
            w.x = pk_bf16(sv[o + 0], sv[o + 1]); w.y = pk_bf16(sv[o + 2], sv[o + 3]); w.z = pk_bf16(sv[o + 4], sv[o + 5]); w.w = pk_bf16(sv[o + 6], sv[o + 7]);
            pf[mp][ks] = __builtin_bit_cast(bf16x8, w); }
    }
#pragma unroll
    for (int ks = 0; ks < 4; ++ks) {
        const bool on = (ks >> 1) ? on1 : on0;
        if (on) {
#pragma unroll
            for (int dt = 0; dt < 2; ++dt)
#pragma unroll
                for (int mp = 0; mp < NMAP; ++mp) st.O[mp][dt] = MFMA32(vf[dt][ks], pf[mp][ks], st.O[mp][dt]);
        }
    }
}
__device__ __forceinline__ int perm16(int k) { return 8 * ((k >> 2) & 1) + 4 * (k >> 3) + (k & 3); }

__device__ __forceinline__ void attn_c2_unit(const Frame& F, int li, int unit) {
    PH_ARGS();
    const bool ctxq = unit >= NB * 4 * 8;
    int b, h, t0;
    if (!ctxq) { b = unit >> 5; h = (unit >> 3) & 3; t0 = NCTX + (unit & 7) * 256; } else { const int u = unit - NB * 4 * 8; b = u >> 2; h = u & 3; t0 = 0; }
    const int nsteps = ctxq ? NCTX / 64 : TB / 64;
    const int rb = b * TB, r = F.lane & 31, hh = F.lane >> 5;
    const float c2 = 0.17677669529663687f * LOG2E;
    const float lam_init = 0.8f - 0.6f * expf(-0.3f * (float)li);
    float d0 = 0.f, d1 = 0.f;
    if (F.lane < 32) { d0 = A_->in[I_LAMQ][li * 64 + F.lane] * A_->in[I_LAMK][li * 64 + F.lane]; d1 = A_->in[I_LAMQ][li * 64 + 32 + F.lane] * A_->in[I_LAMK][li * 64 + 32 + F.lane]; }
    const float lam = expf(wave_sum(d0)) - expf(wave_sum(d1)) + lam_init;
    const bf16_t* P = WSP(bf16_t, WS_P);
    const bf16_t* VT = WSP(bf16_t, WS_VTC) + (size_t)(b * 4 + h) * 64 * TB;
    const int tq = t0 + 32 * F.wave + r;
    bf16x8 qf[2][2];
#pragma unroll
    for (int mp = 0; mp < 2; ++mp)
#pragma unroll
        for (int sx = 0; sx < 2; ++sx) qf[mp][sx] = *(const bf16x8*)(P + (size_t)(rb + tq) * LDP + PC_QC + (2 * h + mp) * 32 + 16 * sx + 8 * hh);
    At2State<2> st;
#pragma unroll
    for (int mp = 0; mp < 2; ++mp) { st.m[mp] = M_INIT; st.l[mp] = 0.f;
#pragma unroll
        for (int dt = 0; dt < 2; ++dt)
#pragma unroll
            for (int i = 0; i < 16; ++i) st.O[mp][dt][i] = 0.f; }
    const int srow = F.tid >> 3, spc = F.tid & 7;
    const bf16_t* kp = P + (size_t)(rb + srow) * LDP + PC_KC + h * 64 + spc * 8;
    const bf16_t* vp = VT + (size_t)srow * TB + spc * 8;
    LAS bf16_t* SB = (LAS bf16_t*)F.lds;
    const int nst2 = nsteps >> 1;
    u32x4 kr[2], vr[2];
#pragma unroll
    for (int p = 0; p < 2; ++p) { kr[p] = *(const u32x4*)(kp + (size_t)(64 * p) * LDP); vr[p] = *(const u32x4*)(vp + 64 * p); }
    __syncthreads();
#pragma unroll
    for (int p = 0; p < 2; ++p) { *(LAS u32x4*)(SB + p * AT2_TILE + srow * LD2 + spc * 8) = kr[p]; *(LAS u32x4*)(SB + (2 + p) * AT2_TILE + srow * LD2 + spc * 8) = vr[p]; }
    __syncthreads();
    for (int sp = 0; sp < nst2; ++sp) {
        const int cur = sp & 1;
        if (sp + 1 < nst2) {
#pragma unroll
            for (int p = 0; p < 2; ++p) { kr[p] = *(const u32x4*)(kp + (size_t)((sp + 1) * 128 + 64 * p) * LDP); vr[p] = *(const u32x4*)(vp + (sp + 1) * 128 + 64 * p); } }
#pragma unroll 1
        for (int p = 0; p < 2; ++p) at2_step<2, 32, false>(SB + (cur * 4 + p) * AT2_TILE, SB + (cur * 4 + 2 + p) * AT2_TILE, qf, st, c2, true, true, 0, 0, F.lane);
        if (sp + 1 < nst2) {
#pragma unroll
            for (int p = 0; p < 2; ++p) { *(LAS u32x4*)(SB + ((cur ^ 1) * 4 + p) * AT2_TILE + srow * LD2 + spc * 8) = kr[p]; *(LAS u32x4*)(SB + ((cur ^ 1) * 4 + 2 + p) * AT2_TILE + srow * LD2 + spc * 8) = vr[p]; } }
        __syncthreads();
    }
    const float i0 = 1.0f / (st.l[0] + __shfl_xor(st.l[0], 32)), i1 = lam / (st.l[1] + __shfl_xor(st.l[1], 32));
    float ss = 0.f;
#pragma unroll
    for (int dt = 0; dt < 2; ++dt)
#pragma unroll
        for (int i = 0; i < 16; ++i) { const float o = st.O[0][dt][i] * i0 - st.O[1][dt][i] * i1; st.O[0][dt][i] = o; ss += o * o; }
    ss += __shfl_xor(ss, 32);
    const float sc = rsqrtf(ss * (1.0f / 64.0f) + LN_EPS) * (1.0f - lam_init);
    bf16_t* op = WSP(bf16_t, WS_MIX) + (size_t)(rb + tq) * D + 768 + h * 64;
#pragma unroll
    for (int dt = 0; dt < 2; ++dt)
#pragma unroll
        for (int q4 = 0; q4 < 4; ++q4) { const int d = 32 * dt + 8 * q4 + 4 * hh; const f32x4 nw = *(const f32x4*)(A_->in[I_DIFFNW] + li * 64 + d);
            u32x2 w; w.x = pk_bf16(st.O[0][dt][4 * q4] * sc * nw[0], st.O[0][dt][4 * q4 + 1] * sc * nw[1]); w.y = pk_bf16(st.O[0][dt][4 * q4 + 2] * sc * nw[2], st.O[0][dt][4 * q4 + 3] * sc * nw[3]);
            *(u32x2*)(op + d) = w; }
}

__device__ __forceinline__ void attn_a2_unit(const Frame& F, int li, int unit) {
    PH_ARGS();
    const int qt = unit % NCH, hq = (unit / NCH) % 6, b = unit / (6 * NCH), kvh = hq / 3;
    const int rb = b * TB, r = F.lane & 31, hh = F.lane >> 5, grp = F.wave & 3, part = F.wave >> 2;
    const float c2 = 0.125f * LOG2E;
    const bf16_t* P = WSP(bf16_t, WS_P);
    const bf16_t* VT = WSP(bf16_t, WS_VTA) + (size_t)(b * 2 + kvh) * 64 * TB;
    LAS bf16_t* SB = (LAS bf16_t*)F.lds;
    const int q0 = 128 * qt + 32 * grp, tq = q0 + r;
    bf16x8 qf[1][4];
#pragma unroll
    for (int sx = 0; sx < 4; ++sx) qf[0][sx] = *(const bf16x8*)(P + (size_t)(rb + tq) * LDP + PC_QA + hq * 64 + 16 * sx + 8 * hh);
    At2State<1> st; st.m[0] = M_INIT; st.l[0] = 0.f;
#pragma unroll
    for (int dt = 0; dt < 2; ++dt)
#pragma unroll
        for (int i = 0; i < 16; ++i) st.O[0][dt][i] = 0.f;
    const int nit = qt < 2 ? 2 : 5;
    const int srow = F.tid >> 3, spc = F.tid & 7;
#define A2_STEP_T(s) ((s) < 4 ? 64 * (s) : ((128 * (qt - 1) + 64 * ((s) - 4)) >= NCTX && (128 * (qt - 1) + 64 * ((s) - 4)) < TB ? (128 * (qt - 1) + 64 * ((s) - 4)) : -1))
    u32x4 kr[2], vr[2];
#define A2_LOAD(it) do { _Pragma("unroll") for (int p_ = 0; p_ < 2; ++p_) { int t_ = A2_STEP_T(2 * (it) + p_); if (t_ < 0) t_ = 0; \
        kr[p_] = *(const u32x4*)(P + (size_t)(rb + t_ + srow) * LDP + PC_KA + kvh * 64 + spc * 8); vr[p_] = *(const u32x4*)(VT + (size_t)srow * TB + t_ + spc * 8); } } while (0)
#define A2_STORE(buf) do { _Pragma("unroll") for (int p_ = 0; p_ < 2; ++p_) { *(LAS u32x4*)(SB + ((buf) * 4 + p_) * AT2_TILE + srow * LD2 + spc * 8) = kr[p_]; \
        *(LAS u32x4*)(SB + ((buf) * 4 + 2 + p_) * AT2_TILE + srow * LD2 + spc * 8) = vr[p_]; } } while (0)
    A2_LOAD(0);
    __syncthreads();
    A2_STORE(0);
    __syncthreads();
    for (int it = 0; it < nit; ++it) {
        const int cur = it & 1;
        if (it + 1 < nit) A2_LOAD(it + 1);
        const int sidx = 2 * it + part, tk0 = A2_STEP_T(sidx);
        const LAS bf16_t* Kt = SB + (cur * 4 + part) * AT2_TILE; const LAS bf16_t* Vt = SB + (cur * 4 + 2 + part) * AT2_TILE;
        if (sidx < 4) at2_step<1, 64, false>(Kt, Vt, qf, st, c2, true, true, 0, 0, F.lane);
        else if (tk0 >= 0) {
            const bool on0 = (tk0 + 31 >= q0 - 128) && (tk0 <= q0 + 31 + 128), on1 = (tk0 + 63 >= q0 - 128) && (tk0 + 32 <= q0 + 31 + 128);
            if (on0 || on1) at2_step<1, 64, true>(Kt, Vt, qf, st, c2, on0, on1, tq, tk0, F.lane);
        }
        if (it + 1 < nit) A2_STORE(cur ^ 1);
        __syncthreads();
    }
#undef A2_STEP_T
#undef A2_LOAD
#undef A2_STORE
    const float ltot = st.l[0] + __shfl_xor(st.l[0], 32);
    LAS float* MB = (LAS float*)F.lds + grp * 34 * 64;
    if (part == 1) { MB[F.lane] = st.m[0]; MB[64 + F.lane] = ltot;
#pragma unroll
        for (int dt = 0; dt < 2; ++dt)
#pragma unroll
            for (int i = 0; i < 16; ++i) MB[(2 + dt * 16 + i) * 64 + F.lane] = st.O[0][dt][i]; }
    __syncthreads();
    if (part == 0) {
        const float m2 = MB[F.lane], l2 = MB[64 + F.lane];
        const float mm = fmaxf(st.m[0], m2), a1 = fast_exp2(st.m[0] - mm), a2 = fast_exp2(m2 - mm);
        const float sk = A_->in[I_SINK][li * 6 + hq] * LOG2E;
        const float inv = 1.0f / (ltot * a1 + l2 * a2 + fast_exp2(sk - mm));
        bf16_t* op = WSP(bf16_t, WS_MIX) + (size_t)(rb + tq) * D + hq * 64;
#pragma unroll
        for (int dt = 0; dt < 2; ++dt)
#pragma unroll
            for (int q4 = 0; q4 < 4; ++q4) { float o[4];
#pragma unroll
                for (int e = 0; e < 4; ++e) o[e] = (st.O[0][dt][4 * q4 + e] * a1 + MB[(2 + dt * 16 + 4 * q4 + e) * 64 + F.lane] * a2) * inv;
                u32x2 w; w.x = pk_bf16(o[0], o[1]); w.y = pk_bf16(o[2], o[3]); *(u32x2*)(op + 32 * dt + 8 * q4 + 4 * hh) = w; }
    }
    __syncthreads();
}


__device__ __forceinline__ void ssd_m1g_item(const Frame& F, int li, int item) {
    PH_ARGS();
    const int g = item & 1, bc = item >> 1, b = bc / NCH, c = bc % NCH, r0 = b * TB + c * 128;
    const int seg_lo = c < 2 ? b * TB : b * TB + NCTX, seg_hi = c < 2 ? b * TB + NCTX : (b + 1) * TB;
    LAS float* s_dt = (LAS float*)F.lds;
    LAS float* s_ac = s_dt + 6 * 128;
    LAS float* s_sc = s_ac + 6 * 128;
    LAS bf16_t* xT = (LAS bf16_t*)(s_sc + 6 * 128);
    LAS bf16_t* bT = xT + 192 * LDT;
    __syncthreads();
    const int sg = F.tid & 7, oc = F.tid >> 3;
    const int ucol = oc < 24 ? g * 192 + 8 * oc : (oc < 40 ? 384 + g * 128 + 8 * (oc - 24) : 640 + g * 128 + 8 * (oc - 40));
    u32x4 raw[20];
    if (F.tid < 448) {
        const bf16_t* Pp = WSP(bf16_t, WS_P) + PC_XBC + ucol;
#pragma unroll
        for (int i = 0; i < 20; ++i) { const int r = r0 + 16 * sg - 2 + i; raw[i] = (r >= seg_lo && r < seg_hi) ? *(const u32x4*)(Pp + (size_t)r * LDP) : (u32x4){0u, 0u, 0u, 0u}; }
    }
    for (int i = F.tid; i < 128 * 6; i += 512) {
        const int l = i / 6, k = i % 6, hd = (k / 3) * 6 + g * 3 + (k % 3);
        const float rawdt = WSP(float, WS_DT)[(size_t)(r0 + l) * 16 + hd] + A_->in[I_DTBIAS][li * 12 + hd];
        const float dtv = rawdt > 20.f ? rawdt : log1pf(expf(rawdt));
        s_dt[k * 128 + l] = dtv; s_ac[k * 128 + l] = -dtv * expf(A_->in[I_ALOG][li * 12 + hd]);
        WSP(float, WS_DTV)[(size_t)(r0 + l) * 12 + hd] = dtv;
    }
    __syncthreads();
    if (F.wave < 6) {
        const int k = F.wave, hd = (k / 3) * 6 + g * 3 + (k % 3); const bool bw = k >= 3;
        const int l0 = bw ? 127 - 2 * F.lane : 2 * F.lane, l1 = bw ? 126 - 2 * F.lane : 2 * F.lane + 1;
        const float v0 = s_ac[k * 128 + l0], v1 = s_ac[k * 128 + l1];
        float inc = v0 + v1;
#pragma unroll
        for (int o = 1; o < 64; o <<= 1) { const float up = __shfl_up(inc, o); if (F.lane >= o) inc += up; }
        const float exc = inc - (v0 + v1), tot = __shfl(inc, 63);
        const float a0 = exc + v0, a1 = exc + v0 + v1;
        s_sc[k * 128 + l0] = s_dt[k * 128 + l0] * expf(tot - a0); s_sc[k * 128 + l1] = s_dt[k * 128 + l1] * expf(tot - a1);
        WSP(float, WS_ACUM)[(size_t)(r0 + l0) * 12 + hd] = a0; WSP(float, WS_ACUM)[(size_t)(r0 + l1) * 12 + hd] = a1;
        if (F.lane == 0) WSP(float, WS_CHT)[(size_t)bc * 12 + hd] = tot;
    }
    if (F.tid < 448) {
        float w[5][8], cb[8];
#pragma unroll
        for (int k = 0; k < 5; ++k) { const f32x4 a = *(const f32x4*)(A_->in[I_CONVW] + (size_t)(li * 5 + k) * CONV_DIM + ucol), bq = *(const f32x4*)(A_->in[I_CONVW] + (size_t)(li * 5 + k) * CONV_DIM + ucol + 4);
            w[k][0] = a[0]; w[k][1] = a[1]; w[k][2] = a[2]; w[k][3] = a[3]; w[k][4] = bq[0]; w[k][5] = bq[1]; w[k][6] = bq[2]; w[k][7] = bq[3]; }
        { const f32x4 a = *(const f32x4*)(A_->in[I_CONVB] + li * CONV_DIM + ucol), bq = *(const f32x4*)(A_->in[I_CONVB] + li * CONV_DIM + ucol + 4);
          cb[0] = a[0]; cb[1] = a[1]; cb[2] = a[2]; cb[3] = a[3]; cb[4] = bq[0]; cb[5] = bq[1]; cb[6] = bq[2]; cb[7] = bq[3]; }
        u32x4 pk[16];
#pragma unroll
        for (int rr = 0; rr < 16; ++rr) {
            float y[8];
#pragma unroll
            for (int e = 0; e < 8; ++e) y[e] = cb[e];
#pragma unroll
            for (int k = 0; k < 5; ++k) { const u32x4 q = raw[rr + k];
                y[0] += w[k][0] * __uint_as_float(q.x << 16); y[1] += w[k][1] * __uint_as_float(q.x & 0xffff0000u); y[2] += w[k][2] * __uint_as_float(q.y << 16); y[3] += w[k][3] * __uint_as_float(q.y & 0xffff0000u);
                y[4] += w[k][4] * __uint_as_float(q.z << 16); y[5] += w[k][5] * __uint_as_float(q.z & 0xffff0000u); y[6] += w[k][6] * __uint_as_float(q.w << 16); y[7] += w[k][7] * __uint_as_float(q.w & 0xffff0000u); }
#pragma unroll
            for (int e = 0; e < 8; ++e) y[e] = silu_f(y[e]);
            pk[rr].x = pk_bf16(y[0], y[1]); pk[rr].y = pk_bf16(y[2], y[3]); pk[rr].z = pk_bf16(y[4], y[5]); pk[rr].w = pk_bf16(y[6], y[7]);
            *(u32x4*)(WSP(bf16_t, WS_U) + (size_t)(r0 + 16 * sg + rr) * CONV_DIM + ucol) = pk[rr];
        }
        if (oc < 40) {
            LAS bf16_t* tb = oc < 24 ? xT + (8 * oc) * LDT + 16 * sg : bT + (8 * (oc - 24)) * LDT + 16 * sg;
#pragma unroll
            for (int q = 0; q < 4; ++q) {
                u32x4 lo0, lo1, hi0, hi1;
#define PKQ(rr_) (q == 0 ? pk[rr_].x : (q == 1 ? pk[rr_].y : (q == 2 ? pk[rr_].z : pk[rr_].w)))
#define LO2(a_, b_) ((PKQ(a_) & 0xffffu) | (PKQ(b_) << 16))
#define HI2(a_, b_) ((PKQ(a_) >> 16) | (PKQ(b_) & 0xffff0000u))
                lo0.x = LO2(0, 1); lo0.y = LO2(2, 3); lo0.z = LO2(4, 5); lo0.w = LO2(6, 7); lo1.x = LO2(8, 9); lo1.y = LO2(10, 11); lo1.z = LO2(12, 13); lo1.w = LO2(14, 15);
                hi0.x = HI2(0, 1); hi0.y = HI2(2, 3); hi0.z = HI2(4, 5); hi0.w = HI2(6, 7); hi1.x = HI2(8, 9); hi1.y = HI2(10, 11); hi1.z = HI2(12, 13); hi1.w = HI2(14, 15);
#undef PKQ
#undef LO2
#undef HI2
                *(LAS u32x4*)(tb + (2 * q) * LDT) = lo0; *(LAS u32x4*)(tb + (2 * q) * LDT + 8) = lo1;
                *(LAS u32x4*)(tb + (2 * q + 1) * LDT) = hi0; *(LAS u32x4*)(tb + (2 * q + 1) * LDT + 8) = hi1;
            }
        }
    }
    __syncthreads();
    for (int i = F.tid; i < 192 * 16; i += 512) { const int ch = i >> 4, cc = i & 15;
        *(u32x4*)(WSP(bf16_t, WS_XT) + ((size_t)bc * D_INNER + g * 192 + ch) * 128 + cc * 8) = *(const LAS u32x4*)(xT + ch * LDT + cc * 8); }
    for (int q = F.wave; q < 24; q += 8) {
        const int k = q >> 2, ptile = q & 3, hl = k % 3, hd = (k / 3) * 6 + g * 3 + hl;
        bf16x8 af[4];
#pragma unroll
        for (int kt = 0; kt < 4; ++kt) {
            const bf16x8 xr = lds_frag(xT, LDT, hl * 64 + ptile * 16, kt * 32, F.lane);
            const LAS float* sp = s_sc + k * 128 + kt * 32 + 8 * (F.lane >> 4);
            const f32x4 s0 = *(const LAS f32x4*)sp, s1 = *(const LAS f32x4*)(sp + 4);
            u32x4 wv;
            wv.x = pk_bf16(bf2f((bf16_t)xr[0]) * s0[0], bf2f((bf16_t)xr[1]) * s0[1]); wv.y = pk_bf16(bf2f((bf16_t)xr[2]) * s0[2], bf2f((bf16_t)xr[3]) * s0[3]);
            wv.z = pk_bf16(bf2f((bf16_t)xr[4]) * s1[0], bf2f((bf16_t)xr[5]) * s1[1]); wv.w = pk_bf16(bf2f((bf16_t)xr[6]) * s1[2], bf2f((bf16_t)xr[7]) * s1[3]);
            af[kt] = __builtin_bit_cast(bf16x8, wv);
        }
        bf16_t* outp = WSP(bf16_t, WS_CHS) + ((size_t)bc * 12 + hd) * 8192 + (size_t)(ptile * 16 + (F.lane & 15)) * 128 + 4 * (F.lane >> 4);
#pragma unroll 2
        for (int nt = 0; nt < 8; ++nt) {
            f32x4 acc = {0.f, 0.f, 0.f, 0.f};
#pragma unroll
            for (int kt = 0; kt < 4; ++kt) acc = MFMA16(lds_frag(bT, LDT, nt * 16, kt * 32, F.lane), af[kt], acc);
            { u32x2 pw; pw.x = (unsigned)f2bf(acc[0]) | ((unsigned)f2bf(acc[1]) << 16); pw.y = (unsigned)f2bf(acc[2]) | ((unsigned)f2bf(acc[3]) << 16); *(u32x2*)(outp + nt * 16) = pw; }
        }
    }
}

__device__ __forceinline__ void phase_ssd_scan2(const Frame& F) {
    PH_ARGS();
    const bf16_t* chs = WSP(bf16_t, WS_CHS); const float* cht = WSP(float, WS_CHT); bf16_t* h0b = WSP(bf16_t, WS_H0B);
    for (int idx = F.bid * 512 + F.tid; idx < NB * 12 * 2048; idx += F.G * 512) {
        const int e4 = idx & 2047, bh = idx >> 11, hd = bh % 12, b = bh / 12;
        f32x4 st[NCH]; float dec[NCH];
#pragma unroll
        for (int s = 0; s < NCH; ++s) { const int c = hd < 6 ? s : (s < 2 ? 1 - s : NCH + 1 - s);
            { const u32x2 q = *(const u32x2*)(chs + ((size_t)(b * NCH + c) * 12 + hd) * 8192 + e4 * 4); st[s] = (f32x4){__uint_as_float(q.x << 16), __uint_as_float(q.x & 0xffff0000u), __uint_as_float(q.y << 16), __uint_as_float(q.y & 0xffff0000u)}; }
            dec[s] = cht[(size_t)(b * NCH + c) * 12 + hd]; }
        f32x4 h = {0.f, 0.f, 0.f, 0.f};
#pragma unroll
        for (int s = 0; s < NCH; ++s) { const int c = hd < 6 ? s : (s < 2 ? 1 - s : NCH + 1 - s);
            u32x2 w; w.x = pk_bf16(h[0], h[1]); w.y = pk_bf16(h[2], h[3]);
            *(u32x2*)(h0b + ((size_t)(b * NCH + c) * 12 + hd) * 8192 + e4 * 4) = w; h = h * expf(dec[s]) + st[s]; }
    }
}

__device__ __forceinline__ void ssd_m3w_item(const Frame& F, int li, int item) {
    PH_ARGS();
    const int b = item / NCH, c = item % NCH, r0 = b * TB + c * 128;
    LAS float* s_dt = (LAS float*)F.lds;
    LAS float* s_ac = s_dt + 12 * 128;
    LAS bf16_t* bN = (LAS bf16_t*)(s_ac + 12 * 128);
    LAS bf16_t* xTl = bN + 128 * LDT;
    LAS bf16_t* h0l = xTl + 64 * LDT;
    LAS bf16_t* gd = h0l + 2 * 64 * LDT;
    const int w = F.wave, r = F.lane & 15, gq = F.lane >> 4;
    LAS bf16_t* gdw = gd + w * 16 * LDT;
    const bf16_t* U = WSP(bf16_t, WS_U);
    const bf16_t* XT = WSP(bf16_t, WS_XT) + (size_t)item * D_INNER * 128;
    const bf16_t* H0 = WSP(bf16_t, WS_H0B) + (size_t)item * 12 * 8192;
    float* YG = WSP(float, WS_YG);
    const int prow = F.tid >> 4, ppc = F.tid & 15;
    u32x4 px[2], ph[2][2];
#define M3_LOADHEAD(h_) do { _Pragma("unroll") for (int i_ = 0; i_ < 2; ++i_) { px[i_] = *(const u32x4*)(XT + (size_t)((h_) * 64 + prow + 32 * i_) * 128 + ppc * 8); \
        ph[0][i_] = *(const u32x4*)(H0 + (size_t)(h_) * 8192 + (size_t)(prow + 32 * i_) * 128 + ppc * 8); ph[1][i_] = *(const u32x4*)(H0 + (size_t)(6 + (h_)) * 8192 + (size_t)(prow + 32 * i_) * 128 + ppc * 8); } } while (0)
#define M3_STOREHEAD() do { _Pragma("unroll") for (int i_ = 0; i_ < 2; ++i_) { *(LAS u32x4*)(xTl + (prow + 32 * i_) * LDT + ppc * 8) = px[i_]; \
        *(LAS u32x4*)(h0l + (prow + 32 * i_) * LDT + ppc * 8) = ph[0][i_]; *(LAS u32x4*)(h0l + (64 + prow + 32 * i_) * LDT + ppc * 8) = ph[1][i_]; } } while (0)
    unsigned long long qa_ = 0; if ((SPINMASK >> 14) & 1) qa_ = wall_clock64();
    float ssq = 0.f;
    M3_LOADHEAD(0);
    __syncthreads();
    for (int i = F.tid; i < 128 * 12; i += 512) { const int l = i / 12, hd = i % 12; s_dt[hd * 128 + l] = WSP(float, WS_DTV)[(size_t)(r0 + l) * 12 + hd]; s_ac[hd * 128 + l] = WSP(float, WS_ACUM)[(size_t)(r0 + l) * 12 + hd]; }
    for (int g = 0; g < 2; ++g) {
        bf16x8 cf[4];
#pragma unroll
        for (int kt = 0; kt < 4; ++kt) cf[kt] = *(const bf16x8*)(U + (size_t)(r0 + 16 * w + r) * CONV_DIM + 640 + g * 128 + kt * 32 + 8 * gq);
        { u32x4 pb[4];
#pragma unroll
          for (int i = 0; i < 4; ++i) { const int id = F.tid + 512 * i; pb[i] = *(const u32x4*)(U + (size_t)(r0 + (id >> 4)) * CONV_DIM + 384 + g * 128 + (id & 15) * 8); }
          if (g) __syncthreads();
#pragma unroll
          for (int i = 0; i < 4; ++i) { const int id = F.tid + 512 * i; *(LAS u32x4*)(bN + (id >> 4) * LDT + (id & 15) * 8) = pb[i]; } }
        for (int hl = 0; hl < 3; ++hl) {
            const int h = g * 3 + hl;
            M3_STOREHEAD();
            __syncthreads();
            if (h < 5) M3_LOADHEAD(h + 1);
            const int erow = r0 + 16 * w + (F.lane >> 2), ecol = 16 * (F.lane & 3);
            const u32x4 zq0 = *(const u32x4*)(WSP(bf16_t, WS_P) + (size_t)erow * LDP + PC_Z + h * 64 + ecol), zq1 = *(const u32x4*)(WSP(bf16_t, WS_P) + (size_t)erow * LDP + PC_Z + h * 64 + ecol + 8);
            const u32x4 xq0 = *(const u32x4*)(U + (size_t)erow * CONV_DIM + h * 64 + ecol), xq1 = *(const u32x4*)(U + (size_t)erow * CONV_DIM + h * 64 + ecol + 8);
            f32x4 G[8];
#pragma unroll
            for (int st = 0; st < 8; ++st) { f32x4 acc = {0.f, 0.f, 0.f, 0.f};
#pragma unroll
                for (int kt = 0; kt < 4; ++kt) acc = MFMA16(lds_frag(bN, LDT, st * 16, kt * 32, F.lane), cf[kt], acc);
                G[st] = acc; }
            bf16x8 gf[2][4]; float eal[2][4];
#pragma unroll
            for (int dir = 0; dir < 2; ++dir) {
                const int hd = dir * 6 + h;
#pragma unroll
                for (int j = 0; j < 4; ++j) eal[dir][j] = __expf(s_ac[hd * 128 + 16 * w + 4 * gq + j]);
                const int l = 16 * w + r; const float acl = s_ac[hd * 128 + l];
#pragma unroll
                for (int st = 0; st < 8; ++st) { const int s0 = 16 * st + 4 * gq;
                    const f32x4 acs = *(const LAS f32x4*)(s_ac + hd * 128 + s0), dts = *(const LAS f32x4*)(s_dt + hd * 128 + s0);
                    float v[4];
#pragma unroll
                    for (int j = 0; j < 4; ++j) { const bool ok = dir == 0 ? (s0 + j <= l) : (s0 + j >= l); v[j] = ok ? G[st][j] * __expf(acl - acs[j]) * dts[j] : 0.f; }
                    u32x2 pw; pw.x = pk_bf16(v[0], v[1]); pw.y = pk_bf16(v[2], v[3]);
                    *(LAS u32x2*)(gdw + r * LDT + s0) = pw; }
                asm volatile("s_waitcnt lgkmcnt(0)" ::: "memory");
#pragma unroll
                for (int kt = 0; kt < 4; ++kt) gf[dir][kt] = lds_frag(gdw, LDT, 0, kt * 32, F.lane);
                asm volatile("s_waitcnt lgkmcnt(0)" ::: "memory");
            }
            const float dsk = A_->in[I_DSKIP][li * 6 + h];
#pragma unroll
            for (int pt = 0; pt < 4; ++pt) {
                f32x4 yv = {0.f, 0.f, 0.f, 0.f}, t0 = {0.f, 0.f, 0.f, 0.f}, t1 = {0.f, 0.f, 0.f, 0.f};
#pragma unroll
                for (int kt = 0; kt < 4; ++kt) { const bf16x8 xf = lds_frag(xTl, LDT, pt * 16, kt * 32, F.lane);
                    yv = MFMA16(gf[0][kt], xf, yv); yv = MFMA16(gf[1][kt], xf, yv);
                    t0 = MFMA16(cf[kt], lds_frag(h0l, LDT, pt * 16, kt * 32, F.lane), t0); t1 = MFMA16(cf[kt], lds_frag(h0l + 64 * LDT, LDT, pt * 16, kt * 32, F.lane), t1); }
#pragma unroll
                for (int j = 0; j < 4; ++j) ((LAS float*)gdw)[(4 * gq + j) * 68 + pt * 16 + r] = yv[j] + eal[0][j] * t0[j] + eal[1][j] * t1[j];
            }
            asm volatile("s_waitcnt lgkmcnt(0)" ::: "memory");
            {
                const LAS float* yr = (const LAS float*)gdw + (F.lane >> 2) * 68 + ecol;
                const unsigned zz[8] = {zq0.x, zq0.y, zq0.z, zq0.w, zq1.x, zq1.y, zq1.z, zq1.w}, xx[8] = {xq0.x, xq0.y, xq0.z, xq0.w, xq1.x, xq1.y, xq1.z, xq1.w};
                float o[16];
#pragma unroll
                for (int q4 = 0; q4 < 4; ++q4) { const f32x4 yq = *(const LAS f32x4*)(yr + 4 * q4); const f32x4 nw = *(const f32x4*)(A_->in[I_SSMNW] + li * D_INNER + h * 64 + ecol + 4 * q4);
#pragma unroll
                    for (int e = 0; e < 4; ++e) { const int c = 4 * q4 + e; const unsigned zw = zz[c >> 1], xw = xx[c >> 1];
                        const float zv = (c & 1) ? __uint_as_float(zw & 0xffff0000u) : __uint_as_float(zw << 16), xv = (c & 1) ? __uint_as_float(xw & 0xffff0000u) : __uint_as_float(xw << 16);
                        const float gv = (yq[e] + dsk * xv) * silu_f(zv); ssq += gv * gv; o[c] = gv * nw[e]; } }
                u32x4 w0, w1; w0.x = pk_bf16(o[0], o[1]); w0.y = pk_bf16(o[2], o[3]); w0.z = pk_bf16(o[4], o[5]); w0.w = pk_bf16(o[6], o[7]); w1.x = pk_bf16(o[8], o[9]); w1.y = pk_bf16(o[10], o[11]); w1.z = pk_bf16(o[12], o[13]); w1.w = pk_bf16(o[14], o[15]);
                bf16_t* mp = WSP(bf16_t, WS_MIX) + (size_t)erow * D + 384 + h * 64 + ecol;
                *(u32x4*)mp = w0; *(u32x4*)(mp + 8) = w1;
            }
            __syncthreads();
        }
    }
#undef M3_LOADHEAD
#undef M3_STOREHEAD
    if ((SPINMASK >> 14) & 1) { const unsigned long long q1_ = wall_clock64(), qd_ = q1_ - qa_; while (wall_clock64() - q1_ < qd_) __builtin_amdgcn_s_sleep(8); }
    unsigned long long qb_ = 0; if ((SPINMASK >> 15) & 1) qb_ = wall_clock64();
    asm volatile("s_waitcnt vmcnt(0)" ::: "memory");
    { ssq += __shfl_xor(ssq, 1); ssq += __shfl_xor(ssq, 2);
      const float rstd = rsqrtf(ssq * (1.0f / 384.0f) + LN_EPS);
      bf16_t* mp = WSP(bf16_t, WS_MIX) + (size_t)(r0 + 16 * w + (F.lane >> 2)) * D + 384 + 16 * (F.lane & 3);
      u32x4 q[12];
#pragma unroll
      for (int hh = 0; hh < 6; ++hh) { q[2 * hh] = *(const u32x4*)(mp + hh * 64); q[2 * hh + 1] = *(const u32x4*)(mp + hh * 64 + 8); }
#pragma unroll
      for (int i = 0; i < 12; ++i) { u32x4 v = q[i]; unsigned* vp = (unsigned*)&v;
#pragma unroll
          for (int e = 0; e < 4; ++e) vp[e] = pk_bf16(__uint_as_float(vp[e] << 16) * rstd, __uint_as_float(vp[e] & 0xffff0000u) * rstd);
          *(u32x4*)(mp + (i >> 1) * 64 + (i & 1) * 8) = v; } }
    if ((SPINMASK >> 15) & 1) { asm volatile("s_waitcnt vmcnt(0)" ::: "memory"); const unsigned long long q1_ = wall_clock64(), qd_ = q1_ - qb_; while (wall_clock64() - q1_ < qd_) __builtin_amdgcn_s_sleep(8); }
}

#ifndef ONE_LAUNCH
#define ONE_LAUNCH 1
#endif
constexpr int PH_PER_LAYER = 9, PH_TOTAL = 2 + DEPTH * PH_PER_LAYER;
constexpr int ZCOL_TILE = 3;
constexpr int NC3 = 89;

__global__ void __launch_bounds__(512, 2) hybrid_fwd(Args args) {
    extern __shared__ __attribute__((aligned(16))) unsigned char lds_raw[];
    volatile LAS unsigned* bst = (volatile LAS unsigned*)((LAS unsigned char*)lds_raw + LDS_BYTES - 16);
    if (threadIdx.x < 4) bst[threadIdx.x] = 0u;
    __syncthreads();
    XcdBarrier bar; bar.bar = (unsigned*)(args.ws + WS_CTL); bar.x = 0; bar.st = bst;
    if (args.use_bar) bar = xcd_barrier_post((unsigned*)(args.ws + WS_CTL), bst);
    const int lo = args.ph_lo, hi = args.ph_hi;
#ifndef PMASK
#define PMASK 0xFFFF
#endif
#define PM(b) ((PMASK >> (b)) & 1)
#ifndef DBLMASK
#define DBLMASK 0
#endif
#define REPS(b) (((DBLMASK >> (b)) & 1) ? 2 : 1)
#define IN(k) (lo <= (k) && (k) < hi)
#ifndef SPINMASK
#define SPINMASK 0
#endif
#ifndef DBLBAR
#define DBLBAR 0
#endif
#define PT0(b) unsigned long long pt0_ = 0; if ((SPINMASK >> (b)) & 1) pt0_ = wall_clock64()
#define PT1(b) do { if ((SPINMASK >> (b)) & 1) { const unsigned long long pt1_ = wall_clock64(), ptd_ = pt1_ - pt0_; while (wall_clock64() - pt1_ < ptd_) __builtin_amdgcn_s_sleep(8); } } while (0)
#define SEAM(k) do { if (args.use_bar && (k) + 1 < hi) { xcd_barrier(bar); if (DBLBAR) xcd_barrier(bar); } else __syncthreads(); } while (0)
    LAS unsigned char* glds = (LAS unsigned char*)lds_raw;
    volatile LAS int* qslot = (volatile LAS int*)((LAS unsigned char*)lds_raw + LDS_BYTES - 32);
#define MKFRAME() Frame F; { int t_ = threadIdx.x; asm volatile("" : "+v"(t_)); F.lds = (LAS unsigned char*)lds_raw; F.tid = t_; F.lane = t_ & 63; F.wave = __builtin_amdgcn_readfirstlane(t_ >> 6); \
        F.G = gridDim.x; F.bid = blockIdx.x; F.ka = (KArgs)__builtin_amdgcn_kernarg_segment_ptr(); }

    if (PM(0) && IN(0)) { PT0(0); MKFRAME(); for (int rep_ = 0; rep_ < REPS(0); ++rep_) { if (rep_) __syncthreads(); phase_pre_a(F); } PT1(0); SEAM(0); }
    if (PM(1) && IN(1)) { PT0(1); MKFRAME(); phase_pre_b(F); PT1(1); SEAM(1); }

    for (int li = 0; li < DEPTH; ++li) {
        const int pb = 2 + li * PH_PER_LAYER; const bool moe = li & 1; const int jm = li >> 1; const bool last = li == DEPTH - 1;
        if (PM(2) && IN(pb + 0)) { PT0(2);
            MKFRAME(); PH_ARGS();
            pg8::Gemm g{WSP(bf16_t, WS_H), WSP(bf16_t, WS_WIN) + (size_t)li * LDP * D, T, LDP, D / 2};     pg8::StaticOrder S; S.init(T, LDP - 256, F.G, F.bid, 0, ZCOL_TILE);
            const float* rp = WSP(float, WS_ROPE);
            pg8::EpiInProj E{WSP(bf16_t, WS_P), WSP(float, WS_DT), rp, rp + 2048 * 32, rp + 2 * 2048 * 32, rp + 2 * 2048 * 32 + 2048 * 16, WSP(bf16_t, WS_VTA), WSP(bf16_t, WS_VTC), WSP(float, WS_RSC), WSP(float, WS_WSC) + (size_t)18 * 2 * DFF + (size_t)li * LDP};
            for (int rep_ = 0; rep_ < REPS(2); ++rep_) pg8::gemm_phase<pg8::EpiInProj, pg8::StaticOrder, 2>(glds, g, S, E, nullptr);
            PT1(2); SEAM(pb + 0);
        }
        const int nC = last ? NB * 4 * 8 : NB * 4 * 9;
        if (PM(3) && IN(pb + 1)) { PT0(3);
            unsigned* qh = (unsigned*)(args.ws + WS_CTL + CTL_Q_OFF) + (li * 2 + 0) * 64;
            const int e0 = NC3, e1 = e0 + T / 256, e2 = e1 + 2 * NB * NCH, e3 = e2 + NB * 6 * NCH / 2;
            for (;;) {
                __syncthreads(); if (threadIdx.x == 0) *qslot = (int)atomicAdd(qh, 1u); __syncthreads();
                const int it = *qslot;
                if (it >= e3) break;
                MKFRAME(); PH_ARGS();
                if (it < e0) attn_c2_unit(F, li, it);
                else if (it < e1) {
                    pg8::Gemm g{WSP(bf16_t, WS_H), WSP(bf16_t, WS_WIN) + (size_t)li * LDP * D, T, LDP, D / 2};     pg8::OneUnit S{it - e0, ZCOL_TILE};
                    const float* rp = WSP(float, WS_ROPE);
                    pg8::EpiInProj E{WSP(bf16_t, WS_P), WSP(float, WS_DT), rp, rp + 2048 * 32, rp + 2 * 2048 * 32, rp + 2 * 2048 * 32 + 2048 * 16, WSP(bf16_t, WS_VTA), WSP(bf16_t, WS_VTC), WSP(float, WS_RSC), WSP(float, WS_WSC) + (size_t)18 * 2 * DFF + (size_t)li * LDP};
                    pg8::gemm_phase<pg8::EpiInProj, pg8::OneUnit, 2>(glds, g, S, E, nullptr);
                }
                else if (it < e2) ssd_m1g_item(F, li, it - e1);
                else { const int ia = 2 * (it - e2);
                    if (!(last && (ia % NCH) < 2)) attn_a2_unit(F, li, ia);
                    if (!(last && ((ia + 1) % NCH) < 2)) attn_a2_unit(F, li, ia + 1); }
            }
            PT1(3); SEAM(pb + 1);
        }
        if (PM(4) && IN(pb + 2)) { PT0(4);
            MKFRAME();
            phase_ssd_scan2(F);
            PT1(4); SEAM(pb + 2);
        }
        if (PM(5) && IN(pb + 3)) { PT0(5);
            unsigned* qh = (unsigned*)(args.ws + WS_CTL + CTL_Q_OFF) + (li * 2 + 1) * 64;
            const int e0 = nC - NC3, e1 = e0 + NB * NCH;
            for (;;) {
                __syncthreads(); if (threadIdx.x == 0) *qslot = (int)atomicAdd(qh, 1u); __syncthreads();
                const int it = *qslot;
                if (it >= e1) break;
                MKFRAME(); PH_ARGS();
                if (it < e0) attn_c2_unit(F, li, NC3 + it);
                else { const int im = it - e0; if (!(last && (im % NCH) < 2)) ssd_m3w_item(F, li, im); }
            }
            PT1(5); SEAM(pb + 3);
        }
        if (PM(6) && IN(pb + 4)) { PT0(6);
            MKFRAME(); PH_ARGS();
            pg8::Gemm g{WSP(bf16_t, WS_MIX), WSP(bf16_t, WS_WOUT) + (size_t)li * D * D, T, D, D}; pg8::StaticOrder S; S.init(last ? NB * SEQ : T, D, F.G, F.bid, last ? 1 : 0);
            pg8::EpiBf16 E{WSP(bf16_t, WS_O), D, 1.0f};
            for (int rep_ = 0; rep_ < REPS(6); ++rep_) pg8::gemm_phase<pg8::EpiBf16, pg8::StaticOrder>(glds, g, S, E, nullptr);
            PT1(6); SEAM(pb + 4);
        }
        if (PM(7) && IN(pb + 5)) { PT0(7); MKFRAME(); phase_post_mixer(F, li); PT1(7); SEAM(pb + 5); }
        if (PM(8) && IN(pb + 6)) { PT0(8); unsigned long long pg_ = 0; if ((SPINMASK >> (moe ? 16 : 17)) & 1) pg_ = wall_clock64();
            MKFRAME(); PH_ARGS();
            if (!moe) {
                pg8::EpiSwiGLUI8 E{WSP(unsigned char, WS_ACT), WSP(float, WS_RSC), WSP(float, WS_WSC) + (size_t)jm * 2 * DFF};
                pg8::Gemm g{WSP(bf16_t, WS_H), WSP(bf16_t, WS_WGU) + (size_t)jm * 2 * DFF * D, T, 2 * DFF, D / 2}; pg8::StaticOrder S; S.init(T, 2 * DFF, F.G, F.bid);
                for (int rep_ = 0; rep_ < REPS(8); ++rep_) pg8::gemm_phase<pg8::EpiSwiGLUI8, pg8::StaticOrder, 2>(glds, g, S, E, nullptr);
            } else {
                pg8::EpiSwiGLUI8 E{WSP(unsigned char, WS_ACT), WSP(float, WS_HPS), WSP(float, WS_WSC) + (size_t)(2 + jm * 8) * 2 * DFF};
                const unsigned* cnt = (const unsigned*)(ws_ + WS_CTL + CTL_CNT_OFF) + jm * 8 * 64;
                pg8::GroupedOrder<0> S; int acc = 0;
                acc += ((int)cnt[0 * 64] + 255) >> 8; S.t1 = acc; acc += ((int)cnt[1 * 64] + 255) >> 8; S.t2 = acc; acc += ((int)cnt[2 * 64] + 255) >> 8; S.t3 = acc; acc += ((int)cnt[3 * 64] + 255) >> 8; S.t4 = acc;
                acc += ((int)cnt[4 * 64] + 255) >> 8; S.t5 = acc; acc += ((int)cnt[5 * 64] + 255) >> 8; S.t6 = acc; acc += ((int)cnt[6 * 64] + 255) >> 8; S.t7 = acc; acc += ((int)cnt[7 * 64] + 255) >> 8; S.t8 = acc;
                S.nN = 2 * DFF / 256; S.capTiles = MOE_CAP / 256; S.G = F.G; S.c = F.bid;
                pg8::Gemm g{WSP(bf16_t, WS_HP), WSP(bf16_t, WS_WGUE) + (size_t)jm * 8 * 2 * DFF * D, NEXP * MOE_CAP, NEXP * 2 * DFF, D / 2};
                for (int rep_ = 0; rep_ < REPS(8); ++rep_) pg8::gemm_phase<pg8::EpiSwiGLUI8, pg8::GroupedOrder<0>, 2>(glds, g, S, E, nullptr);
            }
            if ((SPINMASK >> (moe ? 16 : 17)) & 1) { const unsigned long long q1_ = wall_clock64(), qd_ = q1_ - pg_; while (wall_clock64() - q1_ < qd_) __builtin_amdgcn_s_sleep(8); }
            PT1(8); SEAM(pb + 6);
        }
        if (PM(9) && IN(pb + 7)) { PT0(9); unsigned long long pd_ = 0; if ((SPINMASK >> (moe ? 18 : 19)) & 1) pd_ = wall_clock64();
            MKFRAME(); PH_ARGS();
            if (!moe) {
                pg8::Gemm g{WSP(bf16_t, WS_ACT), WSP(bf16_t, WS_WD) + (size_t)jm * D * DFF, T, D, DFF / 2}; pg8::StaticOrder S; S.init(T, D, F.G, F.bid);
                pg8::EpiBf16 E{WSP(bf16_t, WS_O), D, 0.015625f};
                for (int rep_ = 0; rep_ < REPS(9); ++rep_) pg8::gemm_phase<pg8::EpiBf16, pg8::StaticOrder, true>(glds, g, S, E, nullptr);
            } else {
                const unsigned* cnt = (const unsigned*)(ws_ + WS_CTL + CTL_CNT_OFF) + jm * 8 * 64;
                pg8::GroupedOrder<1> S; int acc = 0;
                acc += ((int)cnt[0 * 64] + 255) >> 8; S.t1 = acc; acc += ((int)cnt[1 * 64] + 255) >> 8; S.t2 = acc; acc += ((int)cnt[2 * 64] + 255) >> 8; S.t3 = acc; acc += ((int)cnt[3 * 64] + 255) >> 8; S.t4 = acc;
                acc += ((int)cnt[4 * 64] + 255) >> 8; S.t5 = acc; acc += ((int)cnt[5 * 64] + 255) >> 8; S.t6 = acc; acc += ((int)cnt[6 * 64] + 255) >> 8; S.t7 = acc; acc += ((int)cnt[7 * 64] + 255) >> 8; S.t8 = acc;
                S.nN = D / 256; S.capTiles = MOE_CAP / 256; S.G = F.G; S.c = F.bid;
                pg8::Gemm g{WSP(bf16_t, WS_ACT), WSP(bf16_t, WS_WDE) + (size_t)jm * 8 * D * DFF, MAX_SLOT_ROWS, NEXP * D, DFF / 2};
                pg8::EpiBf16 E{WSP(bf16_t, WS_HP), D, 0.015625f};
                for (int rep_ = 0; rep_ < REPS(9); ++rep_) pg8::gemm_phase<pg8::EpiBf16, pg8::GroupedOrder<1>, true>(glds, g, S, E, nullptr);
            }
            if ((SPINMASK >> (moe ? 18 : 19)) & 1) { const unsigned long long q1_ = wall_clock64(), qd_ = q1_ - pd_; while (wall_clock64() - q1_ < qd_) __builtin_amdgcn_s_sleep(8); }
            PT1(9); SEAM(pb + 7);
        }
        if (PM(10) && IN(pb + 8)) { PT0(10); MKFRAME(); phase_post_ffn(F, li); PT1(10); SEAM(pb + 8); }
    }
#undef IN
#undef SEAM
}

extern "C" void kernel_launch(void* const* d_in, const int* in_sizes, int n_in, void* d_out, int out_size, void* d_ws, size_t ws_size, hipStream_t stream) {
    static int grid = 0;
    if (grid == 0) {
        if (n_in != 28 || out_size != NB * SEQ * D || ws_size < WS_END) { fprintf(stderr, "kernel_launch: unexpected shapes (n_in %d, out %d, ws %zu, need %zu); nothing launched\n", n_in, out_size, ws_size, (size_t)WS_END); grid = -1; return; }
        int dev = 0, cus = 0, per_cu = 0;
        if (hipGetDevice(&dev) != hipSuccess || hipDeviceGetAttribute(&cus, hipDeviceAttributeMultiprocessorCount, dev) != hipSuccess) { grid = -1; return; }
        if (hipFuncSetAttribute((const void*)hybrid_fwd, hipFuncAttributeMaxDynamicSharedMemorySize, LDS_BYTES) != hipSuccess) { fprintf(stderr, "kernel_launch: hipFuncSetAttribute failed\n"); grid = -1; return; }
        if (hipOccupancyMaxActiveBlocksPerMultiprocessor(&per_cu, (const void*)hybrid_fwd, 512, LDS_BYTES) != hipSuccess || per_cu < 1) { fprintf(stderr, "kernel_launch: occupancy query says %d blocks per CU\n", per_cu); per_cu = 1; }
        (void)hipGetLastError();
        grid = cus;
    }
    if (grid < 0) return;
    (void)hipMemsetAsync((char*)d_ws + WS_CTL, 0, CTL_BYTES, stream);
    Args a{};
    for (int i = 0; i < 28; ++i) a.in[i] = (const float*)d_in[i];
    a.out = (float*)d_out; a.ws = (unsigned char*)d_ws; a.pad = 0;
#if ONE_LAUNCH
    a.ph_lo = 0; a.ph_hi = PH_TOTAL; a.use_bar = 1;
    hipLaunchKernelGGL(hybrid_fwd, dim3(grid), dim3(512), LDS_BYTES, stream, a);
#else
    for (int p = 0; p < PH_TOTAL; ++p) { a.ph_lo = p; a.ph_hi = p + 1; a.use_bar = 0; hipLaunchKernelGGL(hybrid_fwd, dim3(grid), dim3(512), LDS_BYTES, stream, a); }
#endif
}
```

```cpp
#include <hip/hip_runtime.h>
#include <cstdio>
#include <cstdint>
#include <cstddef>

#ifndef SPINMASK
#define SPINMASK 0
#endif
#define LAS __attribute__((address_space(3)))
typedef unsigned short bf16_t;
typedef short bf16x8 __attribute__((ext_vector_type(8)));
typedef float f32x4 __attribute__((ext_vector_type(4)));
typedef float f32x2 __attribute__((ext_vector_type(2)));
typedef unsigned u32x4 __attribute__((ext_vector_type(4)));
typedef unsigned u32x2 __attribute__((ext_vector_type(2)));

constexpr int NB = 8, SEQ = 2048, NCTX = 256, TB = NCTX + SEQ  , T = NB * TB  , D = 1024, DEPTH = 4;
constexpr int NCH = TB / 128  ;
constexpr int D_IN = 2700, LDP = 2816, DFF = 2816, NEXP = 8, D_INNER = 384, CONV_DIM = 896;
constexpr int PC_QA = 0, PC_KA = 384, PC_VA = 512, PC_Z = 640, PC_XBC = 1024, PC_QC = 1920, PC_KC = 2176, PC_VC = 2432, PC_DT = 2688;
constexpr float LN_EPS = 1e-6f;
constexpr float ALPHA_RES = 1.6817928305074290f;
constexpr float LOG2E = 1.4426950408889634f;
constexpr int MOE_CAP = T;
constexpr int MAX_SLOT_ROWS = 2 * T + NEXP * 256;

constexpr size_t al256(size_t x) { return (x + 255) & ~(size_t)255; }
constexpr size_t WS_CTL = 0;
constexpr size_t CTL_BYTES = 65536;
constexpr size_t CTL_Q_OFF = 32768;
constexpr size_t CTL_CNT_OFF = 16384;
constexpr size_t WS_MOD = WS_CTL + CTL_BYTES;
constexpr size_t WS_ROPE = WS_MOD + al256((size_t)DEPTH * 9 * 6144 * 4);
constexpr size_t WS_WIN = WS_ROPE + (size_t)2048 * 96 * 4;
constexpr size_t WS_WOUT = WS_WIN + (size_t)DEPTH * LDP * D * 2;
constexpr size_t WS_WGU = WS_WOUT + (size_t)DEPTH * D * D * 2;
constexpr size_t WS_WD = WS_WGU + (size_t)2 * 2 * DFF * D * 2;
constexpr size_t WS_WGUE = WS_WD + (size_t)2 * D * DFF * 2;
constexpr size_t WS_WDE = WS_WGUE + (size_t)16 * 2 * DFF * D * 2;
constexpr size_t WS_X = WS_WDE + (size_t)16 * D * DFF * 2;
constexpr size_t WS_H = WS_X + (size_t)T * D * 4;
constexpr size_t WS_P = WS_H + (size_t)T * D * 2;
constexpr size_t WS_DT = WS_P + (size_t)T * LDP * 2;
constexpr size_t WS_U = WS_DT + (size_t)T * 16 * 4;
constexpr size_t WS_DTV = WS_U + (size_t)T * CONV_DIM * 2;
constexpr size_t WS_ACUM = WS_DTV + (size_t)T * 12 * 4;
constexpr size_t WS_CHS = WS_ACUM + (size_t)T * 12 * 4;
constexpr size_t WS_CHT = WS_CHS + (size_t)NB * NCH * 12 * 8192 * 4;
constexpr size_t WS_YG = WS_CHT + 8192;
constexpr size_t WS_MIX = WS_YG + (size_t)T * D_INNER * 4;
constexpr size_t WS_O = WS_MIX + (size_t)T * D * 2;
constexpr size_t WS_ACT = WS_O + (size_t)T * D * 4;
constexpr size_t WS_HP = WS_ACT + (size_t)MAX_SLOT_ROWS * DFF * 2;
constexpr size_t WS_TOK = WS_HP + (size_t)NEXP * MOE_CAP * D * 2;
constexpr size_t WS_VTA = WS_TOK + (size_t)T * 32;
constexpr size_t WS_VTC = WS_VTA + (size_t)NB * 2 * 64 * TB * 2;
constexpr size_t WS_XT = WS_VTC + (size_t)NB * 4 * 64 * TB * 2;
constexpr size_t WS_H0B = WS_XT + (size_t)NB * NCH * D_INNER * 128 * 2;
constexpr size_t WS_WSC = WS_H0B + (size_t)NB * NCH * 12 * 8192 * 2;
constexpr size_t WS_RSC = WS_WSC + (size_t)(18 * 2 * DFF + DEPTH * LDP) * 4;
constexpr size_t WS_HPS = WS_RSC + (size_t)T * 4;
constexpr size_t WS_END = WS_HPS + (size_t)NEXP * MOE_CAP * 4;

constexpr int LDS_BYTES = 147456;

struct Args { const float* in[28]; float* out; unsigned char* ws; int ph_lo, ph_hi, use_bar, pad; };
enum { I_X = 0, I_C, I_CTX, I_CCTX, I_WADA, I_BADA, I_WIN, I_SINK, I_CONVW, I_CONVB, I_DTBIAS, I_ALOG, I_DSKIP, I_SSMNW, I_LAMQ, I_LAMK, I_DIFFNW, I_WOUT,
       I_LN1G, I_LN1B, I_LN2G, I_LN2B, I_FFNGU, I_FFND, I_RW, I_RB, I_EGU, I_ED };

__device__ __forceinline__ float bf2f(bf16_t v) { return __uint_as_float(((unsigned)v) << 16); }
__device__ __forceinline__ bf16_t f2bf(float f) { unsigned u = __float_as_uint(f); u += 0x7FFFu + ((u >> 16) & 1u); return (bf16_t)(u >> 16); }
__device__ __forceinline__ unsigned pk_bf16(float lo, float hi) { unsigned r; asm volatile("v_cvt_pk_bf16_f32 %0, %1, %2" : "=v"(r) : "v"(lo), "v"(hi)); return r; }
__device__ __forceinline__ float fast_exp2(float x) { return __builtin_amdgcn_exp2f(x); }
__device__ __forceinline__ float silu_f(float x) { return x * __builtin_amdgcn_rcpf(1.0f + __expf(-x)); }
__device__ __forceinline__ float wave_sum(float v) {
#pragma unroll
    for (int o = 32; o >= 1; o >>= 1) v += __shfl_xor(v, o);
    return v;
}
#define XB_TMO      128
#define XB_XCNT(j)  (256  + 64 * (j))
#define XB_XSUB(j)  (1280 + 64 * (j))
#define XB_XGEN(j)  (2304 + 64 * (j))
#define XB_TOP      3328
#define XB_TOPGEN   3392
#define XCD_BAR_WORDS 3456
#define XB_SPIN_CAP (1u << 18)
#define LAS __attribute__((address_space(3)))

__device__ __forceinline__ unsigned xb_ld(unsigned* p)              { return __hip_atomic_load(p, __ATOMIC_RELAXED, __HIP_MEMORY_SCOPE_AGENT); }
__device__ __forceinline__ unsigned xb_add(unsigned* p, unsigned v) { return __hip_atomic_fetch_add(p, v, __ATOMIC_RELAXED, __HIP_MEMORY_SCOPE_AGENT); }
__device__ __forceinline__ unsigned xb_xcc_id() { return (unsigned)__builtin_amdgcn_s_getreg((3 << 11) | 20) & 0xFu; }
#define XB_SPIN(cond, bar) do { unsigned _sp = 0; while (cond) { __builtin_amdgcn_s_sleep(1); \
    if ((++_sp & 255u) == 0u) { if (xb_ld(&(bar)[XB_TMO])) break; if (_sp > XB_SPIN_CAP) { atomicAdd(&(bar)[XB_TMO], 1u); break; } } } } while (0)

struct XcdBarrier {
    unsigned* bar; unsigned x;
    volatile LAS unsigned* st;
};

__device__ __forceinline__ XcdBarrier xcd_barrier_post(unsigned* bar, volatile LAS unsigned* st) {
    XcdBarrier b; b.bar = bar; b.x = xb_xcc_id(); b.st = st;
    if (threadIdx.x == 0) (void)xb_add(&bar[XB_XCNT(b.x)], 1u);
    return b;
}
__device__ __forceinline__ void xcd_barrier_complete(unsigned* bar, unsigned x, unsigned& nloc, unsigned& nx) {
    const unsigned G = gridDim.x * gridDim.y * gridDim.z;
    unsigned sum, cnt, mine, sp = 0u;
    for (;;) {
        sum = 0u; cnt = 0u; mine = 0u;
#pragma unroll
        for (unsigned j = 0; j < 16; ++j) { const unsigned c = xb_ld(&bar[XB_XCNT(j)]); sum += c; cnt += (c > 0u) ? 1u : 0u; mine = (j == x) ? c : mine; }
        if (sum == G) break;
        __builtin_amdgcn_s_sleep(1);
        if ((++sp & 255u) == 0u) { if (xb_ld(&bar[XB_TMO])) break; if (sp > XB_SPIN_CAP) { atomicAdd(&bar[XB_TMO], 1u); break; } }
    }
    nloc = mine > 0u ? mine : 1u; nx = cnt > 0u ? cnt : 1u;
}

__device__ __forceinline__ void xcd_barrier(const XcdBarrier& b) {
    asm volatile("s_waitcnt vmcnt(0)" ::: "memory");
    __syncthreads();
    if (threadIdx.x == 0) {
        unsigned* bar = b.bar;
        __builtin_amdgcn_s_waitcnt(0);
        unsigned nloc = b.st[0], nx = b.st[1];
        if (nloc == 0u) { xcd_barrier_complete(bar, b.x, nloc, nx); b.st[0] = nloc; b.st[1] = nx; }
        const unsigned old = xb_add(&bar[XB_XSUB(b.x)], 1u);
        const unsigned gen = old / nloc;
        if (old + 1u == (gen + 1u) * nloc) {
            __builtin_amdgcn_fence(__ATOMIC_RELEASE, "agent");
            asm volatile("s_waitcnt vmcnt(0)" ::: "memory");
            const unsigned og = xb_add(&bar[XB_TOP], 1u);
            const unsigned tg = og / nx;
            if (og + 1u == (tg + 1u) * nx) xb_add(&bar[XB_TOPGEN], 1u);
            else XB_SPIN(xb_ld(&bar[XB_TOPGEN]) == tg, bar);
            __builtin_amdgcn_fence(__ATOMIC_ACQUIRE, "agent");
            xb_add(&bar[XB_XGEN(b.x)], 1u);
            asm volatile("s_waitcnt vmcnt(0)" ::: "memory");
        } else {
            XB_SPIN(xb_ld(&bar[XB_XGEN(b.x)]) == gen, bar);
            __builtin_amdgcn_fence(__ATOMIC_ACQUIRE, "agent");
            asm volatile("s_waitcnt vmcnt(0)" ::: "memory");
        }
    }
    __syncthreads();
}


namespace pg8 {
#define PG8_LAS __attribute__((address_space(3)))
typedef int v4i32 __attribute__((ext_vector_type(4)));
typedef int v8i32 __attribute__((ext_vector_type(8)));
template <bool I> struct AccSel { typedef f32x4 T; };
template <> struct AccSel<true> { typedef v4i32 T; };
constexpr int BM = 256, BK = 64, HALF = 128, HTB = HALF * BK * 2  , STAGE_BYTES = 8 * HTB, NXCD = 8, WGM = 8;

__host__ __device__ __forceinline__ int lds_byte(int r, int c) { const int st = (r >> 4) * 2 + (c >> 5), rr = r & 15, cc = c & 31, ob = rr * 64 + cc * 2; return st * 1024 + (ob ^ (((ob >> 9) & 1) << 5)); }
__host__ __device__ __forceinline__ void stage_rc(int b, int& R, int& C) { const int st = b / 1024, sb = b % 1024, swz = sb ^ (((sb >> 9) & 1) << 5); R = (st >> 1) * 16 + swz / 64; C = (st & 1) * 32 + (swz % 64) / 2; }
__host__ __device__ __forceinline__ int perm32(int rho) { const int n = rho >> 4, i = rho & 15; return 8 * (i >> 2) + 4 * n + (i & 3); }

struct Unit { int pm, pn, po, pc; };
struct Gemm { const bf16_t* A; const bf16_t* Bt; int M, N, K; };

struct StaticOrder {
    int nM, nN, nwg, G, c, skipctx, skipcol;
    __host__ __device__ void init(int M, int N, int G_, int c_, int skipctx_ = 0, int skipcol_ = -1) { nM = M / BM; nN = N / BM; nwg = nM * nN; G = G_; c = c_; skipctx = skipctx_; skipcol = skipcol_; }
    __host__ __device__ bool next(int i, Unit& u) const {
        const long L = (long)i * G + c; if (L >= nwg) return false;
        int wgid = (int)L; { const int q = nwg / NXCD, r = nwg % NXCD, xcd = wgid % NXCD, off = wgid / NXCD; wgid = (xcd < r ? xcd * (q + 1) : r * (q + 1) + (xcd - r) * q) + off; }
        const int nig = WGM * nN, gid = wgid / nig, fm = gid * WGM, gsz = (nM - fm) < WGM ? (nM - fm) : WGM;
        u.pm = fm + ((wgid % nig) % gsz); if (skipctx) u.pm += (u.pm >> 3) + 1;
        u.pn = (wgid % nig) / gsz; if (skipcol >= 0 && u.pn >= skipcol) ++u.pn;
        u.po = u.pm; u.pc = u.pn; return true;
    }
    __device__ __forceinline__ void a_ready(const Unit&) const {}
    __device__ __forceinline__ void done(const Unit&) const {}
};
struct OneUnit {
    int pm, pn;
    __device__ __forceinline__ bool next(int i, Unit& u) const { if (i) return false; u.pm = pm; u.pn = pn; u.po = pm; u.pc = pn; return true; }
    __device__ __forceinline__ void a_ready(const Unit&) const {}
    __device__ __forceinline__ void done(const Unit&) const {}
};
template <int MODE> struct GroupedOrder {
    int t1, t2, t3, t4, t5, t6, t7, t8, nN, capTiles, G, c;
    __device__ __forceinline__ bool next(int i, Unit& u) const {
        const int nwg = t8 * nN, L = i * G + c; if (L >= nwg) return false;
        int wgid = L; { const int q = nwg / NXCD, r = nwg % NXCD, xcd = wgid % NXCD, off = wgid / NXCD; wgid = (xcd < r ? xcd * (q + 1) : r * (q + 1) + (xcd - r) * q) + off; }
        const int nig = WGM * nN, gid = wgid / nig, fm = gid * WGM, gsz = (t8 - fm) < WGM ? (t8 - fm) : WGM;
        const int rt = fm + ((wgid % nig) % gsz), pn = (wgid % nig) / gsz;
        int e = 0, base = 0;
        if (rt >= t1) { e = 1; base = t1; } if (rt >= t2) { e = 2; base = t2; } if (rt >= t3) { e = 3; base = t3; } if (rt >= t4) { e = 4; base = t4; }
        if (rt >= t5) { e = 5; base = t5; } if (rt >= t6) { e = 6; base = t6; } if (rt >= t7) { e = 7; base = t7; }
        u.pm = (MODE == 0) ? e * capTiles + (rt - base) : rt; u.pn = e * nN + pn; u.po = rt; u.pc = pn; return true;
    }
    __device__ __forceinline__ void a_ready(const Unit&) const {}
    __device__ __forceinline__ void done(const Unit&) const {}
};

struct EpiF32 {
    static constexpr bool PERM = false, AFTER_DRAIN = false;
    float* C; int ldc;
    __device__ __forceinline__ void operator()(const f32x4 (&acc)[2][2][4][2], const Unit& u, int wr, int wc, int fr, int fq) const {
        const int row0 = u.po * BM + wr * 64 + fr, col0 = u.pc * BM + wc * 32 + 4 * fq;
#pragma unroll
        for (int ai = 0; ai < 2; ++ai)
#pragma unroll
            for (int m = 0; m < 4; ++m) { float* rowp = C + (size_t)(row0 + ai * HALF + m * 16) * ldc + col0;
#pragma unroll
                for (int bj = 0; bj < 2; ++bj)
#pragma unroll
                    for (int n = 0; n < 2; ++n) *(f32x4*)(rowp + bj * HALF + n * 16) = acc[ai][bj][m][n]; }
    }
};
struct EpiBf16 {
    static constexpr bool PERM = true, AFTER_DRAIN = false;
    bf16_t* O; int ldc; float scale;
    __device__ __forceinline__ void operator()(const f32x4 (&acc)[2][2][4][2], const Unit& u, int wr, int wc, int fr, int fq) const {
        const int row0 = u.po * BM + wr * 64 + fr, col0 = u.pc * BM + wc * 32 + 8 * fq;
#pragma unroll
        for (int ai = 0; ai < 2; ++ai)
#pragma unroll
            for (int m = 0; m < 4; ++m) { bf16_t* rowp = O + (size_t)(row0 + ai * HALF + m * 16) * ldc + col0;
#pragma unroll
                for (int bj = 0; bj < 2; ++bj) { const f32x4 v0 = acc[ai][bj][m][0] * scale, v1 = acc[ai][bj][m][1] * scale;
                    u32x4 w; w.x = pk_bf16(v0[0], v0[1]); w.y = pk_bf16(v0[2], v0[3]); w.z = pk_bf16(v1[0], v1[1]); w.w = pk_bf16(v1[2], v1[3]);
                    *(u32x4*)(rowp + bj * HALF) = w; } }
    }
};
struct EpiInProj {
    static constexpr bool PERM = true, AFTER_DRAIN = false;
    bf16_t* P; float* DT; const float* cosA; const float* sinA; const float* cosC; const float* sinC; bf16_t* VTA; bf16_t* VTC; const float* rsc; const float* wsc;
    __device__ __forceinline__ void operator()(const v4i32 (&acc)[2][2][4][2], const Unit& u, int wr, int wc, int fr, int fq) const {
        const int pt = u.po % 9; const bool latent = pt != 0;
        const int row0 = u.po * BM + wr * 64 + fr, pos0 = (pt - 1) * 256 + wr * 64 + fr;
        const float* wq = wsc + (size_t)u.pn * BM + wc * 32 + 8 * fq; asm volatile("" : "+v"(wq));
        const f32x4 ws0[2] = {*(const f32x4*)wq, *(const f32x4*)(wq + HALF)}, ws1[2] = {*(const f32x4*)(wq + 4), *(const f32x4*)(wq + HALF + 4)};
        float sav[2][4];
#pragma unroll
        for (int ai = 0; ai < 2; ++ai)
#pragma unroll
            for (int m = 0; m < 4; ++m) sav[ai][m] = rsc[row0 + ai * HALF + m * 16];
#pragma unroll
        for (int ai = 0; ai < 2; ++ai)
#pragma unroll
            for (int m = 0; m < 4; ++m) {
                const int row = row0 + ai * HALF + m * 16, pos = pos0 + ai * HALF + m * 16;
#pragma unroll
                for (int bj = 0; bj < 2; ++bj) {
                    const int c0 = u.pc * BM + bj * HALF + wc * 32 + 8 * fq;
                    const v4i32 i0 = acc[ai][bj][m][0], i1 = acc[ai][bj][m][1]; const float sa = sav[ai][m];
                    f32x4 v0 = {(float)i0[0], (float)i0[1], (float)i0[2], (float)i0[3]}, v1 = {(float)i1[0], (float)i1[1], (float)i1[2], (float)i1[3]};
                    v0 *= ws0[bj] * sa; v1 *= ws1[bj] * sa;
                    if (latent) {
                        if (c0 < PC_VA) { const int j = (c0 & 63) >> 3; const f32x4 cs = *(const f32x4*)(cosA + pos * 32 + 4 * j), sn = *(const f32x4*)(sinA + pos * 32 + 4 * j);
                            const f32x4 a = v0 * cs - v1 * sn, b = v0 * sn + v1 * cs; v0 = a; v1 = b; }
                        else if (c0 >= PC_QC && c0 < PC_VC) { const int j = (c0 & 31) >> 3; const f32x4 cs = *(const f32x4*)(cosC + pos * 16 + 4 * j), sn = *(const f32x4*)(sinC + pos * 16 + 4 * j);
                            const f32x4 a = v0 * cs - v1 * sn, b = v0 * sn + v1 * cs; v0 = a; v1 = b; }
                    }
                    u32x4 w; w.x = pk_bf16(v0[0], v0[1]); w.y = pk_bf16(v0[2], v0[3]); w.z = pk_bf16(v1[0], v1[1]); w.w = pk_bf16(v1[2], v1[3]);
                    *(u32x4*)(P + (size_t)row * LDP + c0) = w;
                    if ((c0 >= PC_VA && c0 < PC_Z) || (c0 >= PC_VC && c0 < PC_DT)) {
                        const int bb = u.po / 9, tpos = pt * 256 + ai * HALF + wr * 64 + m * 16 + (8 * ((fr >> 2) & 1) + 4 * (fr >> 3) + (fr & 3));
                        bf16_t* vt = (c0 < PC_Z) ? VTA + ((size_t)(bb * 128 + (c0 - PC_VA)) * TB + tpos) : VTC + ((size_t)(bb * 256 + (c0 - PC_VC)) * TB + tpos);
                        vt[0] = (bf16_t)(w.x & 0xffffu); vt[TB] = (bf16_t)(w.x >> 16); vt[2 * TB] = (bf16_t)(w.y & 0xffffu); vt[3 * TB] = (bf16_t)(w.y >> 16);
                        vt[4 * TB] = (bf16_t)(w.z & 0xffffu); vt[5 * TB] = (bf16_t)(w.z >> 16); vt[6 * TB] = (bf16_t)(w.w & 0xffffu); vt[7 * TB] = (bf16_t)(w.w >> 16); }
                    if (c0 >= PC_DT && c0 < PC_DT + 16) { float* d = DT + (size_t)row * 16 + (c0 - PC_DT); *(f32x4*)d = v0; *(f32x4*)(d + 4) = v1; }
                }
            }
    }
};
struct EpiSwiGLUI8 {
    static constexpr bool PERM = true, AFTER_DRAIN = false;
    unsigned char* O; const float* rsc; const float* wsc;
    __device__ __forceinline__ void operator()(const v4i32 (&acc)[2][2][4][2], const Unit& u, int wr, int wc, int fr, int fq) const {
        const int row0 = u.po * BM + wr * 64 + fr, arow0 = u.pm * BM + wr * 64 + fr, col0 = u.pc * HALF + wc * 32 + 8 * fq;
        const float* wq = wsc + (size_t)u.pn * BM + wc * 32 + 8 * fq; asm volatile("" : "+v"(wq));
        const f32x4 wg0 = *(const f32x4*)wq, wg1 = *(const f32x4*)(wq + 4), wu0 = *(const f32x4*)(wq + HALF), wu1 = *(const f32x4*)(wq + HALF + 4);
        float sav[2][4];
#pragma unroll
        for (int ai = 0; ai < 2; ++ai)
#pragma unroll
            for (int m = 0; m < 4; ++m) sav[ai][m] = rsc[arow0 + ai * HALF + m * 16];
#pragma unroll
        for (int ai = 0; ai < 2; ++ai)
#pragma unroll
            for (int m = 0; m < 4; ++m) {
                const float sa = sav[ai][m];
                const v4i32 g0 = acc[ai][0][m][0], g1 = acc[ai][0][m][1], u0 = acc[ai][1][m][0], u1 = acc[ai][1][m][1];
                float r[8];
#pragma unroll
                for (int j = 0; j < 4; ++j) { r[j] = __builtin_amdgcn_fmed3f(silu_f((float)g0[j] * (sa * wg0[j])) * ((float)u0[j] * (sa * wu0[j])), -448.f, 448.f);
                    r[4 + j] = __builtin_amdgcn_fmed3f(silu_f((float)g1[j] * (sa * wg1[j])) * ((float)u1[j] * (sa * wu1[j])), -448.f, 448.f); }
                int w0 = 0, w1 = 0;
                w0 = __builtin_amdgcn_cvt_pk_fp8_f32(r[0], r[1], w0, false); w0 = __builtin_amdgcn_cvt_pk_fp8_f32(r[2], r[3], w0, true);
                w1 = __builtin_amdgcn_cvt_pk_fp8_f32(r[4], r[5], w1, false); w1 = __builtin_amdgcn_cvt_pk_fp8_f32(r[6], r[7], w1, true);
                *(u32x2*)(O + (size_t)(row0 + ai * HALF + m * 16) * DFF + col0) = (u32x2){(unsigned)w0, (unsigned)w1};
            }
    }
};
struct EpiSwiGLU8 {
    static constexpr bool PERM = true, AFTER_DRAIN = false;
    unsigned char* O; float isc;
    __device__ __forceinline__ void operator()(const f32x4 (&acc)[2][2][4][2], const Unit& u, int wr, int wc, int fr, int fq) const {
        const int row0 = u.po * BM + wr * 64 + fr, col0 = u.pc * HALF + wc * 32 + 8 * fq;
#pragma unroll
        for (int ai = 0; ai < 2; ++ai)
#pragma unroll
            for (int m = 0; m < 4; ++m) {
                const f32x4 g0 = acc[ai][0][m][0], g1 = acc[ai][0][m][1], u0 = acc[ai][1][m][0], u1 = acc[ai][1][m][1];
                float r[8];
#pragma unroll
                for (int j = 0; j < 4; ++j) { r[j] = __builtin_amdgcn_fmed3f(silu_f(g0[j] * isc) * (u0[j] * isc), -448.f, 448.f); r[4 + j] = __builtin_amdgcn_fmed3f(silu_f(g1[j] * isc) * (u1[j] * isc), -448.f, 448.f); }
                int w0 = 0, w1 = 0;
                w0 = __builtin_amdgcn_cvt_pk_fp8_f32(r[0], r[1], w0, false); w0 = __builtin_amdgcn_cvt_pk_fp8_f32(r[2], r[3], w0, true);
                w1 = __builtin_amdgcn_cvt_pk_fp8_f32(r[4], r[5], w1, false); w1 = __builtin_amdgcn_cvt_pk_fp8_f32(r[6], r[7], w1, true);
                *(u32x2*)(O + (size_t)(row0 + ai * HALF + m * 16) * DFF + col0) = (u32x2){(unsigned)w0, (unsigned)w1};
            }
    }
};
struct EpiSwiGLU {
    static constexpr bool PERM = true, AFTER_DRAIN = false;
    bf16_t* O;
    __device__ __forceinline__ void operator()(const f32x4 (&acc)[2][2][4][2], const Unit& u, int wr, int wc, int fr, int fq) const {
        const int row0 = u.po * BM + wr * 64 + fr, col0 = u.pc * HALF + wc * 32 + 8 * fq;
#pragma unroll
        for (int ai = 0; ai < 2; ++ai)
#pragma unroll
            for (int m = 0; m < 4; ++m) {
                const f32x4 g0 = acc[ai][0][m][0], g1 = acc[ai][0][m][1], u0 = acc[ai][1][m][0], u1 = acc[ai][1][m][1];
                float r[8];
#pragma unroll
                for (int j = 0; j < 4; ++j) { r[j] = silu_f(g0[j]) * u0[j]; r[4 + j] = silu_f(g1[j]) * u1[j]; }
                u32x4 w; w.x = pk_bf16(r[0], r[1]); w.y = pk_bf16(r[2], r[3]); w.z = pk_bf16(r[4], r[5]); w.w = pk_bf16(r[6], r[7]);
                *(u32x4*)(O + (size_t)(row0 + ai * HALF + m * 16) * DFF + col0) = w;
            }
    }
};


template <class Epi, class Sched, int MODE = 0, bool STAMP = false>
__device__ __forceinline__ void gemm_phase(PG8_LAS unsigned char* lds, const Gemm g, const Sched& S, const Epi& E, unsigned long long* stamps) {
    int tid_ = threadIdx.x; asm volatile("" : "+v"(tid_));
    const int tid = tid_, wid = __builtin_amdgcn_readfirstlane(tid >> 6), lane = tid & 63, wr = wid >> 2, wc = wid & 3, fr = lane & 15, fq = lane >> 4;
    const int K = g.K, nt = K / BK;
    int ts_lo = 0, ts_hi = 0, nts = 0; const unsigned long long rt_entry = STAMP ? (unsigned long long)wall_clock64() : 0ull;
#define PG8_STAMP() do { if (STAMP && wid == 0 && nts < 64) { const unsigned long long _c = (unsigned long long)clock64(); \
        ts_lo = (lane == nts) ? (int)(unsigned)_c : ts_lo; ts_hi = (lane == nts) ? (int)(unsigned)(_c >> 32) : ts_hi; ++nts; } } while (0)
    PG8_STAMP();
    unsigned voffA[2], voffB[2];
#pragma unroll
    for (int i = 0; i < 2; ++i) { int R, C; stage_rc(tid * 16 + i * 8192, R, C); const int Rb = Epi::PERM ? ((R & ~31) + perm32(R & 31)) : R;
        voffA[i] = (unsigned)(R * K + C) * 2u; voffB[i] = (unsigned)(Rb * K + C) * 2u; }
    const size_t kstep = (size_t)(BK * 2);
    const size_t hstep = (size_t)HALF * K * 2;
    const size_t tstep = 2 * hstep;
    const unsigned ldsw = (unsigned)wid * 1024u;
    const int aoff = lds_byte(wr * 64 + fr, fq * 8), boff = lds_byte(wc * 32 + fr, fq * 8);
#define PG8_SA(b, h) (((b) * 2 + (h)) * HTB)
#define PG8_SB(b, h) ((4 + (b) * 2 + (h)) * HTB)
#define PG8_STAGE(bufoff, gbase, voff) do { _Pragma("unroll") for (int _i = 0; _i < 2; ++_i) \
        __builtin_amdgcn_global_load_lds((const unsigned*)((const char*)(gbase) + (voff)[_i]), (PG8_LAS unsigned*)(lds + (bufoff) + ldsw + _i * 8192), 16, 0, 0); } while (0)
#define PG8_LD8(p_) __builtin_shufflevector(*(const PG8_LAS v4i32*)(p_), *(const PG8_LAS v4i32*)((p_) + 1024), 0, 1, 2, 3, 4, 5, 6, 7)
#define PG8_LDA(dst, b, h) do { _Pragma("unroll") for (int m = 0; m < 4; ++m) dst[m] = PG8_LD8(lds + PG8_SA(b, h) + aoff + m * 2048); } while (0)
#define PG8_LDB(dst, b, h) do { _Pragma("unroll") for (int n = 0; n < 2; ++n) dst[n] = PG8_LD8(lds + PG8_SB(b, h) + boff + n * 2048); } while (0)
#define PG8_HALF(v_, k_) __builtin_bit_cast(bf16x8, __builtin_shufflevector(v_, v_, 4 * (k_), 4 * (k_) + 1, 4 * (k_) + 2, 4 * (k_) + 3))
#define PG8_HALFI(v_, k_) __builtin_shufflevector(v_, v_, 4 * (k_), 4 * (k_) + 1, 4 * (k_) + 2, 4 * (k_) + 3)
#define PG8_MMA(ai, bj, At, Bt) do { __builtin_amdgcn_s_setprio(1); \
        if constexpr (MODE == 1) { _Pragma("unroll") for (int m = 0; m < 4; ++m) _Pragma("unroll") for (int n = 0; n < 2; ++n) \
            asm volatile("v_mfma_f32_16x16x128_f8f6f4 %0, %1, %2, %0" : "+v"(acc[ai][bj][m][n]) : "v"(Bt[n]), "v"(At[m])); } \
        else if constexpr (MODE == 2) {   \
            _Pragma("unroll") for (int m = 0; m < 4; ++m) _Pragma("unroll") for (int n = 0; n < 2; ++n) \
                asm volatile("v_mfma_i32_16x16x64_i8 %0, %1, %2, %0" : "+v"(acc[ai][bj][m][n]) : "v"(PG8_HALFI(Bt[n], 0)), "v"(PG8_HALFI(At[m], 0))); \
            _Pragma("unroll") for (int m = 0; m < 4; ++m) _Pragma("unroll") for (int n = 0; n < 2; ++n) \
                asm volatile("v_mfma_i32_16x16x64_i8 %0, %1, %2, %0" : "+v"(acc[ai][bj][m][n]) : "v"(PG8_HALFI(Bt[n], 1)), "v"(PG8_HALFI(At[m], 1))); } \
        else { _Pragma("unroll") for (int m = 0; m < 4; ++m) _Pragma("unroll") for (int n = 0; n < 2; ++n) { \
            acc[ai][bj][m][n] = __builtin_amdgcn_mfma_f32_16x16x32_bf16(PG8_HALF(Bt[n], 0), PG8_HALF(At[m], 0), acc[ai][bj][m][n], 0, 0, 0); \
            acc[ai][bj][m][n] = __builtin_amdgcn_mfma_f32_16x16x32_bf16(PG8_HALF(Bt[n], 1), PG8_HALF(At[m], 1), acc[ai][bj][m][n], 0, 0, 0); } } \
        __builtin_amdgcn_s_setprio(0); } while (0)
#define PG8_WAIT_V(n) asm volatile("s_waitcnt vmcnt(" #n ")" ::: "memory")
#define PG8_WAIT_L(n) asm volatile("s_waitcnt lgkmcnt(" #n ")" ::: "memory")
#define PG8_BAR __builtin_amdgcn_s_barrier()
#define PG8_SCHED __builtin_amdgcn_sched_barrier(0)
    Unit cur, nxt; int ui = 0;
    if (!S.next(0, cur)) return;
    typename AccSel<MODE == 2>::T acc[2][2][4][2];
#pragma unroll
    for (int a = 0; a < 2; ++a)
#pragma unroll
        for (int b = 0; b < 2; ++b)
#pragma unroll
            for (int m = 0; m < 4; ++m)
#pragma unroll
                for (int n = 0; n < 2; ++n) acc[a][b][m][n] = typename AccSel<MODE == 2>::T{};
    v8i32 At[4], B0[2], B1[2];
    const char* cA = (const char*)g.A + (size_t)cur.pm * tstep; const char* cB = (const char*)g.Bt + (size_t)cur.pn * tstep;
    S.a_ready(cur);
    PG8_STAGE(PG8_SB(0, 0), cB, voffB); PG8_STAGE(PG8_SA(0, 0), cA, voffA); PG8_STAGE(PG8_SB(0, 1), cB + hstep, voffB); PG8_STAGE(PG8_SA(0, 1), cA + hstep, voffA);
    if (wr == 1) PG8_BAR;
    PG8_WAIT_V(4); PG8_BAR;
    PG8_STAGE(PG8_SB(1, 0), cB + kstep, voffB); PG8_STAGE(PG8_SA(1, 0), cA + kstep, voffA); PG8_STAGE(PG8_SB(1, 1), cB + hstep + kstep, voffB);
    PG8_WAIT_V(6); PG8_BAR;
    PG8_STAMP();
    for (;;) {
        const bool has_next = S.next(ui + 1, nxt);
        const char* nA = has_next ? (const char*)g.A + (size_t)nxt.pm * tstep : cA; const char* nB = has_next ? (const char*)g.Bt + (size_t)nxt.pn * tstep : cB;
        for (int t = 0; t < nt; t += 2) {
            const bool last = (t == nt - 2);
            const char* a1 = cA + (size_t)(t + 1) * kstep;
            const char* a2 = last ? nA : cA + (size_t)(t + 2) * kstep; const char* b2 = last ? nB : cB + (size_t)(t + 2) * kstep;
            const char* a3 = a2 + kstep; const char* b3 = b2 + kstep;
            if (last && has_next) S.a_ready(nxt);
            PG8_LDB(B0, 0, 0); PG8_SCHED; PG8_LDA(At, 0, 0); PG8_STAGE(PG8_SA(1, 1), a1 + hstep, voffA);
            PG8_WAIT_L(8); PG8_BAR; PG8_WAIT_L(0); PG8_MMA(0, 0, At, B0); PG8_BAR; PG8_SCHED;
            PG8_LDB(B1, 0, 1); PG8_STAGE(PG8_SB(0, 0), b2, voffB);
            PG8_BAR; PG8_WAIT_L(0); PG8_MMA(0, 1, At, B1); PG8_BAR;
            PG8_LDA(At, 0, 1); PG8_STAGE(PG8_SA(0, 0), a2, voffA);
            PG8_BAR; PG8_WAIT_L(0); PG8_MMA(1, 0, At, B0); PG8_BAR; PG8_SCHED;
            PG8_STAGE(PG8_SB(0, 1), b2 + hstep, voffB);
            PG8_WAIT_V(6); PG8_BAR; PG8_MMA(1, 1, At, B1); PG8_BAR;
            PG8_LDB(B0, 1, 0); PG8_SCHED; PG8_LDA(At, 1, 0); PG8_STAGE(PG8_SA(0, 1), a2 + hstep, voffA);
            PG8_WAIT_L(8); PG8_BAR; PG8_WAIT_L(0); PG8_MMA(0, 0, At, B0); PG8_BAR; PG8_SCHED;
            PG8_LDB(B1, 1, 1); PG8_STAGE(PG8_SB(1, 0), b3, voffB);
            PG8_BAR; PG8_WAIT_L(0); PG8_MMA(0, 1, At, B1); PG8_BAR;
            PG8_LDA(At, 1, 1); PG8_STAGE(PG8_SA(1, 0), a3, voffA);
            PG8_BAR; PG8_WAIT_L(0); PG8_MMA(1, 0, At, B0); PG8_BAR; PG8_SCHED;
            PG8_STAGE(PG8_SB(1, 1), b3 + hstep, voffB);
            PG8_WAIT_V(6); PG8_BAR; PG8_MMA(1, 1, At, B1); PG8_BAR;
        }
        PG8_STAMP();
        asm volatile("s_nop 15\n\ts_nop 15" ::: "memory");
        if constexpr (!Epi::AFTER_DRAIN) { E(acc, cur, wr, wc, fr, fq); S.done(cur); }
        PG8_STAMP();
        if (!has_next) break;
#pragma unroll
        for (int a = 0; a < 2; ++a)
#pragma unroll
            for (int b = 0; b < 2; ++b)
#pragma unroll
                for (int m = 0; m < 4; ++m)
#pragma unroll
                    for (int n = 0; n < 2; ++n) acc[a][b][m][n] = typename AccSel<MODE == 2>::T{};
        cur = nxt; cA = nA; cB = nB; ++ui;
    }
    PG8_WAIT_V(0);
    if (wr == 0) PG8_BAR;
    PG8_BAR;
    if constexpr (Epi::AFTER_DRAIN) { E.fused(acc, cur, wr, wc, fr, fq, lds, wid, lane); S.done(cur); }
    PG8_STAMP();
    if (STAMP && wid == 0) { stamps[lane] = lane < nts ? (((unsigned long long)(unsigned)ts_hi << 32) | (unsigned)ts_lo) : 0ull;
        if (lane == 62) stamps[62] = rt_entry; if (lane == 63) stamps[63] = (unsigned long long)wall_clock64(); }
#undef PG8_STAMP
#undef PG8_SA
#undef PG8_SB
#undef PG8_STAGE
#undef PG8_LDA
#undef PG8_LDB
#undef PG8_LD8
#undef PG8_HALF
#undef PG8_HALFI
#undef PG8_MMA
#undef PG8_WAIT_V
#undef PG8_WAIT_L
#undef PG8_BAR
#undef PG8_SCHED
}
}

typedef const __attribute__((address_space(4))) Args* KArgs;
struct Frame {
    LAS unsigned char* lds; int tid, lane, wave, G, bid;
    KArgs ka;
};
#define PH_ARGS() int z_ = 0; asm volatile("" : "+v"(z_)); KArgs A_ = (KArgs)((const __attribute__((address_space(4))) char*)F.ka + __builtin_amdgcn_readfirstlane(z_)); unsigned char* const ws_ = A_->ws; (void)ws_
#define WSP(T_, off) ((T_*)(ws_ + (off)))

__device__ __forceinline__ int ropeperm64(int s) { const int j = s >> 3, i = s & 7; return i < 4 ? 4 * j + i : 32 + 4 * j + (i - 4); }
__device__ __forceinline__ int ropeperm32(int s) { const int j = s >> 3, i = s & 7; return i < 4 ? 4 * j + i : 16 + 4 * j + (i - 4); }
__device__ __forceinline__ int inproj_src(int n) {
    if (n < 384) return (n & ~63) + ropeperm64(n & 63);
    if (n < 512) return 384 + ((n - 384) & ~63) + ropeperm64((n - 384) & 63);
    if (n < 1920) return n;
    if (n < 2176) { const int m = n - 1920; return 1932 + (m & ~31) + ropeperm32(m & 31); }
    if (n < 2432) { const int m = n - 2176; return 2188 + (m & ~31) + ropeperm32(m & 31); }
    if (n < 2688) return 2444 + (n - 2432);
    if (n < 2700) return 1920 + (n - 2688);
    return -1;
}
__device__ __forceinline__ int gu_src(int n) { const int tile = n >> 8, r = n & 255; return r < 128 ? tile * 128 + r : DFF + tile * 128 + (r - 128); }

constexpr int CV_T0 = DEPTH * 44 * 16;
constexpr int CV_T1 = CV_T0 + DEPTH * 16 * 16;
constexpr int CV_T2 = CV_T1 + 2 * 88 * 16;
constexpr int CV_T3 = CV_T2 + 2 * 16 * 44;
constexpr int CV_T4 = CV_T3 + 16 * 88 * 16;
constexpr int CV_T5 = CV_T4 + 16 * 16 * 44;
constexpr int PA_MODJOBS = DEPTH * 96;
constexpr int PA_JOBS = CV_T5 + PA_MODJOBS + 1;

constexpr int CJ_TOTAL = 2 * (768 + 4464);
struct ConvTile { const float* src; unsigned char* dst; int Nsrc, K, esz; bool zero, skip; };
__device__ __forceinline__ void conv_desc(const Frame& F, KArgs A_, unsigned char* ws_, int job, ConvTile& t) {
    const float* W; bf16_t* dst; int Nsrc, K, kind, rt, kt, esz = 2; bool skip = false;
    const int half = job / 5232, li0 = 2 * half; int j = job - half * 5232;
    if (j < 768) {
        const int li = li0, jd = half;
        if (j < 176) { W = A_->in[I_WIN] + (size_t)li * D * D_IN; Nsrc = D_IN; dst = WSP(bf16_t, WS_WIN) + (size_t)li * LDP * D; K = D; kind = 0; rt = j % 11; kt = j / 11; skip = true; }
        else if (j < 240) { const int r = j - 176; W = A_->in[I_WOUT] + (size_t)li * D * D; Nsrc = D; dst = WSP(bf16_t, WS_WOUT) + (size_t)li * D * D; K = D; kind = 1; rt = r % 4; kt = r / 4; }
        else if (j < 592) { const int r = j - 240; W = A_->in[I_FFNGU] + (size_t)jd * D * 2 * DFF; Nsrc = 2 * DFF; dst = WSP(bf16_t, WS_WGU) + (size_t)jd * 2 * DFF * D; K = D; kind = 2; rt = r % 22; kt = r / 22; skip = true; }
        else { const int r = j - 592; W = A_->in[I_FFND] + (size_t)jd * DFF * D; Nsrc = D; dst = WSP(bf16_t, WS_WD) + (size_t)jd * D * DFF; K = DFF; kind = 1; rt = r % 4; kt = r / 4; esz = 1; }
    } else {
        const int li = li0 + 1, jm = half; j -= 768;
        if (j < 176) { W = A_->in[I_WIN] + (size_t)li * D * D_IN; Nsrc = D_IN; dst = WSP(bf16_t, WS_WIN) + (size_t)li * LDP * D; K = D; kind = 0; rt = j % 11; kt = j / 11; skip = true; }
        else if (j < 240) { const int r = j - 176; W = A_->in[I_WOUT] + (size_t)li * D * D; Nsrc = D; dst = WSP(bf16_t, WS_WOUT) + (size_t)li * D * D; K = D; kind = 1; rt = r % 4; kt = r / 4; }
        else if (j < 240 + 8 * 352) { const int q = j - 240, e = q / 352, m = jm * 8 + e, r = q % 352; W = A_->in[I_EGU] + (size_t)m * D * 2 * DFF; Nsrc = 2 * DFF; dst = WSP(bf16_t, WS_WGUE) + (size_t)jm * 8 * 2 * DFF * D + (size_t)e * DFF * D; K = D; kind = 2; rt = r % 22; kt = r / 22; esz = 1; skip = true; }
        else { const int q = j - 240 - 8 * 352, e = q / 176, m = jm * 8 + e, r = q % 176; W = A_->in[I_ED] + (size_t)m * DFF * D; Nsrc = D; dst = WSP(bf16_t, WS_WDE) + (size_t)jm * 8 * D * DFF + (size_t)e * (D * DFF / 2); K = DFF; kind = 1; rt = r % 4; kt = r / 4; esz = 1; }
    }
    const int nd = rt * 256 + (F.tid & 255);
    const int sc = kind == 0 ? inproj_src(nd) : (kind == 2 ? gu_src(nd) : nd);
    t.src = W + (size_t)(kt * 64 + (F.tid >> 8)) * Nsrc + (sc >= 0 ? sc : 0);
    t.dst = (unsigned char*)dst + ((size_t)(rt * 256 + (F.tid >> 3)) * K + kt * 64 + (F.tid & 7) * 8) * esz;
    t.Nsrc = Nsrc; t.K = K; t.esz = esz; t.zero = sc < 0; t.skip = skip;
}
__device__ __forceinline__ void conv_load(const ConvTile& t, float (&v)[32]) {
    if (t.skip) return;
#pragma unroll
    for (int i = 0; i < 32; ++i) v[i] = __builtin_nontemporal_load(t.src + (size_t)(2 * i) * t.Nsrc);
}
__device__ __forceinline__ void conv_finish(const Frame& F, const ConvTile& t, const float (&v)[32]) {
    if (t.skip) return;
    LAS float* tile = (LAS float*)F.lds;
    const int n = F.tid & 255, kk0 = F.tid >> 8;
#pragma unroll
    for (int i = 0; i < 32; ++i) tile[(kk0 + 2 * i) * 257 + n] = t.zero ? 0.f : v[i];
    __syncthreads();
    { const int nn = F.tid >> 3, kq = F.tid & 7;
#pragma unroll
      for (int i = 0; i < 4; ++i) { float o[8];
#pragma unroll
          for (int j = 0; j < 8; ++j) o[j] = tile[(kq * 8 + j) * 257 + nn + 64 * i];
          if (t.esz == 2) { u32x4 w; w.x = pk_bf16(o[0], o[1]); w.y = pk_bf16(o[2], o[3]); w.z = pk_bf16(o[4], o[5]); w.w = pk_bf16(o[6], o[7]);
              __builtin_nontemporal_store(w, (u32x4*)(t.dst + (size_t)(64 * i) * t.K * 2)); }
          else { int w0 = 0, w1 = 0;
              w0 = __builtin_amdgcn_cvt_pk_fp8_f32(o[0] * 64.f, o[1] * 64.f, w0, false); w0 = __builtin_amdgcn_cvt_pk_fp8_f32(o[2] * 64.f, o[3] * 64.f, w0, true);
              w1 = __builtin_amdgcn_cvt_pk_fp8_f32(o[4] * 64.f, o[5] * 64.f, w1, false); w1 = __builtin_amdgcn_cvt_pk_fp8_f32(o[6] * 64.f, o[7] * 64.f, w1, true);
              __builtin_nontemporal_store((u32x2){(unsigned)w0, (unsigned)w1}, (u32x2*)(t.dst + (size_t)(64 * i) * t.K)); } } }
    __syncthreads();
}

constexpr int SJ_PER_MAT = 44, SJ_GU = 18 * SJ_PER_MAT, SJ_TOTAL = SJ_GU + DEPTH * 22;
__device__ __forceinline__ void strip_job(const Frame& F, KArgs A_, unsigned char* ws_, int job) {
    const bool isin = job >= SJ_GU;
    const int m = isin ? (job - SJ_GU) / 22 : job / SJ_PER_MAT, st = isin ? (job - SJ_GU) % 22 : job % SJ_PER_MAT;
    const float* W = isin ? A_->in[I_WIN] + (size_t)m * D * D_IN : (m < 2 ? A_->in[I_FFNGU] + (size_t)m * D * 2 * DFF : A_->in[I_EGU] + (size_t)(m - 2) * D * 2 * DFF);
    const int Nsrc = isin ? D_IN : 2 * DFF;
    unsigned char* dst = isin ? WSP(unsigned char, WS_WIN) + (size_t)m * LDP * D * 2
                       : (m < 2 ? WSP(unsigned char, WS_WGU) + (size_t)m * 2 * DFF * D * 2
                                : WSP(unsigned char, WS_WGUE) + (size_t)((m - 2) >> 3) * 8 * 2 * DFF * D * 2 + (size_t)((m - 2) & 7) * 2 * DFF * D);
    float* wsc = isin ? WSP(float, WS_WSC) + (size_t)18 * 2 * DFF + (size_t)m * LDP : WSP(float, WS_WSC) + (size_t)m * 2 * DFF;
    LAS float* pmx = (LAS float*)F.lds;
    const int cg = F.tid & 31, kq = F.tid >> 5;
    const int nd = st * 128 + 4 * cg, sc0 = isin ? inproj_src(nd) : gu_src(nd), sc = sc0 < 0 ? 0 : sc0;
    const float* wp = W + (size_t)(64 * kq) * Nsrc + sc;
    unsigned pk[4][32];
    float mx[4] = {0.f, 0.f, 0.f, 0.f};
#pragma unroll
    for (int i0 = 0; i0 < 64; i0 += 16) { f32x4 v[16];
#pragma unroll
        for (int i = 0; i < 16; ++i) { v[i] = __builtin_nontemporal_load((const f32x4*)(wp + (size_t)(i0 + i) * Nsrc)); if (sc0 < 0) v[i] = (f32x4){0.f, 0.f, 0.f, 0.f}; }
#pragma unroll
        for (int i = 0; i < 16; i += 2)
#pragma unroll
            for (int c = 0; c < 4; ++c) { mx[c] = fmaxf(mx[c], fmaxf(fabsf(v[i][c]), fabsf(v[i + 1][c]))); pk[c][(i0 + i) >> 1] = pk_bf16(v[i][c], v[i + 1][c]); } }
    __syncthreads();
#pragma unroll
    for (int c = 0; c < 4; ++c) pmx[kq * 128 + 4 * cg + c] = mx[c];
    __syncthreads();
    if (F.tid < 128) { float a = pmx[F.tid];
#pragma unroll
        for (int q = 1; q < 16; ++q) a = fmaxf(a, pmx[q * 128 + F.tid]);
        const float scl = a > 0.f ? a * (1.0f / 127.0f) : 1.0f;
        wsc[st * 128 + F.tid] = scl; pmx[2048 + F.tid] = 1.0f / scl; }
    __syncthreads();
#pragma unroll
    for (int c = 0; c < 4; ++c) { const float inv = pmx[2048 + 4 * cg + c];
        unsigned char* dp = dst + (size_t)(nd + c) * D + 64 * kq;
#pragma unroll
        for (int j = 0; j < 4; ++j) { unsigned o[4];
#pragma unroll
            for (int q = 0; q < 4; ++q) { const unsigned a = pk[c][8 * j + 2 * q], bq = pk[c][8 * j + 2 * q + 1];
                const int q0 = (int)rintf(__uint_as_float(a << 16) * inv), q1 = (int)rintf(__uint_as_float(a & 0xffff0000u) * inv), q2 = (int)rintf(__uint_as_float(bq << 16) * inv), q3 = (int)rintf(__uint_as_float(bq & 0xffff0000u) * inv);
                o[q] = (unsigned)(q0 & 0xff) | ((unsigned)(q1 & 0xff) << 8) | ((unsigned)(q2 & 0xff) << 16) | ((unsigned)(q3 & 0xff) << 24); }
            *(u32x4*)(dp + 16 * j) = (u32x4){o[0], o[1], o[2], o[3]}; } }
}

__device__ __forceinline__ void phase_pre_a(const Frame& F) {
    PH_ARGS();
    { ConvTile t0, t1; float v0[32], v1[32];
      int j = F.bid;
      if (j < CJ_TOTAL) { conv_desc(F, A_, ws_, j, t0); conv_load(t0, v0); }
      while (j < CJ_TOTAL) {
          const int jn = j + F.G;
          if (jn < CJ_TOTAL) { conv_desc(F, A_, ws_, jn, t1); conv_load(t1, v1); }
          conv_finish(F, t0, v0);
          t0 = t1;
#pragma unroll
          for (int i = 0; i < 32; ++i) v0[i] = v1[i];
          j = jn;
      } }
    for (int j = F.bid; j < SJ_TOTAL; j += F.G) strip_job(F, A_, ws_, j);
    __syncthreads();
    for (int job = CV_T5 + F.bid; job < PA_JOBS; job += F.G) {
        if (job < CV_T5) {
        } else if (job < CV_T5 + PA_MODJOBS) {

            const int q = job - CV_T5, li = q / 96, cb = q % 96;
            LAS float* act = (LAS float*)F.lds;
            LAS float* part = act + 9 * 1024;
            for (int i = F.tid; i < 9 * 1024; i += 512) { const int r = i >> 10, k = i & 1023; const float cv = r < 8 ? A_->in[I_C][r * 1024 + k] : A_->in[I_CCTX][k]; act[i] = cv / (1.0f + expf(-cv)); }
            __syncthreads();
            float acc[9];
#pragma unroll
            for (int r = 0; r < 9; ++r) acc[r] = 0.f;
            const float* wp = A_->in[I_WADA] + (size_t)li * D * 6144 + cb * 64 + F.lane;
            for (int k0 = F.wave * 128; k0 < F.wave * 128 + 128; k0 += 16) { float wv[16];
#pragma unroll
                for (int u = 0; u < 16; ++u) wv[u] = wp[(size_t)(k0 + u) * 6144];
#pragma unroll
                for (int u = 0; u < 16; ++u)
#pragma unroll
                    for (int r = 0; r < 9; ++r) acc[r] += act[r * 1024 + k0 + u] * wv[u]; }
#pragma unroll
            for (int r = 0; r < 9; ++r) part[(F.wave * 9 + r) * 64 + F.lane] = acc[r];
            __syncthreads();
            for (int i = F.tid; i < 9 * 64; i += 512) { const int r = i >> 6, l = i & 63; float s = A_->in[I_BADA][li * 6144 + cb * 64 + l];
#pragma unroll
                for (int w = 0; w < 8; ++w) s += part[(w * 9 + r) * 64 + l];
                WSP(float, WS_MOD)[(size_t)(li * 9 + r) * 6144 + cb * 64 + l] = s; }
            __syncthreads();
        } else {
            float* cA = WSP(float, WS_ROPE); float* sA = cA + 2048 * 32; float* cC = sA + 2048 * 32; float* sC = cC + 2048 * 16;
            for (int idx = F.tid; idx < 2048 * 48; idx += 512) {
                const int pos = idx / 48, p = idx % 48; const float rowf = (float)(pos >> 6), colf = (float)(pos & 63);
                if (p < 32) { const int i = p & 15; const float inv = exp2f(-(float)i * (13.287712379549449f / 16.0f)); const float ang = (p < 16 ? rowf : colf) * inv; cA[pos * 32 + p] = __cosf(ang); sA[pos * 32 + p] = __sinf(ang); }
                else { const int pp = p - 32, i = pp & 7; const float inv = exp2f(-(float)i * (13.287712379549449f / 8.0f)); const float ang = (pp < 8 ? rowf : colf) * inv; cC[pos * 16 + pp] = __cosf(ang); sC[pos * 16 + pp] = __sinf(ang); }
            }
        }
    }
}

__device__ __forceinline__ void row_load(float (&v)[16], const float* p, int lane) {
#pragma unroll
    for (int i = 0; i < 2; ++i) { const f32x4 x = *(const f32x4*)(p + 512 * i + 8 * lane), y = *(const f32x4*)(p + 512 * i + 8 * lane + 4);
        v[8 * i] = x[0]; v[8 * i + 1] = x[1]; v[8 * i + 2] = x[2]; v[8 * i + 3] = x[3]; v[8 * i + 4] = y[0]; v[8 * i + 5] = y[1]; v[8 * i + 6] = y[2]; v[8 * i + 7] = y[3]; }
}
__device__ __forceinline__ void row_load_bf16(float (&v)[16], const bf16_t* p, int lane) {
#pragma unroll
    for (int i = 0; i < 2; ++i) { const u32x4 x = *(const u32x4*)(p + 512 * i + 8 * lane);
        v[8 * i] = __uint_as_float(x.x << 16); v[8 * i + 1] = __uint_as_float(x.x & 0xffff0000u); v[8 * i + 2] = __uint_as_float(x.y << 16); v[8 * i + 3] = __uint_as_float(x.y & 0xffff0000u);
        v[8 * i + 4] = __uint_as_float(x.z << 16); v[8 * i + 5] = __uint_as_float(x.z & 0xffff0000u); v[8 * i + 6] = __uint_as_float(x.w << 16); v[8 * i + 7] = __uint_as_float(x.w & 0xffff0000u); }
}
__device__ __forceinline__ void row_store(const float (&v)[16], float* p, int lane) {
#pragma unroll
    for (int i = 0; i < 2; ++i) { *(f32x4*)(p + 512 * i + 8 * lane) = (f32x4){v[8 * i], v[8 * i + 1], v[8 * i + 2], v[8 * i + 3]}; *(f32x4*)(p + 512 * i + 8 * lane + 4) = (f32x4){v[8 * i + 4], v[8 * i + 5], v[8 * i + 6], v[8 * i + 7]}; }
}
__device__ __forceinline__ void row_store_bf16(const float (&v)[16], bf16_t* p, int lane) {
#pragma unroll
    for (int i = 0; i < 2; ++i) { u32x4 w; w.x = pk_bf16(v[8 * i], v[8 * i + 1]); w.y = pk_bf16(v[8 * i + 2], v[8 * i + 3]); w.z = pk_bf16(v[8 * i + 4], v[8 * i + 5]); w.w = pk_bf16(v[8 * i + 6], v[8 * i + 7]); *(u32x4*)(p + 512 * i + 8 * lane) = w; }
}
__device__ __forceinline__ void row_store_fp8(const float (&v)[16], unsigned char* p, int lane) {
#pragma unroll
    for (int i = 0; i < 2; ++i) { int w0 = 0, w1 = 0; float c[8];
#pragma unroll
        for (int j = 0; j < 8; ++j) c[j] = __builtin_amdgcn_fmed3f(v[8 * i + j], -448.f, 448.f);
        w0 = __builtin_amdgcn_cvt_pk_fp8_f32(c[0], c[1], w0, false); w0 = __builtin_amdgcn_cvt_pk_fp8_f32(c[2], c[3], w0, true);
        w1 = __builtin_amdgcn_cvt_pk_fp8_f32(c[4], c[5], w1, false); w1 = __builtin_amdgcn_cvt_pk_fp8_f32(c[6], c[7], w1, true);
        *(u32x2*)(p + 512 * i + 8 * lane) = (u32x2){(unsigned)w0, (unsigned)w1}; }
}
__device__ __forceinline__ float row_store_i8(const float (&v)[16], unsigned char* p, int lane) {
    float a = 0.f;
#pragma unroll
    for (int i = 0; i < 16; ++i) a = fmaxf(a, fabsf(v[i]));
#pragma unroll
    for (int o = 32; o >= 1; o >>= 1) a = fmaxf(a, __shfl_xor(a, o));
    const float scl = a > 0.f ? a * (1.0f / 127.0f) : 1.0f, inv = 1.0f / scl;
#pragma unroll
    for (int i = 0; i < 2; ++i) { unsigned w[2];
#pragma unroll
        for (int q = 0; q < 2; ++q) { const int q0 = (int)rintf(v[8 * i + 4 * q] * inv), q1 = (int)rintf(v[8 * i + 4 * q + 1] * inv), q2 = (int)rintf(v[8 * i + 4 * q + 2] * inv), q3 = (int)rintf(v[8 * i + 4 * q + 3] * inv);
            w[q] = (unsigned)(q0 & 0xff) | ((unsigned)(q1 & 0xff) << 8) | ((unsigned)(q2 & 0xff) << 16) | ((unsigned)(q3 & 0xff) << 24); }
        *(u32x2*)(p + 512 * i + 8 * lane) = (u32x2){w[0], w[1]}; }
    return scl;
}
__device__ __forceinline__ void row_ln(float (&v)[16]) {
    float s = 0.f;
#pragma unroll
    for (int i = 0; i < 16; ++i) s += v[i];
    const float mean = wave_sum(s) * (1.0f / 1024.0f);
    float q = 0.f;
#pragma unroll
    for (int i = 0; i < 16; ++i) { v[i] -= mean; q += v[i] * v[i]; }
    const float rstd = rsqrtf(wave_sum(q) * (1.0f / 1024.0f) + LN_EPS);
#pragma unroll
    for (int i = 0; i < 16; ++i) v[i] *= rstd;
}
__device__ __forceinline__ void row_modulate(const float (&v)[16], float (&h)[16], const float* shift, const float* scale, int lane) {
    float sh[16], sc[16]; row_load(sh, shift, lane); row_load(sc, scale, lane);
#pragma unroll
    for (int i = 0; i < 16; ++i) h[i] = v[i] * (1.0f + sc[i]) + sh[i];
}
__device__ __forceinline__ const float* mod_row(unsigned char* ws_, int li, int row) { const int b = row / TB, t = row - b * TB; return WSP(float, WS_MOD) + (size_t)(li * 9 + (t < NCTX ? 8 : b)) * 6144; }

__device__ __forceinline__ void phase_pre_b(const Frame& F) {
    PH_ARGS();
    const int stride = F.G * 8;
    int row = F.bid * 8 + F.wave;
    float cur[16], nxt[16];
#define PB_SRC(r_) ((r_) % TB < NCTX ? A_->in[I_CTX] + (size_t)(((r_) / TB) * NCTX + (r_) % TB) * D : A_->in[I_X] + (size_t)(((r_) / TB) * SEQ + ((r_) % TB - NCTX)) * D)
    if (row < T) row_load(cur, PB_SRC(row), F.lane);
    while (row < T) {
        const int nr = row + stride;
        if (nr < T) row_load(nxt, PB_SRC(nr), F.lane);
        float h[16]; row_store(cur, WSP(float, WS_X) + (size_t)row * D, F.lane);
        row_ln(cur); const float* md = mod_row(ws_, 0, row); row_modulate(cur, h, md, md + 1024, F.lane);
        { const float scl = row_store_i8(h, WSP(unsigned char, WS_H) + (size_t)row * D, F.lane); if (F.lane == 0) WSP(float, WS_RSC)[row] = scl; }
#pragma unroll
        for (int i = 0; i < 16; ++i) cur[i] = nxt[i];
        row = nr;
    }
#undef PB_SRC
}

__device__ __forceinline__ void phase_post_mixer(const Frame& F, int li) {
    PH_ARGS(); const bool moe = li & 1; const int jm = li >> 1;
    const bool skip_ctx = li == DEPTH - 1;
    LAS float* wr = (LAS float*)F.lds;
    if (moe) { for (int i = F.tid; i < 1024 * 8; i += 512) wr[(i & 7) * 1024 + (i >> 3)] = A_->in[I_RW][(size_t)jm * 8192 + i]; __syncthreads(); }
    unsigned* cnt = (unsigned*)(ws_ + WS_CTL + CTL_CNT_OFF);
    LAS unsigned* bcnt = (LAS unsigned*)(wr + 8192);
    LAS unsigned* rtab = bcnt + 16;
    LAS float* rwt = (LAS float*)(rtab + 8 * 16 * 4);
    if (moe) { if (F.tid < 16) bcnt[F.tid] = 0u; __syncthreads(); }
    const int stride = F.G * 8;
    int row = F.bid * 8 + F.wave, rix = 0;
    float v[16], o[16], vn[16], on[16];
#define PM_LIVE(r_) ((r_) < T && !(skip_ctx && (r_) % TB < NCTX))
    if (PM_LIVE(row)) { row_load(v, WSP(float, WS_X) + (size_t)row * D, F.lane); row_load_bf16(o, WSP(bf16_t, WS_O) + (size_t)row * D, F.lane); }
    while (row < T) {
        const int nr = row + stride;
        if (PM_LIVE(nr)) { row_load(vn, WSP(float, WS_X) + (size_t)nr * D, F.lane); row_load_bf16(on, WSP(bf16_t, WS_O) + (size_t)nr * D, F.lane); }
        if (PM_LIVE(row)) {
        const float* md = mod_row(ws_, li, row);
        float g[16], lg1[16], lb1[16];
        row_load(g, md + 2048, F.lane); row_load(lg1, A_->in[I_LN1G] + li * D, F.lane); row_load(lb1, A_->in[I_LN1B] + li * D, F.lane);
#pragma unroll
        for (int i = 0; i < 16; ++i) v[i] = ALPHA_RES * v[i] + g[i] * o[i];
        row_ln(v);
#pragma unroll
        for (int i = 0; i < 16; ++i) v[i] = v[i] * lg1[i] + lb1[i];
        row_store(v, WSP(float, WS_X) + (size_t)row * D, F.lane);
        row_ln(v);
        float h[16]; row_modulate(v, h, md + 3072, md + 4096, F.lane);
        if (!moe) { const float scl = row_store_i8(h, WSP(unsigned char, WS_H) + (size_t)row * D, F.lane); if (F.lane == 0) WSP(float, WS_RSC)[row] = scl; }
        else {
        float lg[8];
#pragma unroll
        for (int e = 0; e < 8; ++e) lg[e] = 0.f;
#pragma unroll
        for (int e = 0; e < 8; ++e)
#pragma unroll
            for (int i = 0; i < 2; ++i) { const f32x4 w0 = *(const LAS f32x4*)(wr + e * 1024 + 512 * i + 8 * F.lane), w1 = *(const LAS f32x4*)(wr + e * 1024 + 512 * i + 8 * F.lane + 4);
                lg[e] += (h[8 * i] * w0[0] + h[8 * i + 1] * w0[1]) + (h[8 * i + 2] * w0[2] + h[8 * i + 3] * w0[3]) + (h[8 * i + 4] * w1[0] + h[8 * i + 5] * w1[1]) + (h[8 * i + 6] * w1[2] + h[8 * i + 7] * w1[3]); }
#pragma unroll
        for (int e = 0; e < 8; ++e) lg[e] = wave_sum(lg[e]) + A_->in[I_RB][jm * 8 + e];
        int e1 = 0; float v1 = lg[0];
#pragma unroll
        for (int e = 1; e < 8; ++e) if (lg[e] > v1) { v1 = lg[e]; e1 = e; }
        int e2 = -1; float v2 = -3.0e38f;
#pragma unroll
        for (int e = 0; e < 8; ++e) if (e != e1 && lg[e] > v2) { v2 = lg[e]; e2 = e; }
        if (e2 < 0) { e2 = e1 == 0 ? 1 : 0; v2 = v1; }
        const float w2 = 1.0f / (1.0f + expf(v1 - v2)), w1 = 1.0f - w2;
        { const float scl = row_store_i8(h, WSP(unsigned char, WS_H) + (size_t)row * D, F.lane); if (F.lane == 0) WSP(float, WS_RSC)[row] = scl; }
        if (F.lane == 0) { const unsigned q1 = atomicAdd((unsigned*)(bcnt + e1), 1u), q2 = atomicAdd((unsigned*)(bcnt + e2), 1u);
            LAS unsigned* te = rtab + (F.wave * 16 + rix) * 4; te[0] = e1; te[1] = q1; te[2] = e2; te[3] = q2; rwt[(F.wave * 16 + rix) * 2] = w1; rwt[(F.wave * 16 + rix) * 2 + 1] = w2; }
        }
        }
        ++rix;
#pragma unroll
        for (int i = 0; i < 16; ++i) { v[i] = vn[i]; o[i] = on[i]; }
        row = nr;
    }
    if (moe) {
        __syncthreads();
        if (F.tid < 8) bcnt[8 + F.tid] = atomicAdd(&cnt[(jm * 8 + F.tid) * 64], bcnt[F.tid]);
        asm volatile("s_waitcnt vmcnt(0)" ::: "memory");
        __syncthreads();
        int r2 = F.bid * 8 + F.wave;
        for (int i = 0; i < rix; ++i, r2 += stride) {
            if (!PM_LIVE(r2)) continue;
            const LAS unsigned* te = rtab + (F.wave * 16 + i) * 4;
            const unsigned e1 = te[0], p1 = bcnt[8 + e1] + te[1], e2 = te[2], p2 = bcnt[8 + e2] + te[3];
            const unsigned char* src = WSP(unsigned char, WS_H) + (size_t)r2 * D + 16 * F.lane;
            const u32x4 hv = *(const u32x4*)src;
            *(u32x4*)(WSP(unsigned char, WS_HP) + ((size_t)e1 * MOE_CAP + p1) * D + 16 * F.lane) = hv;
            *(u32x4*)(WSP(unsigned char, WS_HP) + ((size_t)e2 * MOE_CAP + p2) * D + 16 * F.lane) = hv;
            if (F.lane == 0) { const float scl = WSP(float, WS_RSC)[r2]; WSP(float, WS_HPS)[(size_t)e1 * MOE_CAP + p1] = scl; WSP(float, WS_HPS)[(size_t)e2 * MOE_CAP + p2] = scl; }
            if (F.lane == 0) { unsigned* tk = WSP(unsigned, WS_TOK) + (size_t)r2 * 8; tk[0] = e1; tk[1] = p1; tk[2] = e2; tk[3] = p2; tk[4] = __float_as_uint(rwt[(F.wave * 16 + i) * 2]); tk[5] = __float_as_uint(rwt[(F.wave * 16 + i) * 2 + 1]); }
        }
    }
#undef PM_LIVE
}

__device__ __forceinline__ void phase_post_ffn(const Frame& F, int li) {
    PH_ARGS(); const bool moe = li & 1; const int jm = li >> 1; const bool last = li == DEPTH - 1;
    int tb[8];
    if (moe) { const unsigned* cnt = (const unsigned*)(ws_ + WS_CTL + CTL_CNT_OFF); int acc = 0;
#pragma unroll
        for (int e = 0; e < 8; ++e) { tb[e] = acc; acc += ((int)cnt[(jm * 8 + e) * 64] + 255) >> 8; } }
    const int stride = F.G * 8;
    int row = F.bid * 8 + F.wave;
    float v[16], f[16], vn[16], fn[16];
#define PF_LIVE(r_) ((r_) < T && !(last && (r_) % TB < NCTX))
#define PF_LOAD(r_, v_, f_) do { row_load(v_, WSP(float, WS_X) + (size_t)(r_) * D, F.lane); \
        if (!moe) row_load_bf16(f_, WSP(bf16_t, WS_O) + (size_t)(r_) * D, F.lane); \
        else { const unsigned* tk = WSP(unsigned, WS_TOK) + (size_t)(r_) * 8; \
            const int e1 = tk[0], p1 = tk[1], e2 = tk[2], p2 = tk[3]; const float w1 = __uint_as_float(tk[4]), w2 = __uint_as_float(tk[5]); \
            int b1 = 0, b2 = 0; \
            _Pragma("unroll") for (int e = 0; e < 8; ++e) { b1 = e1 == e ? tb[e] : b1; b2 = e2 == e ? tb[e] : b2; } \
            float f2[16]; \
            row_load_bf16(f_, WSP(bf16_t, WS_HP) + ((size_t)b1 * 256 + p1) * D, F.lane); row_load_bf16(f2, WSP(bf16_t, WS_HP) + ((size_t)b2 * 256 + p2) * D, F.lane); \
            _Pragma("unroll") for (int i = 0; i < 16; ++i) f_[i] = w1 * f_[i] + w2 * f2[i]; } } while (0)
    if (PF_LIVE(row)) PF_LOAD(row, v, f);
    while (row < T) {
        const int nr = row + stride;
        if (PF_LIVE(nr)) PF_LOAD(nr, vn, fn);
        if (PF_LIVE(row)) {
        const int b = row / TB, t = row - b * TB;
        const float* md = mod_row(ws_, li, row);
        float g[16], lg2[16], lb2[16];
        row_load(g, md + 5120, F.lane); row_load(lg2, A_->in[I_LN2G] + li * D, F.lane); row_load(lb2, A_->in[I_LN2B] + li * D, F.lane);
#pragma unroll
        for (int i = 0; i < 16; ++i) v[i] = ALPHA_RES * v[i] + g[i] * f[i];
        row_ln(v);
#pragma unroll
        for (int i = 0; i < 16; ++i) v[i] = v[i] * lg2[i] + lb2[i];
        if (last) row_store(v, A_->out + (size_t)(b * SEQ + (t - NCTX)) * D, F.lane);
        else {
        row_store(v, WSP(float, WS_X) + (size_t)row * D, F.lane);
        row_ln(v);
        const float* mdn = mod_row(ws_, li + 1, row);
        float h[16]; row_modulate(v, h, mdn, mdn + 1024, F.lane);
        { const float scl = row_store_i8(h, WSP(unsigned char, WS_H) + (size_t)row * D, F.lane); if (F.lane == 0) WSP(float, WS_RSC)[row] = scl; }
        }
        }
#pragma unroll
        for (int i = 0; i < 16; ++i) { v[i] = vn[i]; f[i] = fn[i]; }
        row = nr;
    }
#undef PF_LIVE
#undef PF_LOAD
}

__device__ __forceinline__ bf16x8 lds_frag(const LAS bf16_t* base, int ld, int row0, int k0, int lane) {
    return *(const LAS bf16x8*)(base + (row0 + (lane & 15)) * ld + k0 + 8 * (lane >> 4));
}
#define MFMA16(a, b, c) __builtin_amdgcn_mfma_f32_16x16x32_bf16((a), (b), (c), 0, 0, 0)

constexpr int LDT = 136;


typedef float f32x16 __attribute__((ext_vector_type(16)));
#define MFMA32(a, b, c) __builtin_amdgcn_mfma_f32_32x32x16_bf16((a), (b), (c), 0, 0, 0)
constexpr int LD2 = 72;
constexpr int AT2_TILE = 64 * LD2;
constexpr float M_INIT = -10000.0f;

template <int NMAP> struct At2State { float m[NMAP], l[NMAP]; f32x16 O[NMAP][2]; };

template <int NMAP, int DQK, bool WINDOW>
__device__ __forceinline__ void at2_step(const LAS bf16_t* Kt, const LAS bf16_t* Vt, const bf16x8 (&qf)[NMAP][DQK / 16], At2State<NMAP>& st, float c2, bool on0, bool on1, int tq, int tk0, int lane) {
    const int r = lane & 31, h = lane >> 5;
    bf16x8 kf[NMAP][2][DQK / 16];
#pragma unroll
    for (int mp = 0; mp < NMAP; ++mp)
#pragma unroll
        for (int t2 = 0; t2 < 2; ++t2)
#pragma unroll
            for (int sx = 0; sx < DQK / 16; ++sx) kf[mp][t2][sx] = *(const LAS bf16x8*)(Kt + (32 * t2 + r) * LD2 + mp * DQK + 16 * sx + 8 * h);
    __builtin_amdgcn_sched_barrier(0);
    f32x16 s[NMAP][2];
#pragma unroll
    for (int mp = 0; mp < NMAP; ++mp)
#pragma unroll
        for (int t2 = 0; t2 < 2; ++t2) {
            f32x16 acc;
#pragma unroll
            for (int i = 0; i < 16; ++i) acc[i] = 0.f;
#pragma unroll
            for (int sx = 0; sx < DQK / 16; ++sx) acc = MFMA32(kf[mp][t2][sx], qf[mp][sx], acc);
            s[mp][t2] = acc;
        }
    bf16x8 vf[2][4];
#pragma unroll
    for (int dt = 0; dt < 2; ++dt)
#pragma unroll
        for (int ks = 0; ks < 4; ++ks) vf[dt][ks] = *(const LAS bf16x8*)(Vt + (32 * dt + r) * LD2 + 16 * ks + 8 * h);
    bf16x8 pf[NMAP][4];
#pragma unroll
    for (int mp = 0; mp < NMAP; ++mp) {
#pragma unroll
        for (int t2 = 0; t2 < 2; ++t2) {
            const bool on = t2 ? on1 : on0;
            if (!on) {
#pragma unroll
                for (int i = 0; i < 16; ++i) s[mp][t2][i] = -1.0e30f;
            } else if (WINDOW) {
#pragma unroll
                for (int i = 0; i < 16; ++i) { const int d = tq - (tk0 + 32 * t2 + (i & 3) + 8 * (i >> 2) + 4 * h); if (d > 128 || d < -128) s[mp][t2][i] = -1.0e30f; }
            }
        }
        float mx = fmaxf(s[mp][0][0], s[mp][1][0]);
#pragma unroll
        for (int t2 = 0; t2 < 2; ++t2) {
            mx = fmaxf(mx, s[mp][t2][1]);
#pragma unroll
            for (int i = 2; i < 16; i += 2) mx = fmaxf(fmaxf(mx, s[mp][t2][i]), s[mp][t2][i + 1]);
        }
        mx = fmaxf(mx, __shfl_xor(mx, 32));
        const float mnew = fmaxf(st.m[mp], mx * c2), al = fast_exp2(st.m[mp] - mnew);
        st.m[mp] = mnew;
        float ls = 0.f;
#pragma unroll
        for (int t2 = 0; t2 < 2; ++t2)
#pragma unroll
            for (int i = 0; i < 16; ++i) { const float p = fast_exp2(fmaf(s[mp][t2][i], c2, -mnew)); ls += p; s[mp][t2][i] = p; }
        st.l[mp] = st.l[mp] * al + ls;
        if (__builtin_amdgcn_ballot_w64(al != 1.0f) != 0ull) {
#pragma unroll
            for (int dt = 0; dt < 2; ++dt)
#pragma unroll
                for (int i = 0; i < 16; ++i) st.O[mp][dt][i] *= al;
        }
#pragma unroll
        for (int ks = 0; ks < 4; ++ks) { const f32x16& sv = s[mp][ks >> 1]; const int o = 8 * (ks & 1); u32x4 w;
            w.x = pk_bf16(sv[o + 0], sv[o + 1]); w.y = pk_bf16(sv[o + 2], sv[o + 3]); w.z = pk_bf16(sv[o + 4], sv[o + 5]); w.w = pk_bf16(sv[o + 6], sv[o + 7]);
            pf[mp][ks] = __builtin_bit_cast(bf16x8, w); }
    }
#pragma unroll
    for (int ks = 0; ks < 4; ++ks) {
        const bool on = (ks >> 1) ? on1 : on0;
        if (on) {
#pragma unroll
            for (int dt = 0; dt < 2; ++dt)
#pragma unroll
                for (int mp = 0; mp < NMAP; ++mp) st.O[mp][dt] = MFMA32(vf[dt][ks], pf[mp][ks], st.O[mp][dt]);
        }
    }
}
__device__ __forceinline__ int perm16(int k) { return 8 * ((k >> 2) & 1) + 4 * (k >> 3) + (k & 3); }

__device__ __forceinline__ void attn_c2_unit(const Frame& F, int li, int unit) {
    PH_ARGS();
    const bool ctxq = unit >= NB * 4 * 8;
    int b, h, t0;
    if (!ctxq) { b = unit >> 5; h = (unit >> 3) & 3; t0 = NCTX + (unit & 7) * 256; } else { const int u = unit - NB * 4 * 8; b = u >> 2; h = u & 3; t0 = 0; }
    const int nsteps = ctxq ? NCTX / 64 : TB / 64;
    const int rb = b * TB, r = F.lane & 31, hh = F.lane >> 5;
    const float c2 = 0.17677669529663687f * LOG2E;
    const float lam_init = 0.8f - 0.6f * expf(-0.3f * (float)li);
    float d0 = 0.f, d1 = 0.f;
    if (F.lane < 32) { d0 = A_->in[I_LAMQ][li * 64 + F.lane] * A_->in[I_LAMK][li * 64 + F.lane]; d1 = A_->in[I_LAMQ][li * 64 + 32 + F.lane] * A_->in[I_LAMK][li * 64 + 32 + F.lane]; }
    const float lam = expf(wave_sum(d0)) - expf(wave_sum(d1)) + lam_init;
    const bf16_t* P = WSP(bf16_t, WS_P);
    const bf16_t* VT = WSP(bf16_t, WS_VTC) + (size_t)(b * 4 + h) * 64 * TB;
    const int tq = t0 + 32 * F.wave + r;
    bf16x8 qf[2][2];
#pragma unroll
    for (int mp = 0; mp < 2; ++mp)
#pragma unroll
        for (int sx = 0; sx < 2; ++sx) qf[mp][sx] = *(const bf16x8*)(P + (size_t)(rb + tq) * LDP + PC_QC + (2 * h + mp) * 32 + 16 * sx + 8 * hh);
    At2State<2> st;
#pragma unroll
    for (int mp = 0; mp < 2; ++mp) { st.m[mp] = M_INIT; st.l[mp] = 0.f;
#pragma unroll
        for (int dt = 0; dt < 2; ++dt)
#pragma unroll
            for (int i = 0; i < 16; ++i) st.O[mp][dt][i] = 0.f; }
    const int srow = F.tid >> 3, spc = F.tid & 7;
    const bf16_t* kp = P + (size_t)(rb + srow) * LDP + PC_KC + h * 64 + spc * 8;
    const bf16_t* vp = VT + (size_t)srow * TB + spc * 8;
    LAS bf16_t* SB = (LAS bf16_t*)F.lds;
    const int nst2 = nsteps >> 1;
    u32x4 kr[2], vr[2];
#pragma unroll
    for (int p = 0; p < 2; ++p) { kr[p] = *(const u32x4*)(kp + (size_t)(64 * p) * LDP); vr[p] = *(const u32x4*)(vp + 64 * p); }
    __syncthreads();
#pragma unroll
    for (int p = 0; p < 2; ++p) { *(LAS u32x4*)(SB + p * AT2_TILE + srow * LD2 + spc * 8) = kr[p]; *(LAS u32x4*)(SB + (2 + p) * AT2_TILE + srow * LD2 + spc * 8) = vr[p]; }
    __syncthreads();
#pragma unroll
    for (int mp = 0; mp < 2; ++mp)
#pragma unroll
        for (int sx = 0; sx < 2; ++sx) asm volatile("" : "+v"(qf[mp][sx]));
    if ((F.wave >> 2) & 1) __builtin_amdgcn_s_setprio(2);
    for (int sp = 0; sp < nst2; ++sp) {
        const int cur = sp & 1;
        if (sp + 1 < nst2) {
#pragma unroll
            for (int p = 0; p < 2; ++p) { kr[p] = *(const u32x4*)(kp + (size_t)((sp + 1) * 128 + 64 * p) * LDP); vr[p] = *(const u32x4*)(vp + (sp + 1) * 128 + 64 * p); } }
#pragma unroll 1
        for (int p = 0; p < 2; ++p) at2_step<2, 32, false>(SB + (cur * 4 + p) * AT2_TILE, SB + (cur * 4 + 2 + p) * AT2_TILE, qf, st, c2, true, true, 0, 0, F.lane);
        if (sp + 1 < nst2) {
#pragma unroll
            for (int p = 0; p < 2; ++p) { *(LAS u32x4*)(SB + ((cur ^ 1) * 4 + p) * AT2_TILE + srow * LD2 + spc * 8) = kr[p]; *(LAS u32x4*)(SB + ((cur ^ 1) * 4 + 2 + p) * AT2_TILE + srow * LD2 + spc * 8) = vr[p]; } }
        __syncthreads();
    }
    __builtin_amdgcn_s_setprio(0);
    const float i0 = 1.0f / (st.l[0] + __shfl_xor(st.l[0], 32)), i1 = lam / (st.l[1] + __shfl_xor(st.l[1], 32));
    float ss = 0.f;
#pragma unroll
    for (int dt = 0; dt < 2; ++dt)
#pragma unroll
        for (int i = 0; i < 16; ++i) { const float o = st.O[0][dt][i] * i0 - st.O[1][dt][i] * i1; st.O[0][dt][i] = o; ss += o * o; }
    ss += __shfl_xor(ss, 32);
    const float sc = rsqrtf(ss * (1.0f / 64.0f) + LN_EPS) * (1.0f - lam_init);
    bf16_t* op = WSP(bf16_t, WS_MIX) + (size_t)(rb + tq) * D + 768 + h * 64;
#pragma unroll
    for (int dt = 0; dt < 2; ++dt)
#pragma unroll
        for (int q4 = 0; q4 < 4; ++q4) { const int d = 32 * dt + 8 * q4 + 4 * hh; const f32x4 nw = *(const f32x4*)(A_->in[I_DIFFNW] + li * 64 + d);
            u32x2 w; w.x = pk_bf16(st.O[0][dt][4 * q4] * sc * nw[0], st.O[0][dt][4 * q4 + 1] * sc * nw[1]); w.y = pk_bf16(st.O[0][dt][4 * q4 + 2] * sc * nw[2], st.O[0][dt][4 * q4 + 3] * sc * nw[3]);
            *(u32x2*)(op + d) = w; }
}

__device__ __forceinline__ void attn_a2_unit(const Frame& F, int li, int unit) {
    PH_ARGS();
    const int qt = unit % NCH, hq = (unit / NCH) % 6, b = unit / (6 * NCH), kvh = hq / 3;
    const int rb = b * TB, r = F.lane & 31, hh = F.lane >> 5, grp = F.wave & 3, part = F.wave >> 2;
    const float c2 = 0.125f * LOG2E;
    const bf16_t* P = WSP(bf16_t, WS_P);
    const bf16_t* VT = WSP(bf16_t, WS_VTA) + (size_t)(b * 2 + kvh) * 64 * TB;
    LAS bf16_t* SB = (LAS bf16_t*)F.lds;
    const int q0 = 128 * qt + 32 * grp, tq = q0 + r;
    bf16x8 qf[1][4];
#pragma unroll
    for (int sx = 0; sx < 4; ++sx) qf[0][sx] = *(const bf16x8*)(P + (size_t)(rb + tq) * LDP + PC_QA + hq * 64 + 16 * sx + 8 * hh);
    At2State<1> st; st.m[0] = M_INIT; st.l[0] = 0.f;
#pragma unroll
    for (int dt = 0; dt < 2; ++dt)
#pragma unroll
        for (int i = 0; i < 16; ++i) st.O[0][dt][i] = 0.f;
    const int nit = qt < 2 ? 2 : 5;
    const int srow = F.tid >> 3, spc = F.tid & 7;
#define A2_STEP_T(s) ((s) < 4 ? 64 * (s) : ((128 * (qt - 1) + 64 * ((s) - 4)) >= NCTX && (128 * (qt - 1) + 64 * ((s) - 4)) < TB ? (128 * (qt - 1) + 64 * ((s) - 4)) : -1))
    u32x4 kr[2], vr[2];
#define A2_LOAD(it) do { _Pragma("unroll") for (int p_ = 0; p_ < 2; ++p_) { int t_ = A2_STEP_T(2 * (it) + p_); if (t_ < 0) t_ = 0; \
        kr[p_] = *(const u32x4*)(P + (size_t)(rb + t_ + srow) * LDP + PC_KA + kvh * 64 + spc * 8); vr[p_] = *(const u32x4*)(VT + (size_t)srow * TB + t_ + spc * 8); } } while (0)
#define A2_STORE(buf) do { _Pragma("unroll") for (int p_ = 0; p_ < 2; ++p_) { *(LAS u32x4*)(SB + ((buf) * 4 + p_) * AT2_TILE + srow * LD2 + spc * 8) = kr[p_]; \
        *(LAS u32x4*)(SB + ((buf) * 4 + 2 + p_) * AT2_TILE + srow * LD2 + spc * 8) = vr[p_]; } } while (0)
    A2_LOAD(0);
    __syncthreads();
    A2_STORE(0);
    __syncthreads();
    for (int it = 0; it < nit; ++it) {
        const int cur = it & 1;
        if (it + 1 < nit) A2_LOAD(it + 1);
        const int sidx = 2 * it + part, tk0 = A2_STEP_T(sidx);
        const LAS bf16_t* Kt = SB + (cur * 4 + part) * AT2_TILE; const LAS bf16_t* Vt = SB + (cur * 4 + 2 + part) * AT2_TILE;
        if (sidx < 4) at2_step<1, 64, false>(Kt, Vt, qf, st, c2, true, true, 0, 0, F.lane);
        else if (tk0 >= 0) {
            const bool on0 = (tk0 + 31 >= q0 - 128) && (tk0 <= q0 + 31 + 128), on1 = (tk0 + 63 >= q0 - 128) && (tk0 + 32 <= q0 + 31 + 128);
            if (on0 || on1) at2_step<1, 64, true>(Kt, Vt, qf, st, c2, on0, on1, tq, tk0, F.lane);
        }
        if (it + 1 < nit) A2_STORE(cur ^ 1);
        __syncthreads();
    }
#undef A2_STEP_T
#undef A2_LOAD
#undef A2_STORE
    const float ltot = st.l[0] + __shfl_xor(st.l[0], 32);
    LAS float* MB = (LAS float*)F.lds + grp * 34 * 64;
    if (part == 1) { MB[F.lane] = st.m[0]; MB[64 + F.lane] = ltot;
#pragma unroll
        for (int dt = 0; dt < 2; ++dt)
#pragma unroll
            for (int i = 0; i < 16; ++i) MB[(2 + dt * 16 + i) * 64 + F.lane] = st.O[0][dt][i]; }
    __syncthreads();
    if (part == 0) {
        const float m2 = MB[F.lane], l2 = MB[64 + F.lane];
        const float mm = fmaxf(st.m[0], m2), a1 = fast_exp2(st.m[0] - mm), a2 = fast_exp2(m2 - mm);
        const float sk = A_->in[I_SINK][li * 6 + hq] * LOG2E;
        const float inv = 1.0f / (ltot * a1 + l2 * a2 + fast_exp2(sk - mm));
        bf16_t* op = WSP(bf16_t, WS_MIX) + (size_t)(rb + tq) * D + hq * 64;
#pragma unroll
        for (int dt = 0; dt < 2; ++dt)
#pragma unroll
            for (int q4 = 0; q4 < 4; ++q4) { float o[4];
#pragma unroll
                for (int e = 0; e < 4; ++e) o[e] = (st.O[0][dt][4 * q4 + e] * a1 + MB[(2 + dt * 16 + 4 * q4 + e) * 64 + F.lane] * a2) * inv;
                u32x2 w; w.x = pk_bf16(o[0], o[1]); w.y = pk_bf16(o[2], o[3]); *(u32x2*)(op + 32 * dt + 8 * q4 + 4 * hh) = w; }
    }
    __syncthreads();
}


__device__ __forceinline__ void ssd_m1g_item(const Frame& F, int li, int item) {
    PH_ARGS();
    const int g = item & 1, bc = item >> 1, b = bc / NCH, c = bc % NCH, r0 = b * TB + c * 128;
    const int seg_lo = c < 2 ? b * TB : b * TB + NCTX, seg_hi = c < 2 ? b * TB + NCTX : (b + 1) * TB;
    LAS float* s_dt = (LAS float*)F.lds;
    LAS float* s_ac = s_dt + 6 * 128;
    LAS float* s_sc = s_ac + 6 * 128;
    LAS bf16_t* xT = (LAS bf16_t*)(s_sc + 6 * 128);
    LAS bf16_t* bT = xT + 192 * LDT;
    __syncthreads();
    const int sg = F.tid & 7, oc = F.tid >> 3;
    const int ucol = oc < 24 ? g * 192 + 8 * oc : (oc < 40 ? 384 + g * 128 + 8 * (oc - 24) : 640 + g * 128 + 8 * (oc - 40));
    u32x4 raw[20];
    if (F.tid < 448) {
        const bf16_t* Pp = WSP(bf16_t, WS_P) + PC_XBC + ucol;
#pragma unroll
        for (int i = 0; i < 20; ++i) { const int r = r0 + 16 * sg - 2 + i; raw[i] = (r >= seg_lo && r < seg_hi) ? *(const u32x4*)(Pp + (size_t)r * LDP) : (u32x4){0u, 0u, 0u, 0u}; }
    }
    for (int i = F.tid; i < 128 * 6; i += 512) {
        const int l = i / 6, k = i % 6, hd = (k / 3) * 6 + g * 3 + (k % 3);
        const float rawdt = WSP(float, WS_DT)[(size_t)(r0 + l) * 16 + hd] + A_->in[I_DTBIAS][li * 12 + hd];
        const float dtv = rawdt > 20.f ? rawdt : log1pf(expf(rawdt));
        s_dt[k * 128 + l] = dtv; s_ac[k * 128 + l] = -dtv * expf(A_->in[I_ALOG][li * 12 + hd]);
        WSP(float, WS_DTV)[(size_t)(r0 + l) * 12 + hd] = dtv;
    }
    __syncthreads();
    if (F.wave < 6) {
        const int k = F.wave, hd = (k / 3) * 6 + g * 3 + (k % 3); const bool bw = k >= 3;
        const int l0 = bw ? 127 - 2 * F.lane : 2 * F.lane, l1 = bw ? 126 - 2 * F.lane : 2 * F.lane + 1;
        const float v0 = s_ac[k * 128 + l0], v1 = s_ac[k * 128 + l1];
        float inc = v0 + v1;
#pragma unroll
        for (int o = 1; o < 64; o <<= 1) { const float up = __shfl_up(inc, o); if (F.lane >= o) inc += up; }
        const float exc = inc - (v0 + v1), tot = __shfl(inc, 63);
        const float a0 = exc + v0, a1 = exc + v0 + v1;
        s_sc[k * 128 + l0] = s_dt[k * 128 + l0] * expf(tot - a0); s_sc[k * 128 + l1] = s_dt[k * 128 + l1] * expf(tot - a1);
        WSP(float, WS_ACUM)[(size_t)(r0 + l0) * 12 + hd] = a0; WSP(float, WS_ACUM)[(size_t)(r0 + l1) * 12 + hd] = a1;
        if (F.lane == 0) WSP(float, WS_CHT)[(size_t)bc * 12 + hd] = tot;
    }
    if (F.tid < 448) {
        float w[5][8], cb[8];
#pragma unroll
        for (int k = 0; k < 5; ++k) { const f32x4 a = *(const f32x4*)(A_->in[I_CONVW] + (size_t)(li * 5 + k) * CONV_DIM + ucol), bq = *(const f32x4*)(A_->in[I_CONVW] + (size_t)(li * 5 + k) * CONV_DIM + ucol + 4);
            w[k][0] = a[0]; w[k][1] = a[1]; w[k][2] = a[2]; w[k][3] = a[3]; w[k][4] = bq[0]; w[k][5] = bq[1]; w[k][6] = bq[2]; w[k][7] = bq[3]; }
        { const f32x4 a = *(const f32x4*)(A_->in[I_CONVB] + li * CONV_DIM + ucol), bq = *(const f32x4*)(A_->in[I_CONVB] + li * CONV_DIM + ucol + 4);
          cb[0] = a[0]; cb[1] = a[1]; cb[2] = a[2]; cb[3] = a[3]; cb[4] = bq[0]; cb[5] = bq[1]; cb[6] = bq[2]; cb[7] = bq[3]; }
        u32x4 pk[16];
#pragma unroll
        for (int rr = 0; rr < 16; ++rr) {
            float y[8];
#pragma unroll
            for (int e = 0; e < 8; ++e) y[e] = cb[e];
#pragma unroll
            for (int k = 0; k < 5; ++k) { const u32x4 q = raw[rr + k];
                y[0] += w[k][0] * __uint_as_float(q.x << 16); y[1] += w[k][1] * __uint_as_float(q.x & 0xffff0000u); y[2] += w[k][2] * __uint_as_float(q.y << 16); y[3] += w[k][3] * __uint_as_float(q.y & 0xffff0000u);
                y[4] += w[k][4] * __uint_as_float(q.z << 16); y[5] += w[k][5] * __uint_as_float(q.z & 0xffff0000u); y[6] += w[k][6] * __uint_as_float(q.w << 16); y[7] += w[k][7] * __uint_as_float(q.w & 0xffff0000u); }
#pragma unroll
            for (int e = 0; e < 8; ++e) y[e] = silu_f(y[e]);
            pk[rr].x = pk_bf16(y[0], y[1]); pk[rr].y = pk_bf16(y[2], y[3]); pk[rr].z = pk_bf16(y[4], y[5]); pk[rr].w = pk_bf16(y[6], y[7]);
            *(u32x4*)(WSP(bf16_t, WS_U) + (size_t)(r0 + 16 * sg + rr) * CONV_DIM + ucol) = pk[rr];
        }
        if (oc < 40) {
            LAS bf16_t* tb = oc < 24 ? xT + (8 * oc) * LDT + 16 * sg : bT + (8 * (oc - 24)) * LDT + 16 * sg;
#pragma unroll
            for (int q = 0; q < 4; ++q) {
                u32x4 lo0, lo1, hi0, hi1;
#define PKQ(rr_) (q == 0 ? pk[rr_].x : (q == 1 ? pk[rr_].y : (q == 2 ? pk[rr_].z : pk[rr_].w)))
#define LO2(a_, b_) ((PKQ(a_) & 0xffffu) | (PKQ(b_) << 16))
#define HI2(a_, b_) ((PKQ(a_) >> 16) | (PKQ(b_) & 0xffff0000u))
                lo0.x = LO2(0, 1); lo0.y = LO2(2, 3); lo0.z = LO2(4, 5); lo0.w = LO2(6, 7); lo1.x = LO2(8, 9); lo1.y = LO2(10, 11); lo1.z = LO2(12, 13); lo1.w = LO2(14, 15);
                hi0.x = HI2(0, 1); hi0.y = HI2(2, 3); hi0.z = HI2(4, 5); hi0.w = HI2(6, 7); hi1.x = HI2(8, 9); hi1.y = HI2(10, 11); hi1.z = HI2(12, 13); hi1.w = HI2(14, 15);
#undef PKQ
#undef LO2
#undef HI2
                *(LAS u32x4*)(tb + (2 * q) * LDT) = lo0; *(LAS u32x4*)(tb + (2 * q) * LDT + 8) = lo1;
                *(LAS u32x4*)(tb + (2 * q + 1) * LDT) = hi0; *(LAS u32x4*)(tb + (2 * q + 1) * LDT + 8) = hi1;
            }
        }
    }
    __syncthreads();
    for (int i = F.tid; i < 192 * 16; i += 512) { const int ch = i >> 4, cc = i & 15;
        *(u32x4*)(WSP(bf16_t, WS_XT) + ((size_t)bc * D_INNER + g * 192 + ch) * 128 + cc * 8) = *(const LAS u32x4*)(xT + ch * LDT + cc * 8); }
    for (int q = F.wave; q < 24; q += 8) {
        const int k = q >> 2, ptile = q & 3, hl = k % 3, hd = (k / 3) * 6 + g * 3 + hl;
        bf16x8 af[4];
#pragma unroll
        for (int kt = 0; kt < 4; ++kt) {
            const bf16x8 xr = lds_frag(xT, LDT, hl * 64 + ptile * 16, kt * 32, F.lane);
            const LAS float* sp = s_sc + k * 128 + kt * 32 + 8 * (F.lane >> 4);
            const f32x4 s0 = *(const LAS f32x4*)sp, s1 = *(const LAS f32x4*)(sp + 4);
            u32x4 wv;
            wv.x = pk_bf16(bf2f((bf16_t)xr[0]) * s0[0], bf2f((bf16_t)xr[1]) * s0[1]); wv.y = pk_bf16(bf2f((bf16_t)xr[2]) * s0[2], bf2f((bf16_t)xr[3]) * s0[3]);
            wv.z = pk_bf16(bf2f((bf16_t)xr[4]) * s1[0], bf2f((bf16_t)xr[5]) * s1[1]); wv.w = pk_bf16(bf2f((bf16_t)xr[6]) * s1[2], bf2f((bf16_t)xr[7]) * s1[3]);
            af[kt] = __builtin_bit_cast(bf16x8, wv);
        }
        bf16_t* outp = WSP(bf16_t, WS_CHS) + ((size_t)bc * 12 + hd) * 8192 + (size_t)(ptile * 16 + (F.lane & 15)) * 128 + 4 * (F.lane >> 4);
#pragma unroll 2
        for (int nt = 0; nt < 8; ++nt) {
            f32x4 acc = {0.f, 0.f, 0.f, 0.f};
#pragma unroll
            for (int kt = 0; kt < 4; ++kt) acc = MFMA16(lds_frag(bT, LDT, nt * 16, kt * 32, F.lane), af[kt], acc);
            { u32x2 pw; pw.x = (unsigned)f2bf(acc[0]) | ((unsigned)f2bf(acc[1]) << 16); pw.y = (unsigned)f2bf(acc[2]) | ((unsigned)f2bf(acc[3]) << 16); *(u32x2*)(outp + nt * 16) = pw; }
        }
    }
}

__device__ __forceinline__ void phase_ssd_scan2(const Frame& F) {
    PH_ARGS();
    const bf16_t* chs = WSP(bf16_t, WS_CHS); const float* cht = WSP(float, WS_CHT); bf16_t* h0b = WSP(bf16_t, WS_H0B);
    for (int idx = F.bid * 512 + F.tid; idx < NB * 12 * 2048; idx += F.G * 512) {
        const int e4 = idx & 2047, bh = idx >> 11, hd = bh % 12, b = bh / 12;
        f32x4 st[NCH]; float dec[NCH];
#pragma unroll
        for (int s = 0; s < NCH; ++s) { const int c = hd < 6 ? s : (s < 2 ? 1 - s : NCH + 1 - s);
            { const u32x2 q = *(const u32x2*)(chs + ((size_t)(b * NCH + c) * 12 + hd) * 8192 + e4 * 4); st[s] = (f32x4){__uint_as_float(q.x << 16), __uint_as_float(q.x & 0xffff0000u), __uint_as_float(q.y << 16), __uint_as_float(q.y & 0xffff0000u)}; }
            dec[s] = cht[(size_t)(b * NCH + c) * 12 + hd]; }
        f32x4 h = {0.f, 0.f, 0.f, 0.f};
#pragma unroll
        for (int s = 0; s < NCH; ++s) { const int c = hd < 6 ? s : (s < 2 ? 1 - s : NCH + 1 - s);
            u32x2 w; w.x = pk_bf16(h[0], h[1]); w.y = pk_bf16(h[2], h[3]);
            *(u32x2*)(h0b + ((size_t)(b * NCH + c) * 12 + hd) * 8192 + e4 * 4) = w; h = h * expf(dec[s]) + st[s]; }
    }
}

__device__ __forceinline__ void ssd_m3w_item(const Frame& F, int li, int item) {
    PH_ARGS();
    const int b = item / NCH, c = item % NCH, r0 = b * TB + c * 128;
    LAS float* s_dt = (LAS float*)F.lds;
    LAS float* s_ac = s_dt + 12 * 128;
    LAS bf16_t* bN = (LAS bf16_t*)(s_ac + 12 * 128);
    LAS bf16_t* xTl = bN + 128 * LDT;
    LAS bf16_t* h0l = xTl + 64 * LDT;
    LAS bf16_t* gd = h0l + 2 * 64 * LDT;
    const int w = F.wave, r = F.lane & 15, gq = F.lane >> 4;
    LAS bf16_t* gdw = gd + w * 16 * LDT;
    const bf16_t* U = WSP(bf16_t, WS_U);
    const bf16_t* XT = WSP(bf16_t, WS_XT) + (size_t)item * D_INNER * 128;
    const bf16_t* H0 = WSP(bf16_t, WS_H0B) + (size_t)item * 12 * 8192;
    float* YG = WSP(float, WS_YG);
    const int prow = F.tid >> 4, ppc = F.tid & 15;
    u32x4 px[2], ph[2][2];
#define M3_LOADHEAD(h_) do { _Pragma("unroll") for (int i_ = 0; i_ < 2; ++i_) { px[i_] = *(const u32x4*)(XT + (size_t)((h_) * 64 + prow + 32 * i_) * 128 + ppc * 8); \
        ph[0][i_] = *(const u32x4*)(H0 + (size_t)(h_) * 8192 + (size_t)(prow + 32 * i_) * 128 + ppc * 8); ph[1][i_] = *(const u32x4*)(H0 + (size_t)(6 + (h_)) * 8192 + (size_t)(prow + 32 * i_) * 128 + ppc * 8); } } while (0)
#define M3_STOREHEAD() do { _Pragma("unroll") for (int i_ = 0; i_ < 2; ++i_) { *(LAS u32x4*)(xTl + (prow + 32 * i_) * LDT + ppc * 8) = px[i_]; \
        *(LAS u32x4*)(h0l + (prow + 32 * i_) * LDT + ppc * 8) = ph[0][i_]; *(LAS u32x4*)(h0l + (64 + prow + 32 * i_) * LDT + ppc * 8) = ph[1][i_]; } } while (0)
    unsigned long long qa_ = 0; if ((SPINMASK >> 14) & 1) qa_ = wall_clock64();
    float ssq = 0.f;
    M3_LOADHEAD(0);
    __syncthreads();
    for (int i = F.tid; i < 128 * 12; i += 512) { const int l = i / 12, hd = i % 12; s_dt[hd * 128 + l] = WSP(float, WS_DTV)[(size_t)(r0 + l) * 12 + hd]; s_ac[hd * 128 + l] = WSP(float, WS_ACUM)[(size_t)(r0 + l) * 12 + hd]; }
    for (int g = 0; g < 2; ++g) {
        bf16x8 cf[4];
#pragma unroll
        for (int kt = 0; kt < 4; ++kt) cf[kt] = *(const bf16x8*)(U + (size_t)(r0 + 16 * w + r) * CONV_DIM + 640 + g * 128 + kt * 32 + 8 * gq);
        { u32x4 pb[4];
#pragma unroll
          for (int i = 0; i < 4; ++i) { const int id = F.tid + 512 * i; pb[i] = *(const u32x4*)(U + (size_t)(r0 + (id >> 4)) * CONV_DIM + 384 + g * 128 + (id & 15) * 8); }
          if (g) __syncthreads();
#pragma unroll
          for (int i = 0; i < 4; ++i) { const int id = F.tid + 512 * i; *(LAS u32x4*)(bN + (id >> 4) * LDT + (id & 15) * 8) = pb[i]; } }
        for (int hl = 0; hl < 3; ++hl) {
            const int h = g * 3 + hl;
            M3_STOREHEAD();
            __syncthreads();
            if (h < 5) M3_LOADHEAD(h + 1);
            const int erow = r0 + 16 * w + (F.lane >> 2), ecol = 16 * (F.lane & 3);
            const u32x4 zq0 = *(const u32x4*)(WSP(bf16_t, WS_P) + (size_t)erow * LDP + PC_Z + h * 64 + ecol), zq1 = *(const u32x4*)(WSP(bf16_t, WS_P) + (size_t)erow * LDP + PC_Z + h * 64 + ecol + 8);
            const u32x4 xq0 = *(const u32x4*)(U + (size_t)erow * CONV_DIM + h * 64 + ecol), xq1 = *(const u32x4*)(U + (size_t)erow * CONV_DIM + h * 64 + ecol + 8);
            f32x4 G[8];
#pragma unroll
            for (int st = 0; st < 8; ++st) { f32x4 acc = {0.f, 0.f, 0.f, 0.f};
#pragma unroll
                for (int kt = 0; kt < 4; ++kt) acc = MFMA16(lds_frag(bN, LDT, st * 16, kt * 32, F.lane), cf[kt], acc);
                G[st] = acc; }
            bf16x8 gf[2][4]; float eal[2][4];
#pragma unroll
            for (int dir = 0; dir < 2; ++dir) {
                const int hd = dir * 6 + h;
#pragma unroll
                for (int j = 0; j < 4; ++j) eal[dir][j] = __expf(s_ac[hd * 128 + 16 * w + 4 * gq + j]);
                const int l = 16 * w + r; const float acl = s_ac[hd * 128 + l];
#pragma unroll
                for (int st = 0; st < 8; ++st) { const int s0 = 16 * st + 4 * gq;
                    const f32x4 acs = *(const LAS f32x4*)(s_ac + hd * 128 + s0), dts = *(const LAS f32x4*)(s_dt + hd * 128 + s0);
                    float v[4];
#pragma unroll
                    for (int j = 0; j < 4; ++j) { const bool ok = dir == 0 ? (s0 + j <= l) : (s0 + j >= l); v[j] = ok ? G[st][j] * __expf(acl - acs[j]) * dts[j] : 0.f; }
                    u32x2 pw; pw.x = pk_bf16(v[0], v[1]); pw.y = pk_bf16(v[2], v[3]);
                    *(LAS u32x2*)(gdw + r * LDT + s0) = pw; }
                asm volatile("s_waitcnt lgkmcnt(0)" ::: "memory");
#pragma unroll
                for (int kt = 0; kt < 4; ++kt) gf[dir][kt] = lds_frag(gdw, LDT, 0, kt * 32, F.lane);
                asm volatile("s_waitcnt lgkmcnt(0)" ::: "memory");
            }
            const float dsk = A_->in[I_DSKIP][li * 6 + h];
#pragma unroll
            for (int pt = 0; pt < 4; ++pt) {
                f32x4 yv = {0.f, 0.f, 0.f, 0.f}, t0 = {0.f, 0.f, 0.f, 0.f}, t1 = {0.f, 0.f, 0.f, 0.f};
#pragma unroll
                for (int kt = 0; kt < 4; ++kt) { const bf16x8 xf = lds_frag(xTl, LDT, pt * 16, kt * 32, F.lane);
                    yv = MFMA16(gf[0][kt], xf, yv); yv = MFMA16(gf[1][kt], xf, yv);
                    t0 = MFMA16(cf[kt], lds_frag(h0l, LDT, pt * 16, kt * 32, F.lane), t0); t1 = MFMA16(cf[kt], lds_frag(h0l + 64 * LDT, LDT, pt * 16, kt * 32, F.lane), t1); }
#pragma unroll
                for (int j = 0; j < 4; ++j) ((LAS float*)gdw)[(4 * gq + j) * 68 + pt * 16 + r] = yv[j] + eal[0][j] * t0[j] + eal[1][j] * t1[j];
            }
            asm volatile("s_waitcnt lgkmcnt(0)" ::: "memory");
            {
                const LAS float* yr = (const LAS float*)gdw + (F.lane >> 2) * 68 + ecol;
                const unsigned zz[8] = {zq0.x, zq0.y, zq0.z, zq0.w, zq1.x, zq1.y, zq1.z, zq1.w}, xx[8] = {xq0.x, xq0.y, xq0.z, xq0.w, xq1.x, xq1.y, xq1.z, xq1.w};
                float o[16];
#pragma unroll
                for (int q4 = 0; q4 < 4; ++q4) { const f32x4 yq = *(const LAS f32x4*)(yr + 4 * q4); const f32x4 nw = *(const f32x4*)(A_->in[I_SSMNW] + li * D_INNER + h * 64 + ecol + 4 * q4);
#pragma unroll
                    for (int e = 0; e < 4; ++e) { const int c = 4 * q4 + e; const unsigned zw = zz[c >> 1], xw = xx[c >> 1];
                        const float zv = (c & 1) ? __uint_as_float(zw & 0xffff0000u) : __uint_as_float(zw << 16), xv = (c & 1) ? __uint_as_float(xw & 0xffff0000u) : __uint_as_float(xw << 16);
                        const float gv = (yq[e] + dsk * xv) * silu_f(zv); ssq += gv * gv; o[c] = gv * nw[e]; } }
                u32x4 w0, w1; w0.x = pk_bf16(o[0], o[1]); w0.y = pk_bf16(o[2], o[3]); w0.z = pk_bf16(o[4], o[5]); w0.w = pk_bf16(o[6], o[7]); w1.x = pk_bf16(o[8], o[9]); w1.y = pk_bf16(o[10], o[11]); w1.z = pk_bf16(o[12], o[13]); w1.w = pk_bf16(o[14], o[15]);
                bf16_t* mp = WSP(bf16_t, WS_MIX) + (size_t)erow * D + 384 + h * 64 + ecol;
                *(u32x4*)mp = w0; *(u32x4*)(mp + 8) = w1;
            }
            __syncthreads();
        }
    }
#undef M3_LOADHEAD
#undef M3_STOREHEAD
    if ((SPINMASK >> 14) & 1) { const unsigned long long q1_ = wall_clock64(), qd_ = q1_ - qa_; while (wall_clock64() - q1_ < qd_) __builtin_amdgcn_s_sleep(8); }
    unsigned long long qb_ = 0; if ((SPINMASK >> 15) & 1) qb_ = wall_clock64();
    asm volatile("s_waitcnt vmcnt(0)" ::: "memory");
    { ssq += __shfl_xor(ssq, 1); ssq += __shfl_xor(ssq, 2);
      const float rstd = rsqrtf(ssq * (1.0f / 384.0f) + LN_EPS);
      bf16_t* mp = WSP(bf16_t, WS_MIX) + (size_t)(r0 + 16 * w + (F.lane >> 2)) * D + 384 + 16 * (F.lane & 3);
      u32x4 q[12];
#pragma unroll
      for (int hh = 0; hh < 6; ++hh) { q[2 * hh] = *(const u32x4*)(mp + hh * 64); q[2 * hh + 1] = *(const u32x4*)(mp + hh * 64 + 8); }
#pragma unroll
      for (int i = 0; i < 12; ++i) { u32x4 v = q[i]; unsigned* vp = (unsigned*)&v;
#pragma unroll
          for (int e = 0; e < 4; ++e) vp[e] = pk_bf16(__uint_as_float(vp[e] << 16) * rstd, __uint_as_float(vp[e] & 0xffff0000u) * rstd);
          *(u32x4*)(mp + (i >> 1) * 64 + (i & 1) * 8) = v; } }
    if ((SPINMASK >> 15) & 1) { asm volatile("s_waitcnt vmcnt(0)" ::: "memory"); const unsigned long long q1_ = wall_clock64(), qd_ = q1_ - qb_; while (wall_clock64() - q1_ < qd_) __builtin_amdgcn_s_sleep(8); }
}

#ifndef ONE_LAUNCH
#define ONE_LAUNCH 1
#endif
constexpr int PH_PER_LAYER = 9, PH_TOTAL = 2 + DEPTH * PH_PER_LAYER;
constexpr int ZCOL_TILE = 3;
constexpr int NC3 = 89;

__global__ void __launch_bounds__(512, 2) hybrid_fwd(Args args) {
    extern __shared__ __attribute__((aligned(16))) unsigned char lds_raw[];
    volatile LAS unsigned* bst = (volatile LAS unsigned*)((LAS unsigned char*)lds_raw + LDS_BYTES - 16);
    if (threadIdx.x < 4) bst[threadIdx.x] = 0u;
    __syncthreads();
    XcdBarrier bar; bar.bar = (unsigned*)(args.ws + WS_CTL); bar.x = 0; bar.st = bst;
    if (args.use_bar) bar = xcd_barrier_post((unsigned*)(args.ws + WS_CTL), bst);
    const int lo = args.ph_lo, hi = args.ph_hi;
#ifndef PMASK
#define PMASK 0xFFFF
#endif
#define PM(b) ((PMASK >> (b)) & 1)
#ifndef DBLMASK
#define DBLMASK 0
#endif
#define REPS(b) (((DBLMASK >> (b)) & 1) ? 2 : 1)
#define IN(k) (lo <= (k) && (k) < hi)
#ifndef SPINMASK
#define SPINMASK 0
#endif
#ifndef DBLBAR
#define DBLBAR 0
#endif
#define PT0(b) unsigned long long pt0_ = 0; if ((SPINMASK >> (b)) & 1) pt0_ = wall_clock64()
#define PT1(b) do { if ((SPINMASK >> (b)) & 1) { const unsigned long long pt1_ = wall_clock64(), ptd_ = pt1_ - pt0_; while (wall_clock64() - pt1_ < ptd_) __builtin_amdgcn_s_sleep(8); } } while (0)
#define SEAM(k) do { if (args.use_bar && (k) + 1 < hi) { xcd_barrier(bar); if (DBLBAR) xcd_barrier(bar); } else __syncthreads(); } while (0)
    LAS unsigned char* glds = (LAS unsigned char*)lds_raw;
    volatile LAS int* qslot = (volatile LAS int*)((LAS unsigned char*)lds_raw + LDS_BYTES - 32);
#define MKFRAME() Frame F; { int t_ = threadIdx.x; asm volatile("" : "+v"(t_)); F.lds = (LAS unsigned char*)lds_raw; F.tid = t_; F.lane = t_ & 63; F.wave = __builtin_amdgcn_readfirstlane(t_ >> 6); \
        F.G = gridDim.x; F.bid = blockIdx.x; F.ka = (KArgs)__builtin_amdgcn_kernarg_segment_ptr(); }

    if (PM(0) && IN(0)) { PT0(0); MKFRAME(); for (int rep_ = 0; rep_ < REPS(0); ++rep_) { if (rep_) __syncthreads(); phase_pre_a(F); } PT1(0); SEAM(0); }
    if (PM(1) && IN(1)) { PT0(1); MKFRAME(); phase_pre_b(F); PT1(1); SEAM(1); }

    for (int li = 0; li < DEPTH; ++li) {
        const int pb = 2 + li * PH_PER_LAYER; const bool moe = li & 1; const int jm = li >> 1; const bool last = li == DEPTH - 1;
        if (PM(2) && IN(pb + 0)) { PT0(2);
            MKFRAME(); PH_ARGS();
            pg8::Gemm g{WSP(bf16_t, WS_H), WSP(bf16_t, WS_WIN) + (size_t)li * LDP * D, T, LDP, D / 2};     pg8::StaticOrder S; S.init(T, LDP - 256, F.G, F.bid, 0, ZCOL_TILE);
            const float* rp = WSP(float, WS_ROPE);
            pg8::EpiInProj E{WSP(bf16_t, WS_P), WSP(float, WS_DT), rp, rp + 2048 * 32, rp + 2 * 2048 * 32, rp + 2 * 2048 * 32 + 2048 * 16, WSP(bf16_t, WS_VTA), WSP(bf16_t, WS_VTC), WSP(float, WS_RSC), WSP(float, WS_WSC) + (size_t)18 * 2 * DFF + (size_t)li * LDP};
            for (int rep_ = 0; rep_ < REPS(2); ++rep_) pg8::gemm_phase<pg8::EpiInProj, pg8::StaticOrder, 2>(glds, g, S, E, nullptr);
            PT1(2); SEAM(pb + 0);
        }
        const int nC = last ? NB * 4 * 8 : NB * 4 * 9;
        if (PM(3) && IN(pb + 1)) { PT0(3);
            unsigned* qh = (unsigned*)(args.ws + WS_CTL + CTL_Q_OFF) + (li * 2 + 0) * 64;
            const int e0 = NC3, e1 = e0 + T / 256, e2 = e1 + 2 * NB * NCH, e3 = e2 + NB * 6 * NCH / 2;
            for (;;) {
                __syncthreads(); if (threadIdx.x == 0) *qslot = (int)atomicAdd(qh, 1u); __syncthreads();
                const int it = *qslot;
                if (it >= e3) break;
                MKFRAME(); PH_ARGS();
                if (it < e0) attn_c2_unit(F, li, it);
                else if (it < e1) {
                    pg8::Gemm g{WSP(bf16_t, WS_H), WSP(bf16_t, WS_WIN) + (size_t)li * LDP * D, T, LDP, D / 2};     pg8::OneUnit S{it - e0, ZCOL_TILE};
                    const float* rp = WSP(float, WS_ROPE);
                    pg8::EpiInProj E{WSP(bf16_t, WS_P), WSP(float, WS_DT), rp, rp + 2048 * 32, rp + 2 * 2048 * 32, rp + 2 * 2048 * 32 + 2048 * 16, WSP(bf16_t, WS_VTA), WSP(bf16_t, WS_VTC), WSP(float, WS_RSC), WSP(float, WS_WSC) + (size_t)18 * 2 * DFF + (size_t)li * LDP};
                    pg8::gemm_phase<pg8::EpiInProj, pg8::OneUnit, 2>(glds, g, S, E, nullptr);
                }
                else if (it < e2) ssd_m1g_item(F, li, it - e1);
                else { const int ia = 2 * (it - e2);
                    if (!(last && (ia % NCH) < 2)) attn_a2_unit(F, li, ia);
                    if (!(last && ((ia + 1) % NCH) < 2)) attn_a2_unit(F, li, ia + 1); }
            }
            PT1(3); SEAM(pb + 1);
        }
        if (PM(4) && IN(pb + 2)) { PT0(4);
            MKFRAME();
            phase_ssd_scan2(F);
            PT1(4); SEAM(pb + 2);
        }
        if (PM(5) && IN(pb + 3)) { PT0(5);
            unsigned* qh = (unsigned*)(args.ws + WS_CTL + CTL_Q_OFF) + (li * 2 + 1) * 64;
            const int e0 = nC - NC3, e1 = e0 + NB * NCH;
            for (;;) {
                __syncthreads(); if (threadIdx.x == 0) *qslot = (int)atomicAdd(qh, 1u); __syncthreads();
                const int it = *qslot;
                if (it >= e1) break;
                MKFRAME(); PH_ARGS();
                if (it < e0) attn_c2_unit(F, li, NC3 + it);
                else { const int im = it - e0; if (!(last && (im % NCH) < 2)) ssd_m3w_item(F, li, im); }
            }
            PT1(5); SEAM(pb + 3);
        }
        if (PM(6) && IN(pb + 4)) { PT0(6);
            MKFRAME(); PH_ARGS();
            pg8::Gemm g{WSP(bf16_t, WS_MIX), WSP(bf16_t, WS_WOUT) + (size_t)li * D * D, T, D, D}; pg8::StaticOrder S; S.init(last ? NB * SEQ : T, D, F.G, F.bid, last ? 1 : 0);
            pg8::EpiBf16 E{WSP(bf16_t, WS_O), D, 1.0f};
            for (int rep_ = 0; rep_ < REPS(6); ++rep_) pg8::gemm_phase<pg8::EpiBf16, pg8::StaticOrder>(glds, g, S, E, nullptr);
            PT1(6); SEAM(pb + 4);
        }
        if (PM(7) && IN(pb + 5)) { PT0(7); MKFRAME(); phase_post_mixer(F, li); PT1(7); SEAM(pb + 5); }
        if (PM(8) && IN(pb + 6)) { PT0(8); unsigned long long pg_ = 0; if ((SPINMASK >> (moe ? 16 : 17)) & 1) pg_ = wall_clock64();
            MKFRAME(); PH_ARGS();
            if (!moe) {
                pg8::EpiSwiGLUI8 E{WSP(unsigned char, WS_ACT), WSP(float, WS_RSC), WSP(float, WS_WSC) + (size_t)jm * 2 * DFF};
                pg8::Gemm g{WSP(bf16_t, WS_H), WSP(bf16_t, WS_WGU) + (size_t)jm * 2 * DFF * D, T, 2 * DFF, D / 2}; pg8::StaticOrder S; S.init(T, 2 * DFF, F.G, F.bid);
                for (int rep_ = 0; rep_ < REPS(8); ++rep_) pg8::gemm_phase<pg8::EpiSwiGLUI8, pg8::StaticOrder, 2>(glds, g, S, E, nullptr);
            } else {
                pg8::EpiSwiGLUI8 E{WSP(unsigned char, WS_ACT), WSP(float, WS_HPS), WSP(float, WS_WSC) + (size_t)(2 + jm * 8) * 2 * DFF};
                const unsigned* cnt = (const unsigned*)(ws_ + WS_CTL + CTL_CNT_OFF) + jm * 8 * 64;
                pg8::GroupedOrder<0> S; int acc = 0;
                acc += ((int)cnt[0 * 64] + 255) >> 8; S.t1 = acc; acc += ((int)cnt[1 * 64] + 255) >> 8; S.t2 = acc; acc += ((int)cnt[2 * 64] + 255) >> 8; S.t3 = acc; acc += ((int)cnt[3 * 64] + 255) >> 8; S.t4 = acc;
                acc += ((int)cnt[4 * 64] + 255) >> 8; S.t5 = acc; acc += ((int)cnt[5 * 64] + 255) >> 8; S.t6 = acc; acc += ((int)cnt[6 * 64] + 255) >> 8; S.t7 = acc; acc += ((int)cnt[7 * 64] + 255) >> 8; S.t8 = acc;
                S.nN = 2 * DFF / 256; S.capTiles = MOE_CAP / 256; S.G = F.G; S.c = F.bid;
                pg8::Gemm g{WSP(bf16_t, WS_HP), WSP(bf16_t, WS_WGUE) + (size_t)jm * 8 * 2 * DFF * D, NEXP * MOE_CAP, NEXP * 2 * DFF, D / 2};
                for (int rep_ = 0; rep_ < REPS(8); ++rep_) pg8::gemm_phase<pg8::EpiSwiGLUI8, pg8::GroupedOrder<0>, 2>(glds, g, S, E, nullptr);
            }
            if ((SPINMASK >> (moe ? 16 : 17)) & 1) { const unsigned long long q1_ = wall_clock64(), qd_ = q1_ - pg_; while (wall_clock64() - q1_ < qd_) __builtin_amdgcn_s_sleep(8); }
            PT1(8); SEAM(pb + 6);
        }
        if (PM(9) && IN(pb + 7)) { PT0(9); unsigned long long pd_ = 0; if ((SPINMASK >> (moe ? 18 : 19)) & 1) pd_ = wall_clock64();
            MKFRAME(); PH_ARGS();
            if (!moe) {
                pg8::Gemm g{WSP(bf16_t, WS_ACT), WSP(bf16_t, WS_WD) + (size_t)jm * D * DFF, T, D, DFF / 2}; pg8::StaticOrder S; S.init(T, D, F.G, F.bid);
                pg8::EpiBf16 E{WSP(bf16_t, WS_O), D, 0.015625f};
                for (int rep_ = 0; rep_ < REPS(9); ++rep_) pg8::gemm_phase<pg8::EpiBf16, pg8::StaticOrder, true>(glds, g, S, E, nullptr);
            } else {
                const unsigned* cnt = (const unsigned*)(ws_ + WS_CTL + CTL_CNT_OFF) + jm * 8 * 64;
                pg8::GroupedOrder<1> S; int acc = 0;
                acc += ((int)cnt[0 * 64] + 255) >> 8; S.t1 = acc; acc += ((int)cnt[1 * 64] + 255) >> 8; S.t2 = acc; acc += ((int)cnt[2 * 64] + 255) >> 8; S.t3 = acc; acc += ((int)cnt[3 * 64] + 255) >> 8; S.t4 = acc;
                acc += ((int)cnt[4 * 64] + 255) >> 8; S.t5 = acc; acc += ((int)cnt[5 * 64] + 255) >> 8; S.t6 = acc; acc += ((int)cnt[6 * 64] + 255) >> 8; S.t7 = acc; acc += ((int)cnt[7 * 64] + 255) >> 8; S.t8 = acc;
                S.nN = D / 256; S.capTiles = MOE_CAP / 256; S.G = F.G; S.c = F.bid;
                pg8::Gemm g{WSP(bf16_t, WS_ACT), WSP(bf16_t, WS_WDE) + (size_t)jm * 8 * D * DFF, MAX_SLOT_ROWS, NEXP * D, DFF / 2};
                pg8::EpiBf16 E{WSP(bf16_t, WS_HP), D, 0.015625f};
                for (int rep_ = 0; rep_ < REPS(9); ++rep_) pg8::gemm_phase<pg8::EpiBf16, pg8::GroupedOrder<1>, true>(glds, g, S, E, nullptr);
            }
            if ((SPINMASK >> (moe ? 18 : 19)) & 1) { const unsigned long long q1_ = wall_clock64(), qd_ = q1_ - pd_; while (wall_clock64() - q1_ < qd_) __builtin_amdgcn_s_sleep(8); }
            PT1(9); SEAM(pb + 7);
        }
        if (PM(10) && IN(pb + 8)) { PT0(10); MKFRAME(); phase_post_ffn(F, li); PT1(10); SEAM(pb + 8); }
    }
#undef IN
#undef SEAM
}

extern "C" void kernel_launch(void* const* d_in, const int* in_sizes, int n_in, void* d_out, int out_size, void* d_ws, size_t ws_size, hipStream_t stream) {
    static int grid = 0;
    if (grid == 0) {
        if (n_in != 28 || out_size != NB * SEQ * D || ws_size < WS_END) { fprintf(stderr, "kernel_launch: unexpected shapes (n_in %d, out %d, ws %zu, need %zu); nothing launched\n", n_in, out_size, ws_size, (size_t)WS_END); grid = -1; return; }
        int dev = 0, cus = 0, per_cu = 0;
        if (hipGetDevice(&dev) != hipSuccess || hipDeviceGetAttribute(&cus, hipDeviceAttributeMultiprocessorCount, dev) != hipSuccess) { grid = -1; return; }
        if (hipFuncSetAttribute((const void*)hybrid_fwd, hipFuncAttributeMaxDynamicSharedMemorySize, LDS_BYTES) != hipSuccess) { fprintf(stderr, "kernel_launch: hipFuncSetAttribute failed\n"); grid = -1; return; }
        if (hipOccupancyMaxActiveBlocksPerMultiprocessor(&per_cu, (const void*)hybrid_fwd, 512, LDS_BYTES) != hipSuccess || per_cu < 1) { fprintf(stderr, "kernel_launch: occupancy query says %d blocks per CU\n", per_cu); per_cu = 1; }
        (void)hipGetLastError();
        grid = cus;
    }
    if (grid < 0) return;
    (void)hipMemsetAsync((char*)d_ws + WS_CTL, 0, CTL_BYTES, stream);
    Args a{};
    for (int i = 0; i < 28; ++i) a.in[i] = (const float*)d_in[i];
    a.out = (float*)d_out; a.ws = (unsigned char*)d_ws; a.pad = 0;
#if ONE_LAUNCH
    a.ph_lo = 0; a.ph_hi = PH_TOTAL; a.use_bar = 1;
    hipLaunchKernelGGL(hybrid_fwd, dim3(grid), dim3(512), LDS_BYTES, stream, a);
#else
    for (int p = 0; p < PH_TOTAL; ++p) { a.ph_lo = p; a.ph_hi = p + 1; a.use_bar = 0; hipLaunchKernelGGL(hybrid_fwd, dim3(grid), dim3(512), LDS_BYTES, stream, a); }
#endif
}
```

```cpp
#include <hip/hip_runtime.h>
#include <cstdio>
#include <cstdint>
#include <cstddef>

#ifndef SPINMASK
#define SPINMASK 0
#endif
#define LAS __attribute__((address_space(3)))
typedef unsigned short bf16_t;
typedef short bf16x8 __attribute__((ext_vector_type(8)));
typedef float f32x4 __attribute__((ext_vector_type(4)));
typedef float f32x2 __attribute__((ext_vector_type(2)));
typedef unsigned u32x4 __attribute__((ext_vector_type(4)));
typedef unsigned u32x2 __attribute__((ext_vector_type(2)));

constexpr int NB = 8, SEQ = 2048, NCTX = 256, TB = NCTX + SEQ  , T = NB * TB  , D = 1024, DEPTH = 4;
constexpr int NCH = TB / 128  ;
constexpr int D_IN = 2700, LDP = 2816, DFF = 2816, NEXP = 8, D_INNER = 384, CONV_DIM = 896;
constexpr int PC_QA = 0, PC_KA = 384, PC_VA = 512, PC_Z = 640, PC_XBC = 1024, PC_QC = 1920, PC_KC = 2176, PC_VC = 2432, PC_DT = 2688;
constexpr float LN_EPS = 1e-6f;
constexpr float ALPHA_RES = 1.6817928305074290f;
constexpr float LOG2E = 1.4426950408889634f;
constexpr int MOE_CAP = T;
constexpr int MAX_SLOT_ROWS = 2 * T + NEXP * 256;

constexpr size_t al256(size_t x) { return (x + 255) & ~(size_t)255; }
constexpr size_t WS_CTL = 0;
constexpr size_t CTL_BYTES = 65536;
constexpr size_t CTL_Q_OFF = 32768;
constexpr size_t CTL_CNT_OFF = 16384;
constexpr size_t WS_MOD = WS_CTL + CTL_BYTES;
constexpr size_t WS_ROPE = WS_MOD + al256((size_t)DEPTH * 9 * 6144 * 4);
constexpr size_t WS_WIN = WS_ROPE + (size_t)2048 * 96 * 4;
constexpr size_t WS_WOUT = WS_WIN + (size_t)DEPTH * LDP * D * 2;
constexpr size_t WS_WGU = WS_WOUT + (size_t)DEPTH * D * D * 2;
constexpr size_t WS_WD = WS_WGU + (size_t)2 * 2 * DFF * D * 2;
constexpr size_t WS_WGUE = WS_WD + (size_t)2 * D * DFF * 2;
constexpr size_t WS_WDE = WS_WGUE + (size_t)16 * 2 * DFF * D * 2;
constexpr size_t WS_X = WS_WDE + (size_t)16 * D * DFF * 2;
constexpr size_t WS_H = WS_X + (size_t)T * D * 4;
constexpr size_t WS_P = WS_H + (size_t)T * D * 2;
constexpr size_t WS_DT = WS_P + (size_t)T * LDP * 2;
constexpr size_t WS_U = WS_DT + (size_t)T * 16 * 4;
constexpr size_t WS_DTV = WS_U + (size_t)T * CONV_DIM * 2;
constexpr size_t WS_ACUM = WS_DTV + (size_t)T * 12 * 4;
constexpr size_t WS_CHS = WS_ACUM + (size_t)T * 12 * 4;
constexpr size_t WS_CHT = WS_CHS + (size_t)NB * NCH * 12 * 8192 * 4;
constexpr size_t WS_YG = WS_CHT + 8192;
constexpr size_t WS_MIX = WS_YG + (size_t)T * D_INNER * 4;
constexpr size_t WS_O = WS_MIX + (size_t)T * D * 2;
constexpr size_t WS_ACT = WS_O + (size_t)T * D * 4;
constexpr size_t WS_HP = WS_ACT + (size_t)MAX_SLOT_ROWS * DFF * 2;
constexpr size_t WS_TOK = WS_HP + (size_t)NEXP * MOE_CAP * D * 2;
constexpr size_t WS_VTA = WS_TOK + (size_t)T * 32;
constexpr size_t WS_VTC = WS_VTA + (size_t)NB * 2 * 64 * TB * 2;
constexpr size_t WS_XT = WS_VTC + (size_t)NB * 4 * 64 * TB * 2;
constexpr size_t WS_H0B = WS_XT + (size_t)NB * NCH * D_INNER * 128 * 2;
constexpr size_t WS_WSC = WS_H0B + (size_t)NB * NCH * 12 * 8192 * 2;
constexpr size_t WS_RSC = WS_WSC + (size_t)(18 * 2 * DFF + DEPTH * LDP) * 4;
constexpr size_t WS_HPS = WS_RSC + (size_t)T * 4;
constexpr size_t WS_END = WS_HPS + (size_t)NEXP * MOE_CAP * 4;

constexpr int LDS_BYTES = 147456;

struct Args { const float* in[28]; float* out; unsigned char* ws; int ph_lo, ph_hi, use_bar, pad; };
enum { I_X = 0, I_C, I_CTX, I_CCTX, I_WADA, I_BADA, I_WIN, I_SINK, I_CONVW, I_CONVB, I_DTBIAS, I_ALOG, I_DSKIP, I_SSMNW, I_LAMQ, I_LAMK, I_DIFFNW, I_WOUT,
       I_LN1G, I_LN1B, I_LN2G, I_LN2B, I_FFNGU, I_FFND, I_RW, I_RB, I_EGU, I_ED };

__device__ __forceinline__ float bf2f(bf16_t v) { return __uint_as_float(((unsigned)v) << 16); }
__device__ __forceinline__ bf16_t f2bf(float f) { unsigned u = __float_as_uint(f); u += 0x7FFFu + ((u >> 16) & 1u); return (bf16_t)(u >> 16); }
__device__ __forceinline__ unsigned pk_bf16(float lo, float hi) { unsigned r; asm volatile("v_cvt_pk_bf16_f32 %0, %1, %2" : "=v"(r) : "v"(lo), "v"(hi)); return r; }
__device__ __forceinline__ float fast_exp2(float x) { return __builtin_amdgcn_exp2f(x); }
__device__ __forceinline__ float silu_f(float x) { return x * __builtin_amdgcn_rcpf(1.0f + __expf(-x)); }
__device__ __forceinline__ float wave_sum(float v) {
#pragma unroll
    for (int o = 32; o >= 1; o >>= 1) v += __shfl_xor(v, o);
    return v;
}
#define XB_TMO      128
#define XB_XCNT(j)  (256  + 64 * (j))
#define XB_XSUB(j)  (1280 + 64 * (j))
#define XB_XGEN(j)  (2304 + 64 * (j))
#define XB_TOP      3328
#define XB_TOPGEN   3392
#define XCD_BAR_WORDS 3456
#define XB_SPIN_CAP (1u << 18)
#define LAS __attribute__((address_space(3)))

__device__ __forceinline__ unsigned xb_ld(unsigned* p)              { return __hip_atomic_load(p, __ATOMIC_RELAXED, __HIP_MEMORY_SCOPE_AGENT); }
__device__ __forceinline__ unsigned xb_add(unsigned* p, unsigned v) { return __hip_atomic_fetch_add(p, v, __ATOMIC_RELAXED, __HIP_MEMORY_SCOPE_AGENT); }
__device__ __forceinline__ unsigned xb_xcc_id() { return (unsigned)__builtin_amdgcn_s_getreg((3 << 11) | 20) & 0xFu; }
#define XB_SPIN(cond, bar) do { unsigned _sp = 0; while (cond) { __builtin_amdgcn_s_sleep(1); \
    if ((++_sp & 255u) == 0u) { if (xb_ld(&(bar)[XB_TMO])) break; if (_sp > XB_SPIN_CAP) { atomicAdd(&(bar)[XB_TMO], 1u); break; } } } } while (0)

struct XcdBarrier {
    unsigned* bar; unsigned x;
    volatile LAS unsigned* st;
};

__device__ __forceinline__ XcdBarrier xcd_barrier_post(unsigned* bar, volatile LAS unsigned* st) {
    XcdBarrier b; b.bar = bar; b.x = xb_xcc_id(); b.st = st;
    if (threadIdx.x == 0) (void)xb_add(&bar[XB_XCNT(b.x)], 1u);
    return b;
}
__device__ __forceinline__ void xcd_barrier_complete(unsigned* bar, unsigned x, unsigned& nloc, unsigned& nx) {
    const unsigned G = gridDim.x * gridDim.y * gridDim.z;
    unsigned sum, cnt, mine, sp = 0u;
    for (;;) {
        sum = 0u; cnt = 0u; mine = 0u;
#pragma unroll
        for (unsigned j = 0; j < 16; ++j) { const unsigned c = xb_ld(&bar[XB_XCNT(j)]); sum += c; cnt += (c > 0u) ? 1u : 0u; mine = (j == x) ? c : mine; }
        if (sum == G) break;
        __builtin_amdgcn_s_sleep(1);
        if ((++sp & 255u) == 0u) { if (xb_ld(&bar[XB_TMO])) break; if (sp > XB_SPIN_CAP) { atomicAdd(&bar[XB_TMO], 1u); break; } }
    }
    nloc = mine > 0u ? mine : 1u; nx = cnt > 0u ? cnt : 1u;
}

__device__ __forceinline__ void xcd_barrier(const XcdBarrier& b) {
    asm volatile("s_waitcnt vmcnt(0)" ::: "memory");
    __syncthreads();
    if (threadIdx.x == 0) {
        unsigned* bar = b.bar;
        __builtin_amdgcn_s_waitcnt(0);
        unsigned nloc = b.st[0], nx = b.st[1];
        if (nloc == 0u) { xcd_barrier_complete(bar, b.x, nloc, nx); b.st[0] = nloc; b.st[1] = nx; }
        const unsigned old = xb_add(&bar[XB_XSUB(b.x)], 1u);
        const unsigned gen = old / nloc;
        if (old + 1u == (gen + 1u) * nloc) {
            __builtin_amdgcn_fence(__ATOMIC_RELEASE, "agent");
            asm volatile("s_waitcnt vmcnt(0)" ::: "memory");
            const unsigned og = xb_add(&bar[XB_TOP], 1u);
            const unsigned tg = og / nx;
            if (og + 1u == (tg + 1u) * nx) xb_add(&bar[XB_TOPGEN], 1u);
            else XB_SPIN(xb_ld(&bar[XB_TOPGEN]) == tg, bar);
            __builtin_amdgcn_fence(__ATOMIC_ACQUIRE, "agent");
            xb_add(&bar[XB_XGEN(b.x)], 1u);
            asm volatile("s_waitcnt vmcnt(0)" ::: "memory");
        } else {
            XB_SPIN(xb_ld(&bar[XB_XGEN(b.x)]) == gen, bar);
            __builtin_amdgcn_fence(__ATOMIC_ACQUIRE, "agent");
            asm volatile("s_waitcnt vmcnt(0)" ::: "memory");
        }
    }
    __syncthreads();
}


namespace pg8 {
#define PG8_LAS __attribute__((address_space(3)))
typedef int v4i32 __attribute__((ext_vector_type(4)));
typedef int v8i32 __attribute__((ext_vector_type(8)));
template <bool I> struct AccSel { typedef f32x4 T; };
template <> struct AccSel<true> { typedef v4i32 T; };
constexpr int BM = 256, BK = 64, HALF = 128, HTB = HALF * BK * 2  , STAGE_BYTES = 8 * HTB, NXCD = 8, WGM = 8;

__host__ __device__ __forceinline__ int lds_byte(int r, int c) { const int st = (r >> 4) * 2 + (c >> 5), rr = r & 15, cc = c & 31, ob = rr * 64 + cc * 2; return st * 1024 + (ob ^ (((ob >> 9) & 1) << 5)); }
__host__ __device__ __forceinline__ void stage_rc(int b, int& R, int& C) { const int st = b / 1024, sb = b % 1024, swz = sb ^ (((sb >> 9) & 1) << 5); R = (st >> 1) * 16 + swz / 64; C = (st & 1) * 32 + (swz % 64) / 2; }
__host__ __device__ __forceinline__ int perm32(int rho) { const int n = rho >> 4, i = rho & 15; return 8 * (i >> 2) + 4 * n + (i & 3); }

struct Unit { int pm, pn, po, pc; };
struct Gemm { const bf16_t* A; const bf16_t* Bt; int M, N, K; };

struct StaticOrder {
    int nM, nN, nwg, G, c, skipctx, skipcol;
    __host__ __device__ void init(int M, int N, int G_, int c_, int skipctx_ = 0, int skipcol_ = -1) { nM = M / BM; nN = N / BM; nwg = nM * nN; G = G_; c = c_; skipctx = skipctx_; skipcol = skipcol_; }
    __host__ __device__ bool next(int i, Unit& u) const {
        const long L = (long)i * G + c; if (L >= nwg) return false;
        int wgid = (int)L; { const int q = nwg / NXCD, r = nwg % NXCD, xcd = wgid % NXCD, off = wgid / NXCD; wgid = (xcd < r ? xcd * (q + 1) : r * (q + 1) + (xcd - r) * q) + off; }
        const int nig = WGM * nN, gid = wgid / nig, fm = gid * WGM, gsz = (nM - fm) < WGM ? (nM - fm) : WGM;
        u.pm = fm + ((wgid % nig) % gsz); if (skipctx) u.pm += (u.pm >> 3) + 1;
        u.pn = (wgid % nig) / gsz; if (skipcol >= 0 && u.pn >= skipcol) ++u.pn;
        u.po = u.pm; u.pc = u.pn; return true;
    }
    __device__ __forceinline__ void a_ready(const Unit&) const {}
    __device__ __forceinline__ void done(const Unit&) const {}
};
struct OneUnit {
    int pm, pn;
    __device__ __forceinline__ bool next(int i, Unit& u) const { if (i) return false; u.pm = pm; u.pn = pn; u.po = pm; u.pc = pn; return true; }
    __device__ __forceinline__ void a_ready(const Unit&) const {}
    __device__ __forceinline__ void done(const Unit&) const {}
};
template <int MODE> struct GroupedOrder {
    int t1, t2, t3, t4, t5, t6, t7, t8, nN, capTiles, G, c;
    __device__ __forceinline__ bool next(int i, Unit& u) const {
        const int nwg = t8 * nN, L = i * G + c; if (L >= nwg) return false;
        int wgid = L; { const int q = nwg / NXCD, r = nwg % NXCD, xcd = wgid % NXCD, off = wgid / NXCD; wgid = (xcd < r ? xcd * (q + 1) : r * (q + 1) + (xcd - r) * q) + off; }
        const int nig = WGM * nN, gid = wgid / nig, fm = gid * WGM, gsz = (t8 - fm) < WGM ? (t8 - fm) : WGM;
        const int rt = fm + ((wgid % nig) % gsz), pn = (wgid % nig) / gsz;
        int e = 0, base = 0;
        if (rt >= t1) { e = 1; base = t1; } if (rt >= t2) { e = 2; base = t2; } if (rt >= t3) { e = 3; base = t3; } if (rt >= t4) { e = 4; base = t4; }
        if (rt >= t5) { e = 5; base = t5; } if (rt >= t6) { e = 6; base = t6; } if (rt >= t7) { e = 7; base = t7; }
        u.pm = (MODE == 0) ? e * capTiles + (rt - base) : rt; u.pn = e * nN + pn; u.po = rt; u.pc = pn; return true;
    }
    __device__ __forceinline__ void a_ready(const Unit&) const {}
    __device__ __forceinline__ void done(const Unit&) const {}
};

struct EpiF32 {
    static constexpr bool PERM = false, AFTER_DRAIN = false;
    float* C; int ldc;
    __device__ __forceinline__ void operator()(const f32x4 (&acc)[2][2][4][2], const Unit& u, int wr, int wc, int fr, int fq) const {
        const int row0 = u.po * BM + wr * 64 + fr, col0 = u.pc * BM + wc * 32 + 4 * fq;
#pragma unroll
        for (int ai = 0; ai < 2; ++ai)
#pragma unroll
            for (int m = 0; m < 4; ++m) { float* rowp = C + (size_t)(row0 + ai * HALF + m * 16) * ldc + col0;
#pragma unroll
                for (int bj = 0; bj < 2; ++bj)
#pragma unroll
                    for (int n = 0; n < 2; ++n) *(f32x4*)(rowp + bj * HALF + n * 16) = acc[ai][bj][m][n]; }
    }
};
struct EpiBf16 {
    static constexpr bool PERM = true, AFTER_DRAIN = false;
    bf16_t* O; int ldc; float scale;
    __device__ __forceinline__ void operator()(const f32x4 (&acc)[2][2][4][2], const Unit& u, int wr, int wc, int fr, int fq) const {
        const int row0 = u.po * BM + wr * 64 + fr, col0 = u.pc * BM + wc * 32 + 8 * fq;
#pragma unroll
        for (int ai = 0; ai < 2; ++ai)
#pragma unroll
            for (int m = 0; m < 4; ++m) { bf16_t* rowp = O + (size_t)(row0 + ai * HALF + m * 16) * ldc + col0;
#pragma unroll
                for (int bj = 0; bj < 2; ++bj) { const f32x4 v0 = acc[ai][bj][m][0] * scale, v1 = acc[ai][bj][m][1] * scale;
                    u32x4 w; w.x = pk_bf16(v0[0], v0[1]); w.y = pk_bf16(v0[2], v0[3]); w.z = pk_bf16(v1[0], v1[1]); w.w = pk_bf16(v1[2], v1[3]);
                    *(u32x4*)(rowp + bj * HALF) = w; } }
    }
};
struct EpiInProj {
    static constexpr bool PERM = true, AFTER_DRAIN = false;
    bf16_t* P; float* DT; const float* cosA; const float* sinA; const float* cosC; const float* sinC; bf16_t* VTA; bf16_t* VTC; const float* rsc; const float* wsc;
    __device__ __forceinline__ void operator()(const v4i32 (&acc)[2][2][4][2], const Unit& u, int wr, int wc, int fr, int fq) const {
        const int pt = u.po % 9; const bool latent = pt != 0;
        const int row0 = u.po * BM + wr * 64 + fr, pos0 = (pt - 1) * 256 + wr * 64 + fr;
        const float* wq = wsc + (size_t)u.pn * BM + wc * 32 + 8 * fq; asm volatile("" : "+v"(wq));
        const f32x4 ws0[2] = {*(const f32x4*)wq, *(const f32x4*)(wq + HALF)}, ws1[2] = {*(const f32x4*)(wq + 4), *(const f32x4*)(wq + HALF + 4)};
        float sav[2][4];
#pragma unroll
        for (int ai = 0; ai < 2; ++ai)
#pragma unroll
            for (int m = 0; m < 4; ++m) sav[ai][m] = rsc[row0 + ai * HALF + m * 16];
#pragma unroll
        for (int ai = 0; ai < 2; ++ai)
#pragma unroll
            for (int m = 0; m < 4; ++m) {
                const int row = row0 + ai * HALF + m * 16, pos = pos0 + ai * HALF + m * 16;
#pragma unroll
                for (int bj = 0; bj < 2; ++bj) {
                    const int c0 = u.pc * BM + bj * HALF + wc * 32 + 8 * fq;
                    const v4i32 i0 = acc[ai][bj][m][0], i1 = acc[ai][bj][m][1]; const float sa = sav[ai][m];
                    f32x4 v0 = {(float)i0[0], (float)i0[1], (float)i0[2], (float)i0[3]}, v1 = {(float)i1[0], (float)i1[1], (float)i1[2], (float)i1[3]};
                    const float sq = sa * (c0 < PC_KA ? 0.125f * LOG2E : (c0 >= PC_QC && c0 < PC_KC) ? 0.17677669529663687f * LOG2E : 1.0f);
                    v0 *= ws0[bj] * sq; v1 *= ws1[bj] * sq;
                    if (latent) {
                        if (c0 < PC_VA) { const int j = (c0 & 63) >> 3; const f32x4 cs = *(const f32x4*)(cosA + pos * 32 + 4 * j), sn = *(const f32x4*)(sinA + pos * 32 + 4 * j);
                            const f32x4 a = v0 * cs - v1 * sn, b = v0 * sn + v1 * cs; v0 = a; v1 = b; }
                        else if (c0 >= PC_QC && c0 < PC_VC) { const int j = (c0 & 31) >> 3; const f32x4 cs = *(const f32x4*)(cosC + pos * 16 + 4 * j), sn = *(const f32x4*)(sinC + pos * 16 + 4 * j);
                            const f32x4 a = v0 * cs - v1 * sn, b = v0 * sn + v1 * cs; v0 = a; v1 = b; }
                    }
                    u32x4 w; w.x = pk_bf16(v0[0], v0[1]); w.y = pk_bf16(v0[2], v0[3]); w.z = pk_bf16(v1[0], v1[1]); w.w = pk_bf16(v1[2], v1[3]);
                    *(u32x4*)(P + (size_t)row * LDP + c0) = w;
                    if ((c0 >= PC_VA && c0 < PC_Z) || (c0 >= PC_VC && c0 < PC_DT)) {
                        const int bb = u.po / 9, tpos = pt * 256 + ai * HALF + wr * 64 + m * 16 + (8 * ((fr >> 2) & 1) + 4 * (fr >> 3) + (fr & 3));
                        bf16_t* vt = (c0 < PC_Z) ? VTA + ((size_t)(bb * 128 + (c0 - PC_VA)) * TB + tpos) : VTC + ((size_t)(bb * 256 + (c0 - PC_VC)) * TB + tpos);
                        vt[0] = (bf16_t)(w.x & 0xffffu); vt[TB] = (bf16_t)(w.x >> 16); vt[2 * TB] = (bf16_t)(w.y & 0xffffu); vt[3 * TB] = (bf16_t)(w.y >> 16);
                        vt[4 * TB] = (bf16_t)(w.z & 0xffffu); vt[5 * TB] = (bf16_t)(w.z >> 16); vt[6 * TB] = (bf16_t)(w.w & 0xffffu); vt[7 * TB] = (bf16_t)(w.w >> 16); }
                    if (c0 >= PC_DT && c0 < PC_DT + 16) { float* d = DT + (size_t)row * 16 + (c0 - PC_DT); *(f32x4*)d = v0; *(f32x4*)(d + 4) = v1; }
                }
            }
    }
};
struct EpiSwiGLUI8 {
    static constexpr bool PERM = true, AFTER_DRAIN = false;
    unsigned char* O; const float* rsc; const float* wsc;
    __device__ __forceinline__ void operator()(const v4i32 (&acc)[2][2][4][2], const Unit& u, int wr, int wc, int fr, int fq) const {
        const int row0 = u.po * BM + wr * 64 + fr, arow0 = u.pm * BM + wr * 64 + fr, col0 = u.pc * HALF + wc * 32 + 8 * fq;
        const float* wq = wsc + (size_t)u.pn * BM + wc * 32 + 8 * fq; asm volatile("" : "+v"(wq));
        const f32x4 wg0 = *(const f32x4*)wq, wg1 = *(const f32x4*)(wq + 4), wu0 = *(const f32x4*)(wq + HALF), wu1 = *(const f32x4*)(wq + HALF + 4);
        float sav[2][4];
#pragma unroll
        for (int ai = 0; ai < 2; ++ai)
#pragma unroll
            for (int m = 0; m < 4; ++m) sav[ai][m] = rsc[arow0 + ai * HALF + m * 16];
#pragma unroll
        for (int ai = 0; ai < 2; ++ai)
#pragma unroll
            for (int m = 0; m < 4; ++m) {
                const float sa = sav[ai][m];
                const v4i32 g0 = acc[ai][0][m][0], g1 = acc[ai][0][m][1], u0 = acc[ai][1][m][0], u1 = acc[ai][1][m][1];
                float r[8];
#pragma unroll
                for (int j = 0; j < 4; ++j) { r[j] = __builtin_amdgcn_fmed3f(silu_f((float)g0[j] * (sa * wg0[j])) * ((float)u0[j] * (sa * wu0[j])), -448.f, 448.f);
                    r[4 + j] = __builtin_amdgcn_fmed3f(silu_f((float)g1[j] * (sa * wg1[j])) * ((float)u1[j] * (sa * wu1[j])), -448.f, 448.f); }
                int w0 = 0, w1 = 0;
                w0 = __builtin_amdgcn_cvt_pk_fp8_f32(r[0], r[1], w0, false); w0 = __builtin_amdgcn_cvt_pk_fp8_f32(r[2], r[3], w0, true);
                w1 = __builtin_amdgcn_cvt_pk_fp8_f32(r[4], r[5], w1, false); w1 = __builtin_amdgcn_cvt_pk_fp8_f32(r[6], r[7], w1, true);
                *(u32x2*)(O + (size_t)(row0 + ai * HALF + m * 16) * DFF + col0) = (u32x2){(unsigned)w0, (unsigned)w1};
            }
    }
};
struct EpiSwiGLU8 {
    static constexpr bool PERM = true, AFTER_DRAIN = false;
    unsigned char* O; float isc;
    __device__ __forceinline__ void operator()(const f32x4 (&acc)[2][2][4][2], const Unit& u, int wr, int wc, int fr, int fq) const {
        const int row0 = u.po * BM + wr * 64 + fr, col0 = u.pc * HALF + wc * 32 + 8 * fq;
#pragma unroll
        for (int ai = 0; ai < 2; ++ai)
#pragma unroll
            for (int m = 0; m < 4; ++m) {
                const f32x4 g0 = acc[ai][0][m][0], g1 = acc[ai][0][m][1], u0 = acc[ai][1][m][0], u1 = acc[ai][1][m][1];
                float r[8];
#pragma unroll
                for (int j = 0; j < 4; ++j) { r[j] = __builtin_amdgcn_fmed3f(silu_f(g0[j] * isc) * (u0[j] * isc), -448.f, 448.f); r[4 + j] = __builtin_amdgcn_fmed3f(silu_f(g1[j] * isc) * (u1[j] * isc), -448.f, 448.f); }
                int w0 = 0, w1 = 0;
                w0 = __builtin_amdgcn_cvt_pk_fp8_f32(r[0], r[1], w0, false); w0 = __builtin_amdgcn_cvt_pk_fp8_f32(r[2], r[3], w0, true);
                w1 = __builtin_amdgcn_cvt_pk_fp8_f32(r[4], r[5], w1, false); w1 = __builtin_amdgcn_cvt_pk_fp8_f32(r[6], r[7], w1, true);
                *(u32x2*)(O + (size_t)(row0 + ai * HALF + m * 16) * DFF + col0) = (u32x2){(unsigned)w0, (unsigned)w1};
            }
    }
};
struct EpiSwiGLU {
    static constexpr bool PERM = true, AFTER_DRAIN = false;
    bf16_t* O;
    __device__ __forceinline__ void operator()(const f32x4 (&acc)[2][2][4][2], const Unit& u, int wr, int wc, int fr, int fq) const {
        const int row0 = u.po * BM + wr * 64 + fr, col0 = u.pc * HALF + wc * 32 + 8 * fq;
#pragma unroll
        for (int ai = 0; ai < 2; ++ai)
#pragma unroll
            for (int m = 0; m < 4; ++m) {
                const f32x4 g0 = acc[ai][0][m][0], g1 = acc[ai][0][m][1], u0 = acc[ai][1][m][0], u1 = acc[ai][1][m][1];
                float r[8];
#pragma unroll
                for (int j = 0; j < 4; ++j) { r[j] = silu_f(g0[j]) * u0[j]; r[4 + j] = silu_f(g1[j]) * u1[j]; }
                u32x4 w; w.x = pk_bf16(r[0], r[1]); w.y = pk_bf16(r[2], r[3]); w.z = pk_bf16(r[4], r[5]); w.w = pk_bf16(r[6], r[7]);
                *(u32x4*)(O + (size_t)(row0 + ai * HALF + m * 16) * DFF + col0) = w;
            }
    }
};


template <class Epi, class Sched, int MODE = 0, bool STAMP = false>
__device__ __forceinline__ void gemm_phase(PG8_LAS unsigned char* lds, const Gemm g, const Sched& S, const Epi& E, unsigned long long* stamps) {
    int tid_ = threadIdx.x; asm volatile("" : "+v"(tid_));
    const int tid = tid_, wid = __builtin_amdgcn_readfirstlane(tid >> 6), lane = tid & 63, wr = wid >> 2, wc = wid & 3, fr = lane & 15, fq = lane >> 4;
    const int K = g.K, nt = K / BK;
    int ts_lo = 0, ts_hi = 0, nts = 0; const unsigned long long rt_entry = STAMP ? (unsigned long long)wall_clock64() : 0ull;
#define PG8_STAMP() do { if (STAMP && wid == 0 && nts < 64) { const unsigned long long _c = (unsigned long long)clock64(); \
        ts_lo = (lane == nts) ? (int)(unsigned)_c : ts_lo; ts_hi = (lane == nts) ? (int)(unsigned)(_c >> 32) : ts_hi; ++nts; } } while (0)
    PG8_STAMP();
    unsigned voffA[2], voffB[2];
#pragma unroll
    for (int i = 0; i < 2; ++i) { int R, C; stage_rc(tid * 16 + i * 8192, R, C); const int Rb = Epi::PERM ? ((R & ~31) + perm32(R & 31)) : R;
        voffA[i] = (unsigned)(R * K + C) * 2u; voffB[i] = (unsigned)(Rb * K + C) * 2u; }
    const size_t kstep = (size_t)(BK * 2);
    const size_t hstep = (size_t)HALF * K * 2;
    const size_t tstep = 2 * hstep;
    const unsigned ldsw = (unsigned)wid * 1024u;
    const int aoff = lds_byte(wr * 64 + fr, fq * 8), boff = lds_byte(wc * 32 + fr, fq * 8);
#define PG8_SA(b, h) (((b) * 2 + (h)) * HTB)
#define PG8_SB(b, h) ((4 + (b) * 2 + (h)) * HTB)
#define PG8_STAGE(bufoff, gbase, voff) do { _Pragma("unroll") for (int _i = 0; _i < 2; ++_i) \
        __builtin_amdgcn_global_load_lds((const unsigned*)((const char*)(gbase) + (voff)[_i]), (PG8_LAS unsigned*)(lds + (bufoff) + ldsw + _i * 8192), 16, 0, 0); } while (0)
#define PG8_LD8(p_) __builtin_shufflevector(*(const PG8_LAS v4i32*)(p_), *(const PG8_LAS v4i32*)((p_) + 1024), 0, 1, 2, 3, 4, 5, 6, 7)
#define PG8_LDA(dst, b, h) do { _Pragma("unroll") for (int m = 0; m < 4; ++m) dst[m] = PG8_LD8(lds + PG8_SA(b, h) + aoff + m * 2048); } while (0)
#define PG8_LDB(dst, b, h) do { _Pragma("unroll") for (int n = 0; n < 2; ++n) dst[n] = PG8_LD8(lds + PG8_SB(b, h) + boff + n * 2048); } while (0)
#define PG8_HALF(v_, k_) __builtin_bit_cast(bf16x8, __builtin_shufflevector(v_, v_, 4 * (k_), 4 * (k_) + 1, 4 * (k_) + 2, 4 * (k_) + 3))
#define PG8_HALFI(v_, k_) __builtin_shufflevector(v_, v_, 4 * (k_), 4 * (k_) + 1, 4 * (k_) + 2, 4 * (k_) + 3)
#define PG8_MMA(ai, bj, At, Bt) do { __builtin_amdgcn_s_setprio(1); \
        if constexpr (MODE == 1) { _Pragma("unroll") for (int m = 0; m < 4; ++m) _Pragma("unroll") for (int n = 0; n < 2; ++n) \
            asm volatile("v_mfma_f32_16x16x128_f8f6f4 %0, %1, %2, %0" : "+v"(acc[ai][bj][m][n]) : "v"(Bt[n]), "v"(At[m])); } \
        else if constexpr (MODE == 2) {   \
            _Pragma("unroll") for (int m = 0; m < 4; ++m) _Pragma("unroll") for (int n = 0; n < 2; ++n) \
                asm volatile("v_mfma_i32_16x16x64_i8 %0, %1, %2, %0" : "+v"(acc[ai][bj][m][n]) : "v"(PG8_HALFI(Bt[n], 0)), "v"(PG8_HALFI(At[m], 0))); \
            _Pragma("unroll") for (int m = 0; m < 4; ++m) _Pragma("unroll") for (int n = 0; n < 2; ++n) \
                asm volatile("v_mfma_i32_16x16x64_i8 %0, %1, %2, %0" : "+v"(acc[ai][bj][m][n]) : "v"(PG8_HALFI(Bt[n], 1)), "v"(PG8_HALFI(At[m], 1))); } \
        else { _Pragma("unroll") for (int m = 0; m < 4; ++m) _Pragma("unroll") for (int n = 0; n < 2; ++n) { \
            acc[ai][bj][m][n] = __builtin_amdgcn_mfma_f32_16x16x32_bf16(PG8_HALF(Bt[n], 0), PG8_HALF(At[m], 0), acc[ai][bj][m][n], 0, 0, 0); \
            acc[ai][bj][m][n] = __builtin_amdgcn_mfma_f32_16x16x32_bf16(PG8_HALF(Bt[n], 1), PG8_HALF(At[m], 1), acc[ai][bj][m][n], 0, 0, 0); } } \
        __builtin_amdgcn_s_setprio(0); } while (0)
#define PG8_WAIT_V(n) asm volatile("s_waitcnt vmcnt(" #n ")" ::: "memory")
#define PG8_WAIT_L(n) asm volatile("s_waitcnt lgkmcnt(" #n ")" ::: "memory")
#define PG8_BAR __builtin_amdgcn_s_barrier()
#define PG8_SCHED __builtin_amdgcn_sched_barrier(0)
    Unit cur, nxt; int ui = 0;
    if (!S.next(0, cur)) return;
    typename AccSel<MODE == 2>::T acc[2][2][4][2];
#pragma unroll
    for (int a = 0; a < 2; ++a)
#pragma unroll
        for (int b = 0; b < 2; ++b)
#pragma unroll
            for (int m = 0; m < 4; ++m)
#pragma unroll
                for (int n = 0; n < 2; ++n) acc[a][b][m][n] = typename AccSel<MODE == 2>::T{};
    v8i32 At[4], B0[2], B1[2];
    const char* cA = (const char*)g.A + (size_t)cur.pm * tstep; const char* cB = (const char*)g.Bt + (size_t)cur.pn * tstep;
    S.a_ready(cur);
    PG8_STAGE(PG8_SB(0, 0), cB, voffB); PG8_STAGE(PG8_SA(0, 0), cA, voffA); PG8_STAGE(PG8_SB(0, 1), cB + hstep, voffB); PG8_STAGE(PG8_SA(0, 1), cA + hstep, voffA);
    if (wr == 1) PG8_BAR;
    PG8_WAIT_V(4); PG8_BAR;
    PG8_STAGE(PG8_SB(1, 0), cB + kstep, voffB); PG8_STAGE(PG8_SA(1, 0), cA + kstep, voffA); PG8_STAGE(PG8_SB(1, 1), cB + hstep + kstep, voffB);
    PG8_WAIT_V(6); PG8_BAR;
    PG8_STAMP();
    for (;;) {
        const bool has_next = S.next(ui + 1, nxt);
        const char* nA = has_next ? (const char*)g.A + (size_t)nxt.pm * tstep : cA; const char* nB = has_next ? (const char*)g.Bt + (size_t)nxt.pn * tstep : cB;
        for (int t = 0; t < nt; t += 2) {
            const bool last = (t == nt - 2);
            const char* a1 = cA + (size_t)(t + 1) * kstep;
            const char* a2 = last ? nA : cA + (size_t)(t + 2) * kstep; const char* b2 = last ? nB : cB + (size_t)(t + 2) * kstep;
            const char* a3 = a2 + kstep; const char* b3 = b2 + kstep;
            if (last && has_next) S.a_ready(nxt);
            PG8_LDB(B0, 0, 0); PG8_SCHED; PG8_LDA(At, 0, 0); PG8_STAGE(PG8_SA(1, 1), a1 + hstep, voffA);
            PG8_WAIT_L(8); PG8_BAR; PG8_WAIT_L(0); PG8_MMA(0, 0, At, B0); PG8_BAR; PG8_SCHED;
            PG8_LDB(B1, 0, 1); PG8_STAGE(PG8_SB(0, 0), b2, voffB);
            PG8_BAR; PG8_WAIT_L(0); PG8_MMA(0, 1, At, B1); PG8_BAR;
            PG8_LDA(At, 0, 1); PG8_STAGE(PG8_SA(0, 0), a2, voffA);
            PG8_BAR; PG8_WAIT_L(0); PG8_MMA(1, 0, At, B0); PG8_BAR; PG8_SCHED;
            PG8_STAGE(PG8_SB(0, 1), b2 + hstep, voffB);
            PG8_WAIT_V(6); PG8_BAR; PG8_MMA(1, 1, At, B1); PG8_BAR;
            PG8_LDB(B0, 1, 0); PG8_SCHED; PG8_LDA(At, 1, 0); PG8_STAGE(PG8_SA(0, 1), a2 + hstep, voffA);
            PG8_WAIT_L(8); PG8_BAR; PG8_WAIT_L(0); PG8_MMA(0, 0, At, B0); PG8_BAR; PG8_SCHED;
            PG8_LDB(B1, 1, 1); PG8_STAGE(PG8_SB(1, 0), b3, voffB);
            PG8_BAR; PG8_WAIT_L(0); PG8_MMA(0, 1, At, B1); PG8_BAR;
            PG8_LDA(At, 1, 1); PG8_STAGE(PG8_SA(1, 0), a3, voffA);
            PG8_BAR; PG8_WAIT_L(0); PG8_MMA(1, 0, At, B0); PG8_BAR; PG8_SCHED;
            PG8_STAGE(PG8_SB(1, 1), b3 + hstep, voffB);
            PG8_WAIT_V(6); PG8_BAR; PG8_MMA(1, 1, At, B1); PG8_BAR;
        }
        PG8_STAMP();
        asm volatile("s_nop 15\n\ts_nop 15" ::: "memory");
        if constexpr (!Epi::AFTER_DRAIN) { E(acc, cur, wr, wc, fr, fq); S.done(cur); }
        PG8_STAMP();
        if (!has_next) break;
#pragma unroll
        for (int a = 0; a < 2; ++a)
#pragma unroll
            for (int b = 0; b < 2; ++b)
#pragma unroll
                for (int m = 0; m < 4; ++m)
#pragma unroll
                    for (int n = 0; n < 2; ++n) acc[a][b][m][n] = typename AccSel<MODE == 2>::T{};
        cur = nxt; cA = nA; cB = nB; ++ui;
    }
    PG8_WAIT_V(0);
    if (wr == 0) PG8_BAR;
    PG8_BAR;
    if constexpr (Epi::AFTER_DRAIN) { E.fused(acc, cur, wr, wc, fr, fq, lds, wid, lane); S.done(cur); }
    PG8_STAMP();
    if (STAMP && wid == 0) { stamps[lane] = lane < nts ? (((unsigned long long)(unsigned)ts_hi << 32) | (unsigned)ts_lo) : 0ull;
        if (lane == 62) stamps[62] = rt_entry; if (lane == 63) stamps[63] = (unsigned long long)wall_clock64(); }
#undef PG8_STAMP
#undef PG8_SA
#undef PG8_SB
#undef PG8_STAGE
#undef PG8_LDA
#undef PG8_LDB
#undef PG8_LD8
#undef PG8_HALF
#undef PG8_HALFI
#undef PG8_MMA
#undef PG8_WAIT_V
#undef PG8_WAIT_L
#undef PG8_BAR
#undef PG8_SCHED
}
}

typedef const __attribute__((address_space(4))) Args* KArgs;
struct Frame {
    LAS unsigned char* lds; int tid, lane, wave, G, bid;
    KArgs ka;
};
#define PH_ARGS() int z_ = 0; asm volatile("" : "+v"(z_)); KArgs A_ = (KArgs)((const __attribute__((address_space(4))) char*)F.ka + __builtin_amdgcn_readfirstlane(z_)); unsigned char* const ws_ = A_->ws; (void)ws_
#define WSP(T_, off) ((T_*)(ws_ + (off)))

__device__ __forceinline__ int ropeperm64(int s) { const int j = s >> 3, i = s & 7; return i < 4 ? 4 * j + i : 32 + 4 * j + (i - 4); }
__device__ __forceinline__ int ropeperm32(int s) { const int j = s >> 3, i = s & 7; return i < 4 ? 4 * j + i : 16 + 4 * j + (i - 4); }
__device__ __forceinline__ int inproj_src(int n) {
    if (n < 384) return (n & ~63) + ropeperm64(n & 63);
    if (n < 512) return 384 + ((n - 384) & ~63) + ropeperm64((n - 384) & 63);
    if (n < 1920) return n;
    if (n < 2176) { const int m = n - 1920; return 1932 + (m & ~31) + ropeperm32(m & 31); }
    if (n < 2432) { const int m = n - 2176; return 2188 + (m & ~31) + ropeperm32(m & 31); }
    if (n < 2688) return 2444 + (n - 2432);
    if (n < 2700) return 1920 + (n - 2688);
    return -1;
}
__device__ __forceinline__ int gu_src(int n) { const int tile = n >> 8, r = n & 255; return r < 128 ? tile * 128 + r : DFF + tile * 128 + (r - 128); }

constexpr int CV_T0 = DEPTH * 44 * 16;
constexpr int CV_T1 = CV_T0 + DEPTH * 16 * 16;
constexpr int CV_T2 = CV_T1 + 2 * 88 * 16;
constexpr int CV_T3 = CV_T2 + 2 * 16 * 44;
constexpr int CV_T4 = CV_T3 + 16 * 88 * 16;
constexpr int CV_T5 = CV_T4 + 16 * 16 * 44;
constexpr int PA_MODJOBS = DEPTH * 96;
constexpr int PA_JOBS = CV_T5 + PA_MODJOBS + 1;

constexpr int CJ_TOTAL = 2 * (768 + 4464);
struct ConvTile { const float* src; unsigned char* dst; int Nsrc, K, esz; bool zero, skip; };
__device__ __forceinline__ void conv_desc(const Frame& F, KArgs A_, unsigned char* ws_, int job, ConvTile& t) {
    const float* W; bf16_t* dst; int Nsrc, K, kind, rt, kt, esz = 2; bool skip = false;
    const int half = job / 5232, li0 = 2 * half; int j = job - half * 5232;
    if (j < 768) {
        const int li = li0, jd = half;
        if (j < 176) { W = A_->in[I_WIN] + (size_t)li * D * D_IN; Nsrc = D_IN; dst = WSP(bf16_t, WS_WIN) + (size_t)li * LDP * D; K = D; kind = 0; rt = j % 11; kt = j / 11; skip = true; }
        else if (j < 240) { const int r = j - 176; W = A_->in[I_WOUT] + (size_t)li * D * D; Nsrc = D; dst = WSP(bf16_t, WS_WOUT) + (size_t)li * D * D; K = D; kind = 1; rt = r % 4; kt = r / 4; }
        else if (j < 592) { const int r = j - 240; W = A_->in[I_FFNGU] + (size_t)jd * D * 2 * DFF; Nsrc = 2 * DFF; dst = WSP(bf16_t, WS_WGU) + (size_t)jd * 2 * DFF * D; K = D; kind = 2; rt = r % 22; kt = r / 22; skip = true; }
        else { const int r = j - 592; W = A_->in[I_FFND] + (size_t)jd * DFF * D; Nsrc = D; dst = WSP(bf16_t, WS_WD) + (size_t)jd * D * DFF; K = DFF; kind = 1; rt = r % 4; kt = r / 4; esz = 1; }
    } else {
        const int li = li0 + 1, jm = half; j -= 768;
        if (j < 176) { W = A_->in[I_WIN] + (size_t)li * D * D_IN; Nsrc = D_IN; dst = WSP(bf16_t, WS_WIN) + (size_t)li * LDP * D; K = D; kind = 0; rt = j % 11; kt = j / 11; skip = true; }
        else if (j < 240) { const int r = j - 176; W = A_->in[I_WOUT] + (size_t)li * D * D; Nsrc = D; dst = WSP(bf16_t, WS_WOUT) + (size_t)li * D * D; K = D; kind = 1; rt = r % 4; kt = r / 4; }
        else if (j < 240 + 8 * 352) { const int q = j - 240, e = q / 352, m = jm * 8 + e, r = q % 352; W = A_->in[I_EGU] + (size_t)m * D * 2 * DFF; Nsrc = 2 * DFF; dst = WSP(bf16_t, WS_WGUE) + (size_t)jm * 8 * 2 * DFF * D + (size_t)e * DFF * D; K = D; kind = 2; rt = r % 22; kt = r / 22; esz = 1; skip = true; }
        else { const int q = j - 240 - 8 * 352, e = q / 176, m = jm * 8 + e, r = q % 176; W = A_->in[I_ED] + (size_t)m * DFF * D; Nsrc = D; dst = WSP(bf16_t, WS_WDE) + (size_t)jm * 8 * D * DFF + (size_t)e * (D * DFF / 2); K = DFF; kind = 1; rt = r % 4; kt = r / 4; esz = 1; }
    }
    const int nd = rt * 256 + (F.tid & 255);
    const int sc = kind == 0 ? inproj_src(nd) : (kind == 2 ? gu_src(nd) : nd);
    t.src = W + (size_t)(kt * 64 + (F.tid >> 8)) * Nsrc + (sc >= 0 ? sc : 0);
    t.dst = (unsigned char*)dst + ((size_t)(rt * 256 + (F.tid >> 3)) * K + kt * 64 + (F.tid & 7) * 8) * esz;
    t.Nsrc = Nsrc; t.K = K; t.esz = esz; t.zero = sc < 0; t.skip = skip;
}
__device__ __forceinline__ void conv_load(const ConvTile& t, float (&v)[32]) {
    if (t.skip) return;
#pragma unroll
    for (int i = 0; i < 32; ++i) v[i] = __builtin_nontemporal_load(t.src + (size_t)(2 * i) * t.Nsrc);
}
__device__ __forceinline__ void conv_finish(const Frame& F, const ConvTile& t, const float (&v)[32]) {
    if (t.skip) return;
    LAS float* tile = (LAS float*)F.lds;
    const int n = F.tid & 255, kk0 = F.tid >> 8;
#pragma unroll
    for (int i = 0; i < 32; ++i) tile[(kk0 + 2 * i) * 257 + n] = t.zero ? 0.f : v[i];
    __syncthreads();
    { const int nn = F.tid >> 3, kq = F.tid & 7;
#pragma unroll
      for (int i = 0; i < 4; ++i) { float o[8];
#pragma unroll
          for (int j = 0; j < 8; ++j) o[j] = tile[(kq * 8 + j) * 257 + nn + 64 * i];
          if (t.esz == 2) { u32x4 w; w.x = pk_bf16(o[0], o[1]); w.y = pk_bf16(o[2], o[3]); w.z = pk_bf16(o[4], o[5]); w.w = pk_bf16(o[6], o[7]);
              __builtin_nontemporal_store(w, (u32x4*)(t.dst + (size_t)(64 * i) * t.K * 2)); }
          else { int w0 = 0, w1 = 0;
              w0 = __builtin_amdgcn_cvt_pk_fp8_f32(o[0] * 64.f, o[1] * 64.f, w0, false); w0 = __builtin_amdgcn_cvt_pk_fp8_f32(o[2] * 64.f, o[3] * 64.f, w0, true);
              w1 = __builtin_amdgcn_cvt_pk_fp8_f32(o[4] * 64.f, o[5] * 64.f, w1, false); w1 = __builtin_amdgcn_cvt_pk_fp8_f32(o[6] * 64.f, o[7] * 64.f, w1, true);
              __builtin_nontemporal_store((u32x2){(unsigned)w0, (unsigned)w1}, (u32x2*)(t.dst + (size_t)(64 * i) * t.K)); } } }
    __syncthreads();
}

constexpr int SJ_PER_MAT = 44, SJ_GU = 18 * SJ_PER_MAT, SJ_TOTAL = SJ_GU + DEPTH * 22;
__device__ __forceinline__ void strip_job(const Frame& F, KArgs A_, unsigned char* ws_, int job) {
    const bool isin = job >= SJ_GU;
    const int m = isin ? (job - SJ_GU) / 22 : job / SJ_PER_MAT, st = isin ? (job - SJ_GU) % 22 : job % SJ_PER_MAT;
    const float* W = isin ? A_->in[I_WIN] + (size_t)m * D * D_IN : (m < 2 ? A_->in[I_FFNGU] + (size_t)m * D * 2 * DFF : A_->in[I_EGU] + (size_t)(m - 2) * D * 2 * DFF);
    const int Nsrc = isin ? D_IN : 2 * DFF;
    unsigned char* dst = isin ? WSP(unsigned char, WS_WIN) + (size_t)m * LDP * D * 2
                       : (m < 2 ? WSP(unsigned char, WS_WGU) + (size_t)m * 2 * DFF * D * 2
                                : WSP(unsigned char, WS_WGUE) + (size_t)((m - 2) >> 3) * 8 * 2 * DFF * D * 2 + (size_t)((m - 2) & 7) * 2 * DFF * D);
    float* wsc = isin ? WSP(float, WS_WSC) + (size_t)18 * 2 * DFF + (size_t)m * LDP : WSP(float, WS_WSC) + (size_t)m * 2 * DFF;
    LAS float* pmx = (LAS float*)F.lds;
    const int cg = F.tid & 31, kq = F.tid >> 5;
    const int nd = st * 128 + 4 * cg, sc0 = isin ? inproj_src(nd) : gu_src(nd), sc = sc0 < 0 ? 0 : sc0;
    const float* wp = W + (size_t)(64 * kq) * Nsrc + sc;
    unsigned pk[4][32];
    float mx[4] = {0.f, 0.f, 0.f, 0.f};
#pragma unroll
    for (int i0 = 0; i0 < 64; i0 += 16) { f32x4 v[16];
#pragma unroll
        for (int i = 0; i < 16; ++i) { v[i] = __builtin_nontemporal_load((const f32x4*)(wp + (size_t)(i0 + i) * Nsrc)); if (sc0 < 0) v[i] = (f32x4){0.f, 0.f, 0.f, 0.f}; }
#pragma unroll
        for (int i = 0; i < 16; i += 2)
#pragma unroll
            for (int c = 0; c < 4; ++c) { mx[c] = fmaxf(mx[c], fmaxf(fabsf(v[i][c]), fabsf(v[i + 1][c]))); pk[c][(i0 + i) >> 1] = pk_bf16(v[i][c], v[i + 1][c]); } }
    __syncthreads();
#pragma unroll
    for (int c = 0; c < 4; ++c) pmx[kq * 128 + 4 * cg + c] = mx[c];
    __syncthreads();
    if (F.tid < 128) { float a = pmx[F.tid];
#pragma unroll
        for (int q = 1; q < 16; ++q) a = fmaxf(a, pmx[q * 128 + F.tid]);
        const float scl = a > 0.f ? a * (1.0f / 127.0f) : 1.0f;
        wsc[st * 128 + F.tid] = scl; pmx[2048 + F.tid] = 1.0f / scl; }
    __syncthreads();
#pragma unroll
    for (int c = 0; c < 4; ++c) { const float inv = pmx[2048 + 4 * cg + c];
        unsigned char* dp = dst + (size_t)(nd + c) * D + 64 * kq;
#pragma unroll
        for (int j = 0; j < 4; ++j) { unsigned o[4];
#pragma unroll
            for (int q = 0; q < 4; ++q) { const unsigned a = pk[c][8 * j + 2 * q], bq = pk[c][8 * j + 2 * q + 1];
                const int q0 = (int)rintf(__uint_as_float(a << 16) * inv), q1 = (int)rintf(__uint_as_float(a & 0xffff0000u) * inv), q2 = (int)rintf(__uint_as_float(bq << 16) * inv), q3 = (int)rintf(__uint_as_float(bq & 0xffff0000u) * inv);
                o[q] = (unsigned)(q0 & 0xff) | ((unsigned)(q1 & 0xff) << 8) | ((unsigned)(q2 & 0xff) << 16) | ((unsigned)(q3 & 0xff) << 24); }
            *(u32x4*)(dp + 16 * j) = (u32x4){o[0], o[1], o[2], o[3]}; } }
}

__device__ __forceinline__ void phase_pre_a(const Frame& F) {
    PH_ARGS();
    { ConvTile t0, t1; float v0[32], v1[32];
      int j = F.bid;
      if (j < CJ_TOTAL) { conv_desc(F, A_, ws_, j, t0); conv_load(t0, v0); }
      while (j < CJ_TOTAL) {
          const int jn = j + F.G;
          if (jn < CJ_TOTAL) { conv_desc(F, A_, ws_, jn, t1); conv_load(t1, v1); }
          conv_finish(F, t0, v0);
          t0 = t1;
#pragma unroll
          for (int i = 0; i < 32; ++i) v0[i] = v1[i];
          j = jn;
      } }
    for (int j = F.bid; j < SJ_TOTAL; j += F.G) strip_job(F, A_, ws_, j);
    __syncthreads();
    for (int job = CV_T5 + F.bid; job < PA_JOBS; job += F.G) {
        if (job < CV_T5) {
        } else if (job < CV_T5 + PA_MODJOBS) {

            const int q = job - CV_T5, li = q / 96, cb = q % 96;
            LAS float* act = (LAS float*)F.lds;
            LAS float* part = act + 9 * 1024;
            for (int i = F.tid; i < 9 * 1024; i += 512) { const int r = i >> 10, k = i & 1023; const float cv = r < 8 ? A_->in[I_C][r * 1024 + k] : A_->in[I_CCTX][k]; act[i] = cv / (1.0f + expf(-cv)); }
            __syncthreads();
            float acc[9];
#pragma unroll
            for (int r = 0; r < 9; ++r) acc[r] = 0.f;
            const float* wp = A_->in[I_WADA] + (size_t)li * D * 6144 + cb * 64 + F.lane;
            for (int k0 = F.wave * 128; k0 < F.wave * 128 + 128; k0 += 16) { float wv[16];
#pragma unroll
                for (int u = 0; u < 16; ++u) wv[u] = wp[(size_t)(k0 + u) * 6144];
#pragma unroll
                for (int u = 0; u < 16; ++u)
#pragma unroll
                    for (int r = 0; r < 9; ++r) acc[r] += act[r * 1024 + k0 + u] * wv[u]; }
#pragma unroll
            for (int r = 0; r < 9; ++r) part[(F.wave * 9 + r) * 64 + F.lane] = acc[r];
            __syncthreads();
            for (int i = F.tid; i < 9 * 64; i += 512) { const int r = i >> 6, l = i & 63; float s = A_->in[I_BADA][li * 6144 + cb * 64 + l];
#pragma unroll
                for (int w = 0; w < 8; ++w) s += part[(w * 9 + r) * 64 + l];
                WSP(float, WS_MOD)[(size_t)(li * 9 + r) * 6144 + cb * 64 + l] = s; }
            __syncthreads();
        } else {
            float* cA = WSP(float, WS_ROPE); float* sA = cA + 2048 * 32; float* cC = sA + 2048 * 32; float* sC = cC + 2048 * 16;
            for (int idx = F.tid; idx < 2048 * 48; idx += 512) {
                const int pos = idx / 48, p = idx % 48; const float rowf = (float)(pos >> 6), colf = (float)(pos & 63);
                if (p < 32) { const int i = p & 15; const float inv = exp2f(-(float)i * (13.287712379549449f / 16.0f)); const float ang = (p < 16 ? rowf : colf) * inv; cA[pos * 32 + p] = __cosf(ang); sA[pos * 32 + p] = __sinf(ang); }
                else { const int pp = p - 32, i = pp & 7; const float inv = exp2f(-(float)i * (13.287712379549449f / 8.0f)); const float ang = (pp < 8 ? rowf : colf) * inv; cC[pos * 16 + pp] = __cosf(ang); sC[pos * 16 + pp] = __sinf(ang); }
            }
        }
    }
}

__device__ __forceinline__ void row_load(float (&v)[16], const float* p, int lane) {
#pragma unroll
    for (int i = 0; i < 2; ++i) { const f32x4 x = *(const f32x4*)(p + 512 * i + 8 * lane), y = *(const f32x4*)(p + 512 * i + 8 * lane + 4);
        v[8 * i] = x[0]; v[8 * i + 1] = x[1]; v[8 * i + 2] = x[2]; v[8 * i + 3] = x[3]; v[8 * i + 4] = y[0]; v[8 * i + 5] = y[1]; v[8 * i + 6] = y[2]; v[8 * i + 7] = y[3]; }
}
__device__ __forceinline__ void row_load_bf16(float (&v)[16], const bf16_t* p, int lane) {
#pragma unroll
    for (int i = 0; i < 2; ++i) { const u32x4 x = *(const u32x4*)(p + 512 * i + 8 * lane);
        v[8 * i] = __uint_as_float(x.x << 16); v[8 * i + 1] = __uint_as_float(x.x & 0xffff0000u); v[8 * i + 2] = __uint_as_float(x.y << 16); v[8 * i + 3] = __uint_as_float(x.y & 0xffff0000u);
        v[8 * i + 4] = __uint_as_float(x.z << 16); v[8 * i + 5] = __uint_as_float(x.z & 0xffff0000u); v[8 * i + 6] = __uint_as_float(x.w << 16); v[8 * i + 7] = __uint_as_float(x.w & 0xffff0000u); }
}
__device__ __forceinline__ void row_store(const float (&v)[16], float* p, int lane) {
#pragma unroll
    for (int i = 0; i < 2; ++i) { *(f32x4*)(p + 512 * i + 8 * lane) = (f32x4){v[8 * i], v[8 * i + 1], v[8 * i + 2], v[8 * i + 3]}; *(f32x4*)(p + 512 * i + 8 * lane + 4) = (f32x4){v[8 * i + 4], v[8 * i + 5], v[8 * i + 6], v[8 * i + 7]}; }
}
__device__ __forceinline__ void row_store_bf16(const float (&v)[16], bf16_t* p, int lane) {
#pragma unroll
    for (int i = 0; i < 2; ++i) { u32x4 w; w.x = pk_bf16(v[8 * i], v[8 * i + 1]); w.y = pk_bf16(v[8 * i + 2], v[8 * i + 3]); w.z = pk_bf16(v[8 * i + 4], v[8 * i + 5]); w.w = pk_bf16(v[8 * i + 6], v[8 * i + 7]); *(u32x4*)(p + 512 * i + 8 * lane) = w; }
}
__device__ __forceinline__ void row_store_fp8(const float (&v)[16], unsigned char* p, int lane) {
#pragma unroll
    for (int i = 0; i < 2; ++i) { int w0 = 0, w1 = 0; float c[8];
#pragma unroll
        for (int j = 0; j < 8; ++j) c[j] = __builtin_amdgcn_fmed3f(v[8 * i + j], -448.f, 448.f);
        w0 = __builtin_amdgcn_cvt_pk_fp8_f32(c[0], c[1], w0, false); w0 = __builtin_amdgcn_cvt_pk_fp8_f32(c[2], c[3], w0, true);
        w1 = __builtin_amdgcn_cvt_pk_fp8_f32(c[4], c[5], w1, false); w1 = __builtin_amdgcn_cvt_pk_fp8_f32(c[6], c[7], w1, true);
        *(u32x2*)(p + 512 * i + 8 * lane) = (u32x2){(unsigned)w0, (unsigned)w1}; }
}
__device__ __forceinline__ float row_store_i8(const float (&v)[16], unsigned char* p, int lane) {
    float a = 0.f;
#pragma unroll
    for (int i = 0; i < 16; ++i) a = fmaxf(a, fabsf(v[i]));
#pragma unroll
    for (int o = 32; o >= 1; o >>= 1) a = fmaxf(a, __shfl_xor(a, o));
    const float scl = a > 0.f ? a * (1.0f / 127.0f) : 1.0f, inv = 1.0f / scl;
#pragma unroll
    for (int i = 0; i < 2; ++i) { unsigned w[2];
#pragma unroll
        for (int q = 0; q < 2; ++q) { const int q0 = (int)rintf(v[8 * i + 4 * q] * inv), q1 = (int)rintf(v[8 * i + 4 * q + 1] * inv), q2 = (int)rintf(v[8 * i + 4 * q + 2] * inv), q3 = (int)rintf(v[8 * i + 4 * q + 3] * inv);
            w[q] = (unsigned)(q0 & 0xff) | ((unsigned)(q1 & 0xff) << 8) | ((unsigned)(q2 & 0xff) << 16) | ((unsigned)(q3 & 0xff) << 24); }
        *(u32x2*)(p + 512 * i + 8 * lane) = (u32x2){w[0], w[1]}; }
    return scl;
}
__device__ __forceinline__ void row_ln(float (&v)[16]) {
    float s = 0.f;
#pragma unroll
    for (int i = 0; i < 16; ++i) s += v[i];
    const float mean = wave_sum(s) * (1.0f / 1024.0f);
    float q = 0.f;
#pragma unroll
    for (int i = 0; i < 16; ++i) { v[i] -= mean; q += v[i] * v[i]; }
    const float rstd = rsqrtf(wave_sum(q) * (1.0f / 1024.0f) + LN_EPS);
#pragma unroll
    for (int i = 0; i < 16; ++i) v[i] *= rstd;
}
__device__ __forceinline__ void row_modulate(const float (&v)[16], float (&h)[16], const float* shift, const float* scale, int lane) {
    float sh[16], sc[16]; row_load(sh, shift, lane); row_load(sc, scale, lane);
#pragma unroll
    for (int i = 0; i < 16; ++i) h[i] = v[i] * (1.0f + sc[i]) + sh[i];
}
__device__ __forceinline__ const float* mod_row(unsigned char* ws_, int li, int row) { const int b = row / TB, t = row - b * TB; return WSP(float, WS_MOD) + (size_t)(li * 9 + (t < NCTX ? 8 : b)) * 6144; }

__device__ __forceinline__ void phase_pre_b(const Frame& F) {
    PH_ARGS();
    const int stride = F.G * 8;
    int row = F.bid * 8 + F.wave;
    float cur[16], nxt[16];
#define PB_SRC(r_) ((r_) % TB < NCTX ? A_->in[I_CTX] + (size_t)(((r_) / TB) * NCTX + (r_) % TB) * D : A_->in[I_X] + (size_t)(((r_) / TB) * SEQ + ((r_) % TB - NCTX)) * D)
    if (row < T) row_load(cur, PB_SRC(row), F.lane);
    while (row < T) {
        const int nr = row + stride;
        if (nr < T) row_load(nxt, PB_SRC(nr), F.lane);
        float h[16]; row_store(cur, WSP(float, WS_X) + (size_t)row * D, F.lane);
        row_ln(cur); const float* md = mod_row(ws_, 0, row); row_modulate(cur, h, md, md + 1024, F.lane);
        { const float scl = row_store_i8(h, WSP(unsigned char, WS_H) + (size_t)row * D, F.lane); if (F.lane == 0) WSP(float, WS_RSC)[row] = scl; }
#pragma unroll
        for (int i = 0; i < 16; ++i) cur[i] = nxt[i];
        row = nr;
    }
#undef PB_SRC
}

__device__ __forceinline__ void phase_post_mixer(const Frame& F, int li) {
    PH_ARGS(); const bool moe = li & 1; const int jm = li >> 1;
    const bool skip_ctx = li == DEPTH - 1;
    LAS float* wr = (LAS float*)F.lds;
    if (moe) { for (int i = F.tid; i < 1024 * 8; i += 512) wr[(i & 7) * 1024 + (i >> 3)] = A_->in[I_RW][(size_t)jm * 8192 + i]; __syncthreads(); }
    unsigned* cnt = (unsigned*)(ws_ + WS_CTL + CTL_CNT_OFF);
    LAS unsigned* bcnt = (LAS unsigned*)(wr + 8192);
    LAS unsigned* rtab = bcnt + 16;
    LAS float* rwt = (LAS float*)(rtab + 8 * 16 * 4);
    if (moe) { if (F.tid < 16) bcnt[F.tid] = 0u; __syncthreads(); }
    const int stride = F.G * 8;
    int row = F.bid * 8 + F.wave, rix = 0;
    float v[16], o[16], vn[16], on[16];
#define PM_LIVE(r_) ((r_) < T && !(skip_ctx && (r_) % TB < NCTX))
    if (PM_LIVE(row)) { row_load(v, WSP(float, WS_X) + (size_t)row * D, F.lane); row_load_bf16(o, WSP(bf16_t, WS_O) + (size_t)row * D, F.lane); }
    while (row < T) {
        const int nr = row + stride;
        if (PM_LIVE(nr)) { row_load(vn, WSP(float, WS_X) + (size_t)nr * D, F.lane); row_load_bf16(on, WSP(bf16_t, WS_O) + (size_t)nr * D, F.lane); }
        if (PM_LIVE(row)) {
        const float* md = mod_row(ws_, li, row);
        float g[16], lg1[16], lb1[16];
        row_load(g, md + 2048, F.lane); row_load(lg1, A_->in[I_LN1G] + li * D, F.lane); row_load(lb1, A_->in[I_LN1B] + li * D, F.lane);
#pragma unroll
        for (int i = 0; i < 16; ++i) v[i] = ALPHA_RES * v[i] + g[i] * o[i];
        row_ln(v);
#pragma unroll
        for (int i = 0; i < 16; ++i) v[i] = v[i] * lg1[i] + lb1[i];
        row_store(v, WSP(float, WS_X) + (size_t)row * D, F.lane);
        row_ln(v);
        float h[16]; row_modulate(v, h, md + 3072, md + 4096, F.lane);
        if (!moe) { const float scl = row_store_i8(h, WSP(unsigned char, WS_H) + (size_t)row * D, F.lane); if (F.lane == 0) WSP(float, WS_RSC)[row] = scl; }
        else {
        float lg[8];
#pragma unroll
        for (int e = 0; e < 8; ++e) lg[e] = 0.f;
#pragma unroll
        for (int e = 0; e < 8; ++e)
#pragma unroll
            for (int i = 0; i < 2; ++i) { const f32x4 w0 = *(const LAS f32x4*)(wr + e * 1024 + 512 * i + 8 * F.lane), w1 = *(const LAS f32x4*)(wr + e * 1024 + 512 * i + 8 * F.lane + 4);
                lg[e] += (h[8 * i] * w0[0] + h[8 * i + 1] * w0[1]) + (h[8 * i + 2] * w0[2] + h[8 * i + 3] * w0[3]) + (h[8 * i + 4] * w1[0] + h[8 * i + 5] * w1[1]) + (h[8 * i + 6] * w1[2] + h[8 * i + 7] * w1[3]); }
#pragma unroll
        for (int e = 0; e < 8; ++e) lg[e] = wave_sum(lg[e]) + A_->in[I_RB][jm * 8 + e];
        int e1 = 0; float v1 = lg[0];
#pragma unroll
        for (int e = 1; e < 8; ++e) if (lg[e] > v1) { v1 = lg[e]; e1 = e; }
        int e2 = -1; float v2 = -3.0e38f;
#pragma unroll
        for (int e = 0; e < 8; ++e) if (e != e1 && lg[e] > v2) { v2 = lg[e]; e2 = e; }
        if (e2 < 0) { e2 = e1 == 0 ? 1 : 0; v2 = v1; }
        const float w2 = 1.0f / (1.0f + expf(v1 - v2)), w1 = 1.0f - w2;
        { const float scl = row_store_i8(h, WSP(unsigned char, WS_H) + (size_t)row * D, F.lane); if (F.lane == 0) WSP(float, WS_RSC)[row] = scl; }
        if (F.lane == 0) { const unsigned q1 = atomicAdd((unsigned*)(bcnt + e1), 1u), q2 = atomicAdd((unsigned*)(bcnt + e2), 1u);
            LAS unsigned* te = rtab + (F.wave * 16 + rix) * 4; te[0] = e1; te[1] = q1; te[2] = e2; te[3] = q2; rwt[(F.wave * 16 + rix) * 2] = w1; rwt[(F.wave * 16 + rix) * 2 + 1] = w2; }
        }
        }
        ++rix;
#pragma unroll
        for (int i = 0; i < 16; ++i) { v[i] = vn[i]; o[i] = on[i]; }
        row = nr;
    }
    if (moe) {
        __syncthreads();
        if (F.tid < 8) bcnt[8 + F.tid] = atomicAdd(&cnt[(jm * 8 + F.tid) * 64], bcnt[F.tid]);
        asm volatile("s_waitcnt vmcnt(0)" ::: "memory");
        __syncthreads();
        int r2 = F.bid * 8 + F.wave;
        for (int i = 0; i < rix; ++i, r2 += stride) {
            if (!PM_LIVE(r2)) continue;
            const LAS unsigned* te = rtab + (F.wave * 16 + i) * 4;
            const unsigned e1 = te[0], p1 = bcnt[8 + e1] + te[1], e2 = te[2], p2 = bcnt[8 + e2] + te[3];
            const unsigned char* src = WSP(unsigned char, WS_H) + (size_t)r2 * D + 16 * F.lane;
            const u32x4 hv = *(const u32x4*)src;
            *(u32x4*)(WSP(unsigned char, WS_HP) + ((size_t)e1 * MOE_CAP + p1) * D + 16 * F.lane) = hv;
            *(u32x4*)(WSP(unsigned char, WS_HP) + ((size_t)e2 * MOE_CAP + p2) * D + 16 * F.lane) = hv;
            if (F.lane == 0) { const float scl = WSP(float, WS_RSC)[r2]; WSP(float, WS_HPS)[(size_t)e1 * MOE_CAP + p1] = scl; WSP(float, WS_HPS)[(size_t)e2 * MOE_CAP + p2] = scl; }
            if (F.lane == 0) { unsigned* tk = WSP(unsigned, WS_TOK) + (size_t)r2 * 8; tk[0] = e1; tk[1] = p1; tk[2] = e2; tk[3] = p2; tk[4] = __float_as_uint(rwt[(F.wave * 16 + i) * 2]); tk[5] = __float_as_uint(rwt[(F.wave * 16 + i) * 2 + 1]); }
        }
    }
#undef PM_LIVE
}

__device__ __forceinline__ void phase_post_ffn(const Frame& F, int li) {
    PH_ARGS(); const bool moe = li & 1; const int jm = li >> 1; const bool last = li == DEPTH - 1;
    int tb[8];
    if (moe) { const unsigned* cnt = (const unsigned*)(ws_ + WS_CTL + CTL_CNT_OFF); int acc = 0;
#pragma unroll
        for (int e = 0; e < 8; ++e) { tb[e] = acc; acc += ((int)cnt[(jm * 8 + e) * 64] + 255) >> 8; } }
    const int stride = F.G * 8;
    int row = F.bid * 8 + F.wave;
    float v[16], f[16], vn[16], fn[16];
#define PF_LIVE(r_) ((r_) < T && !(last && (r_) % TB < NCTX))
#define PF_LOAD(r_, v_, f_) do { row_load(v_, WSP(float, WS_X) + (size_t)(r_) * D, F.lane); \
        if (!moe) row_load_bf16(f_, WSP(bf16_t, WS_O) + (size_t)(r_) * D, F.lane); \
        else { const unsigned* tk = WSP(unsigned, WS_TOK) + (size_t)(r_) * 8; \
            const int e1 = tk[0], p1 = tk[1], e2 = tk[2], p2 = tk[3]; const float w1 = __uint_as_float(tk[4]), w2 = __uint_as_float(tk[5]); \
            int b1 = 0, b2 = 0; \
            _Pragma("unroll") for (int e = 0; e < 8; ++e) { b1 = e1 == e ? tb[e] : b1; b2 = e2 == e ? tb[e] : b2; } \
            float f2[16]; \
            row_load_bf16(f_, WSP(bf16_t, WS_HP) + ((size_t)b1 * 256 + p1) * D, F.lane); row_load_bf16(f2, WSP(bf16_t, WS_HP) + ((size_t)b2 * 256 + p2) * D, F.lane); \
            _Pragma("unroll") for (int i = 0; i < 16; ++i) f_[i] = w1 * f_[i] + w2 * f2[i]; } } while (0)
    if (PF_LIVE(row)) PF_LOAD(row, v, f);
    while (row < T) {
        const int nr = row + stride;
        if (PF_LIVE(nr)) PF_LOAD(nr, vn, fn);
        if (PF_LIVE(row)) {
        const int b = row / TB, t = row - b * TB;
        const float* md = mod_row(ws_, li, row);
        float g[16], lg2[16], lb2[16];
        row_load(g, md + 5120, F.lane); row_load(lg2, A_->in[I_LN2G] + li * D, F.lane); row_load(lb2, A_->in[I_LN2B] + li * D, F.lane);
#pragma unroll
        for (int i = 0; i < 16; ++i) v[i] = ALPHA_RES * v[i] + g[i] * f[i];
        row_ln(v);
#pragma unroll
        for (int i = 0; i < 16; ++i) v[i] = v[i] * lg2[i] + lb2[i];
        if (last) row_store(v, A_->out + (size_t)(b * SEQ + (t - NCTX)) * D, F.lane);
        else {
        row_store(v, WSP(float, WS_X) + (size_t)row * D, F.lane);
        row_ln(v);
        const float* mdn = mod_row(ws_, li + 1, row);
        float h[16]; row_modulate(v, h, mdn, mdn + 1024, F.lane);
        { const float scl = row_store_i8(h, WSP(unsigned char, WS_H) + (size_t)row * D, F.lane); if (F.lane == 0) WSP(float, WS_RSC)[row] = scl; }
        }
        }
#pragma unroll
        for (int i = 0; i < 16; ++i) { v[i] = vn[i]; f[i] = fn[i]; }
        row = nr;
    }
#undef PF_LIVE
#undef PF_LOAD
}

__device__ __forceinline__ bf16x8 lds_frag(const LAS bf16_t* base, int ld, int row0, int k0, int lane) {
    return *(const LAS bf16x8*)(base + (row0 + (lane & 15)) * ld + k0 + 8 * (lane >> 4));
}
#define MFMA16(a, b, c) __builtin_amdgcn_mfma_f32_16x16x32_bf16((a), (b), (c), 0, 0, 0)

constexpr int LDT = 136;


typedef float f32x16 __attribute__((ext_vector_type(16)));
#define MFMA32(a, b, c) __builtin_amdgcn_mfma_f32_32x32x16_bf16((a), (b), (c), 0, 0, 0)
constexpr int LD2 = 72;
constexpr int AT2_TILE = 64 * LD2;
constexpr float M_INIT = -10000.0f;

template <int NMAP> struct At2State { float m[NMAP], l[NMAP]; f32x16 O[NMAP][2]; u32x4 qa[NMAP]; };
typedef __bf16 bf16v2 __attribute__((ext_vector_type(2)));
__device__ __forceinline__ unsigned pk_bf16n(float lo, float hi) { return __builtin_bit_cast(unsigned, __builtin_convertvector((f32x2){lo, hi}, bf16v2)); }
constexpr float AT2_THR = 8.0f;

template <int NMAP, int DQK, bool WINDOW>
__device__ __forceinline__ void at2_step(const LAS bf16_t* Kt, const LAS bf16_t* Vt, const bf16x8 (&qf)[NMAP][DQK / 16], At2State<NMAP>& st, const u32x4 kaug, bool first, bool on0, bool on1, int tq, int tk0, int lane) {
    const int r = lane & 31, h = lane >> 5;
    bf16x8 kf[NMAP][2][DQK / 16];
#pragma unroll
    for (int mp = 0; mp < NMAP; ++mp)
#pragma unroll
        for (int t2 = 0; t2 < 2; ++t2)
#pragma unroll
            for (int sx = 0; sx < DQK / 16; ++sx) kf[mp][t2][sx] = *(const LAS bf16x8*)(Kt + (32 * t2 + r) * LD2 + mp * DQK + 16 * sx + 8 * h);
    __builtin_amdgcn_sched_barrier(0);
    f32x16 s[NMAP][2];
#pragma unroll
    for (int mp = 0; mp < NMAP; ++mp)
#pragma unroll
        for (int t2 = 0; t2 < 2; ++t2) {
            f32x16 acc;
#pragma unroll
            for (int i = 0; i < 16; ++i) acc[i] = 0.f;
#pragma unroll
            for (int sx = 0; sx < DQK / 16; ++sx) acc = MFMA32(kf[mp][t2][sx], qf[mp][sx], acc);
            s[mp][t2] = MFMA32(__builtin_bit_cast(bf16x8, kaug), __builtin_bit_cast(bf16x8, st.qa[mp]), acc);
        }
    bf16x8 vf[2][4];
#pragma unroll
    for (int dt = 0; dt < 2; ++dt)
#pragma unroll
        for (int ks = 0; ks < 4; ++ks) vf[dt][ks] = *(const LAS bf16x8*)(Vt + (32 * dt + r) * LD2 + 16 * ks + 8 * h);
    bf16x8 pf[NMAP][4];
#pragma unroll
    for (int mp = 0; mp < NMAP; ++mp) {
#pragma unroll
        for (int t2 = 0; t2 < 2; ++t2) {
            const bool on = t2 ? on1 : on0;
            if (!on) {
#pragma unroll
                for (int i = 0; i < 16; ++i) s[mp][t2][i] = -1.0e30f;
            } else if (WINDOW) {
#pragma unroll
                for (int i = 0; i < 16; ++i) { const int d = tq - (tk0 + 32 * t2 + (i & 3) + 8 * (i >> 2) + 4 * h); if (d > 128 || d < -128) s[mp][t2][i] = -1.0e30f; }
            }
        }
        float mx = fmaxf(s[mp][0][0], s[mp][1][0]);
#pragma unroll
        for (int t2 = 0; t2 < 2; ++t2) {
            mx = fmaxf(mx, s[mp][t2][1]);
#pragma unroll
            for (int i = 2; i < 16; i += 2) mx = fmaxf(fmaxf(mx, s[mp][t2][i]), s[mp][t2][i + 1]);
        }
        { const auto sw = __builtin_amdgcn_permlane32_swap(__float_as_uint(mx), __float_as_uint(mx), false, false); mx = fmaxf(__uint_as_float(sw[0]), __uint_as_float(sw[1])); }
        if (first || __builtin_amdgcn_ballot_w64(mx > AT2_THR) != 0ull) {
            const float dl = first ? fmaxf(mx, M_INIT) : fmaxf(mx, 0.f);
            const float t = st.m[mp] + dl; const unsigned tb = pk_bf16n(t, t) & 0xffffu;
            const float mnew = __uint_as_float(tb << 16), d = mnew - st.m[mp], al = first ? 0.f : fast_exp2(-d);
            st.m[mp] = mnew; st.l[mp] *= al; st.qa[mp].x = h ? 0u : (tb ^ 0x8000u);
#pragma unroll
            for (int dt = 0; dt < 2; ++dt)
#pragma unroll
                for (int i = 0; i < 16; ++i) st.O[mp][dt][i] *= al;
#pragma unroll
            for (int t2 = 0; t2 < 2; ++t2)
#pragma unroll
                for (int i = 0; i < 16; ++i) s[mp][t2][i] -= d;
        }
        float ls0 = 0.f, ls1 = 0.f;
#pragma unroll
        for (int ks = 0; ks < 4; ++ks) { f32x16& sv = s[mp][ks >> 1]; const int o = 8 * (ks & 1); u32x4 w;
#pragma unroll
            for (int e = 0; e < 8; ++e) sv[o + e] = fast_exp2(sv[o + e]);
            ls0 += (sv[o + 0] + sv[o + 1]) + (sv[o + 2] + sv[o + 3]); ls1 += (sv[o + 4] + sv[o + 5]) + (sv[o + 6] + sv[o + 7]);
            w.x = pk_bf16n(sv[o + 0], sv[o + 1]); w.y = pk_bf16n(sv[o + 2], sv[o + 3]); w.z = pk_bf16n(sv[o + 4], sv[o + 5]); w.w = pk_bf16n(sv[o + 6], sv[o + 7]);
            pf[mp][ks] = __builtin_bit_cast(bf16x8, w); }
        st.l[mp] += ls0 + ls1;
    }
#pragma unroll
    for (int ks = 0; ks < 4; ++ks) {
        const bool on = (ks >> 1) ? on1 : on0;
        if (on) {
#pragma unroll
            for (int dt = 0; dt < 2; ++dt)
#pragma unroll
                for (int mp = 0; mp < NMAP; ++mp) st.O[mp][dt] = MFMA32(vf[dt][ks], pf[mp][ks], st.O[mp][dt]);
        }
    }
}
__device__ __forceinline__ int perm16(int k) { return 8 * ((k >> 2) & 1) + 4 * (k >> 3) + (k & 3); }

__device__ __forceinline__ void attn_c2_unit(const Frame& F, int li, int unit) {
    PH_ARGS();
    const bool ctxq = unit >= NB * 4 * 8;
    int b, h, t0;
    if (!ctxq) { b = unit >> 5; h = (unit >> 3) & 3; t0 = NCTX + (unit & 7) * 256; } else { const int u = unit - NB * 4 * 8; b = u >> 2; h = u & 3; t0 = 0; }
    const int nsteps = ctxq ? NCTX / 64 : TB / 64;
    const int rb = b * TB, r = F.lane & 31, hh = F.lane >> 5;
    const float lam_init = 0.8f - 0.6f * expf(-0.3f * (float)li);
    float d0 = 0.f, d1 = 0.f;
    if (F.lane < 32) { d0 = A_->in[I_LAMQ][li * 64 + F.lane] * A_->in[I_LAMK][li * 64 + F.lane]; d1 = A_->in[I_LAMQ][li * 64 + 32 + F.lane] * A_->in[I_LAMK][li * 64 + 32 + F.lane]; }
    const float lam = expf(wave_sum(d0)) - expf(wave_sum(d1)) + lam_init;
    const bf16_t* P = WSP(bf16_t, WS_P);
    const bf16_t* VT = WSP(bf16_t, WS_VTC) + (size_t)(b * 4 + h) * 64 * TB;
    const int tq = t0 + 32 * F.wave + r;
    bf16x8 qf[2][2];
#pragma unroll
    for (int mp = 0; mp < 2; ++mp)
#pragma unroll
        for (int sx = 0; sx < 2; ++sx) qf[mp][sx] = *(const bf16x8*)(P + (size_t)(rb + tq) * LDP + PC_QC + (2 * h + mp) * 32 + 16 * sx + 8 * hh);
    At2State<2> st; const u32x4 kaug = {hh ? 0u : 0x3f80u, 0u, 0u, 0u};
#pragma unroll
    for (int mp = 0; mp < 2; ++mp) { st.m[mp] = 0.f; st.l[mp] = 0.f; st.qa[mp] = (u32x4){0u, 0u, 0u, 0u};
#pragma unroll
        for (int dt = 0; dt < 2; ++dt)
#pragma unroll
            for (int i = 0; i < 16; ++i) st.O[mp][dt][i] = 0.f; }
    const int srow = F.tid >> 3, spc = F.tid & 7;
    const bf16_t* kp = P + (size_t)(rb + srow) * LDP + PC_KC + h * 64 + spc * 8;
    const bf16_t* vp = VT + (size_t)srow * TB + spc * 8;
    LAS bf16_t* SB = (LAS bf16_t*)F.lds;
    const int nst2 = nsteps >> 1;
    u32x4 kr[2], vr[2];
#pragma unroll
    for (int p = 0; p < 2; ++p) { kr[p] = *(const u32x4*)(kp + (size_t)(64 * p) * LDP); vr[p] = *(const u32x4*)(vp + 64 * p); }
    __syncthreads();
#pragma unroll
    for (int p = 0; p < 2; ++p) { *(LAS u32x4*)(SB + p * AT2_TILE + srow * LD2 + spc * 8) = kr[p]; *(LAS u32x4*)(SB + (2 + p) * AT2_TILE + srow * LD2 + spc * 8) = vr[p]; }
    __syncthreads();
#pragma unroll
    for (int mp = 0; mp < 2; ++mp)
#pragma unroll
        for (int sx = 0; sx < 2; ++sx) asm volatile("" : "+v"(qf[mp][sx]));
    for (int sp = 0; sp < nst2; ++sp) {
        const int cur = sp & 1;
        if (sp + 1 < nst2) {
#pragma unroll
            for (int p = 0; p < 2; ++p) { kr[p] = *(const u32x4*)(kp + (size_t)((sp + 1) * 128 + 64 * p) * LDP); vr[p] = *(const u32x4*)(vp + (sp + 1) * 128 + 64 * p); } }
#pragma unroll 1
        for (int p = 0; p < 2; ++p) at2_step<2, 32, false>(SB + (cur * 4 + p) * AT2_TILE, SB + (cur * 4 + 2 + p) * AT2_TILE, qf, st, kaug, (sp | p) == 0, true, true, 0, 0, F.lane);
        if (sp + 1 < nst2) {
#pragma unroll
            for (int p = 0; p < 2; ++p) { *(LAS u32x4*)(SB + ((cur ^ 1) * 4 + p) * AT2_TILE + srow * LD2 + spc * 8) = kr[p]; *(LAS u32x4*)(SB + ((cur ^ 1) * 4 + 2 + p) * AT2_TILE + srow * LD2 + spc * 8) = vr[p]; } }
        __syncthreads();
    }
    const float i0 = 1.0f / (st.l[0] + __shfl_xor(st.l[0], 32)), i1 = lam / (st.l[1] + __shfl_xor(st.l[1], 32));
    float ss = 0.f;
#pragma unroll
    for (int dt = 0; dt < 2; ++dt)
#pragma unroll
        for (int i = 0; i < 16; ++i) { const float o = st.O[0][dt][i] * i0 - st.O[1][dt][i] * i1; st.O[0][dt][i] = o; ss += o * o; }
    ss += __shfl_xor(ss, 32);
    const float sc = rsqrtf(ss * (1.0f / 64.0f) + LN_EPS) * (1.0f - lam_init);
    bf16_t* op = WSP(bf16_t, WS_MIX) + (size_t)(rb + tq) * D + 768 + h * 64;
#pragma unroll
    for (int dt = 0; dt < 2; ++dt)
#pragma unroll
        for (int q4 = 0; q4 < 4; ++q4) { const int d = 32 * dt + 8 * q4 + 4 * hh; const f32x4 nw = *(const f32x4*)(A_->in[I_DIFFNW] + li * 64 + d);
            u32x2 w; w.x = pk_bf16(st.O[0][dt][4 * q4] * sc * nw[0], st.O[0][dt][4 * q4 + 1] * sc * nw[1]); w.y = pk_bf16(st.O[0][dt][4 * q4 + 2] * sc * nw[2], st.O[0][dt][4 * q4 + 3] * sc * nw[3]);
            *(u32x2*)(op + d) = w; }
}

__device__ __forceinline__ void attn_a2_unit(const Frame& F, int li, int unit) {
    PH_ARGS();
    const int qt = unit % NCH, hq = (unit / NCH) % 6, b = unit / (6 * NCH), kvh = hq / 3;
    const int rb = b * TB, r = F.lane & 31, hh = F.lane >> 5, grp = F.wave & 3, part = F.wave >> 2;
    const bf16_t* P = WSP(bf16_t, WS_P);
    const bf16_t* VT = WSP(bf16_t, WS_VTA) + (size_t)(b * 2 + kvh) * 64 * TB;
    LAS bf16_t* SB = (LAS bf16_t*)F.lds;
    const int q0 = 128 * qt + 32 * grp, tq = q0 + r;
    bf16x8 qf[1][4];
#pragma unroll
    for (int sx = 0; sx < 4; ++sx) qf[0][sx] = *(const bf16x8*)(P + (size_t)(rb + tq) * LDP + PC_QA + hq * 64 + 16 * sx + 8 * hh);
    At2State<1> st; st.m[0] = 0.f; st.l[0] = 0.f; st.qa[0] = (u32x4){0u, 0u, 0u, 0u}; const u32x4 kaug = {hh ? 0u : 0x3f80u, 0u, 0u, 0u};
#pragma unroll
    for (int dt = 0; dt < 2; ++dt)
#pragma unroll
        for (int i = 0; i < 16; ++i) st.O[0][dt][i] = 0.f;
    const int nit = qt < 2 ? 2 : 5;
    const int srow = F.tid >> 3, spc = F.tid & 7;
#define A2_STEP_T(s) ((s) < 4 ? 64 * (s) : ((128 * (qt - 1) + 64 * ((s) - 4)) >= NCTX && (128 * (qt - 1) + 64 * ((s) - 4)) < TB ? (128 * (qt - 1) + 64 * ((s) - 4)) : -1))
    u32x4 kr[2], vr[2];
#define A2_LOAD(it) do { _Pragma("unroll") for (int p_ = 0; p_ < 2; ++p_) { int t_ = A2_STEP_T(2 * (it) + p_); if (t_ < 0) t_ = 0; \
        kr[p_] = *(const u32x4*)(P + (size_t)(rb + t_ + srow) * LDP + PC_KA + kvh * 64 + spc * 8); vr[p_] = *(const u32x4*)(VT + (size_t)srow * TB + t_ + spc * 8); } } while (0)
#define A2_STORE(buf) do { _Pragma("unroll") for (int p_ = 0; p_ < 2; ++p_) { *(LAS u32x4*)(SB + ((buf) * 4 + p_) * AT2_TILE + srow * LD2 + spc * 8) = kr[p_]; \
        *(LAS u32x4*)(SB + ((buf) * 4 + 2 + p_) * AT2_TILE + srow * LD2 + spc * 8) = vr[p_]; } } while (0)
    A2_LOAD(0);
    __syncthreads();
    A2_STORE(0);
    __syncthreads();
    for (int it = 0; it < nit; ++it) {
        const int cur = it & 1;
        if (it + 1 < nit) A2_LOAD(it + 1);
        const int sidx = 2 * it + part, tk0 = A2_STEP_T(sidx);
        const LAS bf16_t* Kt = SB + (cur * 4 + part) * AT2_TILE; const LAS bf16_t* Vt = SB + (cur * 4 + 2 + part) * AT2_TILE;
        if (sidx < 4) at2_step<1, 64, false>(Kt, Vt, qf, st, kaug, it == 0, true, true, 0, 0, F.lane);
        else if (tk0 >= 0) {
            const bool on0 = (tk0 + 31 >= q0 - 128) && (tk0 <= q0 + 31 + 128), on1 = (tk0 + 63 >= q0 - 128) && (tk0 + 32 <= q0 + 31 + 128);
            if (on0 || on1) at2_step<1, 64, true>(Kt, Vt, qf, st, kaug, false, on0, on1, tq, tk0, F.lane);
        }
        if (it + 1 < nit) A2_STORE(cur ^ 1);
        __syncthreads();
    }
#undef A2_STEP_T
#undef A2_LOAD
#undef A2_STORE
    const float ltot = st.l[0] + __shfl_xor(st.l[0], 32);
    LAS float* MB = (LAS float*)F.lds + grp * 34 * 64;
    if (part == 1) { MB[F.lane] = st.m[0]; MB[64 + F.lane] = ltot;
#pragma unroll
        for (int dt = 0; dt < 2; ++dt)
#pragma unroll
            for (int i = 0; i < 16; ++i) MB[(2 + dt * 16 + i) * 64 + F.lane] = st.O[0][dt][i]; }
    __syncthreads();
    if (part == 0) {
        const float m2 = MB[F.lane], l2 = MB[64 + F.lane];
        const float mm = fmaxf(st.m[0], m2), a1 = fast_exp2(st.m[0] - mm), a2 = fast_exp2(m2 - mm);
        const float sk = A_->in[I_SINK][li * 6 + hq] * LOG2E;
        const float inv = 1.0f / (ltot * a1 + l2 * a2 + fast_exp2(sk - mm));
        bf16_t* op = WSP(bf16_t, WS_MIX) + (size_t)(rb + tq) * D + hq * 64;
#pragma unroll
        for (int dt = 0; dt < 2; ++dt)
#pragma unroll
            for (int q4 = 0; q4 < 4; ++q4) { float o[4];
#pragma unroll
                for (int e = 0; e < 4; ++e) o[e] = (st.O[0][dt][4 * q4 + e] * a1 + MB[(2 + dt * 16 + 4 * q4 + e) * 64 + F.lane] * a2) * inv;
                u32x2 w; w.x = pk_bf16(o[0], o[1]); w.y = pk_bf16(o[2], o[3]); *(u32x2*)(op + 32 * dt + 8 * q4 + 4 * hh) = w; }
    }
    __syncthreads();
}


__device__ __forceinline__ void ssd_m1g_item(const Frame& F, int li, int item) {
    PH_ARGS();
    const int g = item & 1, bc = item >> 1, b = bc / NCH, c = bc % NCH, r0 = b * TB + c * 128;
    const int seg_lo = c < 2 ? b * TB : b * TB + NCTX, seg_hi = c < 2 ? b * TB + NCTX : (b + 1) * TB;
    LAS float* s_dt = (LAS float*)F.lds;
    LAS float* s_ac = s_dt + 6 * 128;
    LAS float* s_sc = s_ac + 6 * 128;
    LAS bf16_t* xT = (LAS bf16_t*)(s_sc + 6 * 128);
    LAS bf16_t* bT = xT + 192 * LDT;
    __syncthreads();
    const int sg = F.tid & 7, oc = F.tid >> 3;
    const int ucol = oc < 24 ? g * 192 + 8 * oc : (oc < 40 ? 384 + g * 128 + 8 * (oc - 24) : 640 + g * 128 + 8 * (oc - 40));
    u32x4 raw[20];
    if (F.tid < 448) {
        const bf16_t* Pp = WSP(bf16_t, WS_P) + PC_XBC + ucol;
#pragma unroll
        for (int i = 0; i < 20; ++i) { const int r = r0 + 16 * sg - 2 + i; raw[i] = (r >= seg_lo && r < seg_hi) ? *(const u32x4*)(Pp + (size_t)r * LDP) : (u32x4){0u, 0u, 0u, 0u}; }
    }
    for (int i = F.tid; i < 128 * 6; i += 512) {
        const int l = i / 6, k = i % 6, hd = (k / 3) * 6 + g * 3 + (k % 3);
        const float rawdt = WSP(float, WS_DT)[(size_t)(r0 + l) * 16 + hd] + A_->in[I_DTBIAS][li * 12 + hd];
        const float dtv = rawdt > 20.f ? rawdt : log1pf(expf(rawdt));
        s_dt[k * 128 + l] = dtv; s_ac[k * 128 + l] = -dtv * expf(A_->in[I_ALOG][li * 12 + hd]);
        WSP(float, WS_DTV)[(size_t)(r0 + l) * 12 + hd] = dtv;
    }
    __syncthreads();
    if (F.wave < 6) {
        const int k = F.wave, hd = (k / 3) * 6 + g * 3 + (k % 3); const bool bw = k >= 3;
        const int l0 = bw ? 127 - 2 * F.lane : 2 * F.lane, l1 = bw ? 126 - 2 * F.lane : 2 * F.lane + 1;
        const float v0 = s_ac[k * 128 + l0], v1 = s_ac[k * 128 + l1];
        float inc = v0 + v1;
#pragma unroll
        for (int o = 1; o < 64; o <<= 1) { const float up = __shfl_up(inc, o); if (F.lane >= o) inc += up; }
        const float exc = inc - (v0 + v1), tot = __shfl(inc, 63);
        const float a0 = exc + v0, a1 = exc + v0 + v1;
        s_sc[k * 128 + l0] = s_dt[k * 128 + l0] * expf(tot - a0); s_sc[k * 128 + l1] = s_dt[k * 128 + l1] * expf(tot - a1);
        WSP(float, WS_ACUM)[(size_t)(r0 + l0) * 12 + hd] = a0; WSP(float, WS_ACUM)[(size_t)(r0 + l1) * 12 + hd] = a1;
        if (F.lane == 0) WSP(float, WS_CHT)[(size_t)bc * 12 + hd] = tot;
    }
    if (F.tid < 448) {
        float w[5][8], cb[8];
#pragma unroll
        for (int k = 0; k < 5; ++k) { const f32x4 a = *(const f32x4*)(A_->in[I_CONVW] + (size_t)(li * 5 + k) * CONV_DIM + ucol), bq = *(const f32x4*)(A_->in[I_CONVW] + (size_t)(li * 5 + k) * CONV_DIM + ucol + 4);
            w[k][0] = a[0]; w[k][1] = a[1]; w[k][2] = a[2]; w[k][3] = a[3]; w[k][4] = bq[0]; w[k][5] = bq[1]; w[k][6] = bq[2]; w[k][7] = bq[3]; }
        { const f32x4 a = *(const f32x4*)(A_->in[I_CONVB] + li * CONV_DIM + ucol), bq = *(const f32x4*)(A_->in[I_CONVB] + li * CONV_DIM + ucol + 4);
          cb[0] = a[0]; cb[1] = a[1]; cb[2] = a[2]; cb[3] = a[3]; cb[4] = bq[0]; cb[5] = bq[1]; cb[6] = bq[2]; cb[7] = bq[3]; }
        u32x4 pk[16];
#pragma unroll
        for (int rr = 0; rr < 16; ++rr) {
            float y[8];
#pragma unroll
            for (int e = 0; e < 8; ++e) y[e] = cb[e];
#pragma unroll
            for (int k = 0; k < 5; ++k) { const u32x4 q = raw[rr + k];
                y[0] += w[k][0] * __uint_as_float(q.x << 16); y[1] += w[k][1] * __uint_as_float(q.x & 0xffff0000u); y[2] += w[k][2] * __uint_as_float(q.y << 16); y[3] += w[k][3] * __uint_as_float(q.y & 0xffff0000u);
                y[4] += w[k][4] * __uint_as_float(q.z << 16); y[5] += w[k][5] * __uint_as_float(q.z & 0xffff0000u); y[6] += w[k][6] * __uint_as_float(q.w << 16); y[7] += w[k][7] * __uint_as_float(q.w & 0xffff0000u); }
#pragma unroll
            for (int e = 0; e < 8; ++e) y[e] = silu_f(y[e]);
            pk[rr].x = pk_bf16(y[0], y[1]); pk[rr].y = pk_bf16(y[2], y[3]); pk[rr].z = pk_bf16(y[4], y[5]); pk[rr].w = pk_bf16(y[6], y[7]);
            *(u32x4*)(WSP(bf16_t, WS_U) + (size_t)(r0 + 16 * sg + rr) * CONV_DIM + ucol) = pk[rr];
        }
        if (oc < 40) {
            LAS bf16_t* tb = oc < 24 ? xT + (8 * oc) * LDT + 16 * sg : bT + (8 * (oc - 24)) * LDT + 16 * sg;
#pragma unroll
            for (int q = 0; q < 4; ++q) {
                u32x4 lo0, lo1, hi0, hi1;
#define PKQ(rr_) (q == 0 ? pk[rr_].x : (q == 1 ? pk[rr_].y : (q == 2 ? pk[rr_].z : pk[rr_].w)))
#define LO2(a_, b_) ((PKQ(a_) & 0xffffu) | (PKQ(b_) << 16))
#define HI2(a_, b_) ((PKQ(a_) >> 16) | (PKQ(b_) & 0xffff0000u))
                lo0.x = LO2(0, 1); lo0.y = LO2(2, 3); lo0.z = LO2(4, 5); lo0.w = LO2(6, 7); lo1.x = LO2(8, 9); lo1.y = LO2(10, 11); lo1.z = LO2(12, 13); lo1.w = LO2(14, 15);
                hi0.x = HI2(0, 1); hi0.y = HI2(2, 3); hi0.z = HI2(4, 5); hi0.w = HI2(6, 7); hi1.x = HI2(8, 9); hi1.y = HI2(10, 11); hi1.z = HI2(12, 13); hi1.w = HI2(14, 15);
#undef PKQ
#undef LO2
#undef HI2
                *(LAS u32x4*)(tb + (2 * q) * LDT) = lo0; *(LAS u32x4*)(tb + (2 * q) * LDT + 8) = lo1;
                *(LAS u32x4*)(tb + (2 * q + 1) * LDT) = hi0; *(LAS u32x4*)(tb + (2 * q + 1) * LDT + 8) = hi1;
            }
        }
    }
    __syncthreads();
    for (int i = F.tid; i < 192 * 16; i += 512) { const int ch = i >> 4, cc = i & 15;
        *(u32x4*)(WSP(bf16_t, WS_XT) + ((size_t)bc * D_INNER + g * 192 + ch) * 128 + cc * 8) = *(const LAS u32x4*)(xT + ch * LDT + cc * 8); }
    for (int q = F.wave; q < 24; q += 8) {
        const int k = q >> 2, ptile = q & 3, hl = k % 3, hd = (k / 3) * 6 + g * 3 + hl;
        bf16x8 af[4];
#pragma unroll
        for (int kt = 0; kt < 4; ++kt) {
            const bf16x8 xr = lds_frag(xT, LDT, hl * 64 + ptile * 16, kt * 32, F.lane);
            const LAS float* sp = s_sc + k * 128 + kt * 32 + 8 * (F.lane >> 4);
            const f32x4 s0 = *(const LAS f32x4*)sp, s1 = *(const LAS f32x4*)(sp + 4);
            u32x4 wv;
            wv.x = pk_bf16(bf2f((bf16_t)xr[0]) * s0[0], bf2f((bf16_t)xr[1]) * s0[1]); wv.y = pk_bf16(bf2f((bf16_t)xr[2]) * s0[2], bf2f((bf16_t)xr[3]) * s0[3]);
            wv.z = pk_bf16(bf2f((bf16_t)xr[4]) * s1[0], bf2f((bf16_t)xr[5]) * s1[1]); wv.w = pk_bf16(bf2f((bf16_t)xr[6]) * s1[2], bf2f((bf16_t)xr[7]) * s1[3]);
            af[kt] = __builtin_bit_cast(bf16x8, wv);
        }
        bf16_t* outp = WSP(bf16_t, WS_CHS) + ((size_t)bc * 12 + hd) * 8192 + (size_t)(ptile * 16 + (F.lane & 15)) * 128 + 4 * (F.lane >> 4);
#pragma unroll 2
        for (int nt = 0; nt < 8; ++nt) {
            f32x4 acc = {0.f, 0.f, 0.f, 0.f};
#pragma unroll
            for (int kt = 0; kt < 4; ++kt) acc = MFMA16(lds_frag(bT, LDT, nt * 16, kt * 32, F.lane), af[kt], acc);
            { u32x2 pw; pw.x = (unsigned)f2bf(acc[0]) | ((unsigned)f2bf(acc[1]) << 16); pw.y = (unsigned)f2bf(acc[2]) | ((unsigned)f2bf(acc[3]) << 16); *(u32x2*)(outp + nt * 16) = pw; }
        }
    }
}

__device__ __forceinline__ void phase_ssd_scan2(const Frame& F) {
    PH_ARGS();
    const bf16_t* chs = WSP(bf16_t, WS_CHS); const float* cht = WSP(float, WS_CHT); bf16_t* h0b = WSP(bf16_t, WS_H0B);
    for (int idx = F.bid * 512 + F.tid; idx < NB * 12 * 2048; idx += F.G * 512) {
        const int e4 = idx & 2047, bh = idx >> 11, hd = bh % 12, b = bh / 12;
        f32x4 st[NCH]; float dec[NCH];
#pragma unroll
        for (int s = 0; s < NCH; ++s) { const int c = hd < 6 ? s : (s < 2 ? 1 - s : NCH + 1 - s);
            { const u32x2 q = *(const u32x2*)(chs + ((size_t)(b * NCH + c) * 12 + hd) * 8192 + e4 * 4); st[s] = (f32x4){__uint_as_float(q.x << 16), __uint_as_float(q.x & 0xffff0000u), __uint_as_float(q.y << 16), __uint_as_float(q.y & 0xffff0000u)}; }
            dec[s] = cht[(size_t)(b * NCH + c) * 12 + hd]; }
        f32x4 h = {0.f, 0.f, 0.f, 0.f};
#pragma unroll
        for (int s = 0; s < NCH; ++s) { const int c = hd < 6 ? s : (s < 2 ? 1 - s : NCH + 1 - s);
            u32x2 w; w.x = pk_bf16(h[0], h[1]); w.y = pk_bf16(h[2], h[3]);
            *(u32x2*)(h0b + ((size_t)(b * NCH + c) * 12 + hd) * 8192 + e4 * 4) = w; h = h * expf(dec[s]) + st[s]; }
    }
}

__device__ __forceinline__ void ssd_m3w_item(const Frame& F, int li, int item) {
    PH_ARGS();
    const int b = item / NCH, c = item % NCH, r0 = b * TB + c * 128;
    LAS float* s_dt = (LAS float*)F.lds;
    LAS float* s_ac = s_dt + 12 * 128;
    LAS bf16_t* bN = (LAS bf16_t*)(s_ac + 12 * 128);
    LAS bf16_t* xTl = bN + 128 * LDT;
    LAS bf16_t* h0l = xTl + 64 * LDT;
    LAS bf16_t* gd = h0l + 2 * 64 * LDT;
    const int w = F.wave, r = F.lane & 15, gq = F.lane >> 4;
    LAS bf16_t* gdw = gd + w * 16 * LDT;
    const bf16_t* U = WSP(bf16_t, WS_U);
    const bf16_t* XT = WSP(bf16_t, WS_XT) + (size_t)item * D_INNER * 128;
    const bf16_t* H0 = WSP(bf16_t, WS_H0B) + (size_t)item * 12 * 8192;
    float* YG = WSP(float, WS_YG);
    const int prow = F.tid >> 4, ppc = F.tid & 15;
    u32x4 px[2], ph[2][2];
#define M3_LOADHEAD(h_) do { _Pragma("unroll") for (int i_ = 0; i_ < 2; ++i_) { px[i_] = *(const u32x4*)(XT + (size_t)((h_) * 64 + prow + 32 * i_) * 128 + ppc * 8); \
        ph[0][i_] = *(const u32x4*)(H0 + (size_t)(h_) * 8192 + (size_t)(prow + 32 * i_) * 128 + ppc * 8); ph[1][i_] = *(const u32x4*)(H0 + (size_t)(6 + (h_)) * 8192 + (size_t)(prow + 32 * i_) * 128 + ppc * 8); } } while (0)
#define M3_STOREHEAD() do { _Pragma("unroll") for (int i_ = 0; i_ < 2; ++i_) { *(LAS u32x4*)(xTl + (prow + 32 * i_) * LDT + ppc * 8) = px[i_]; \
        *(LAS u32x4*)(h0l + (prow + 32 * i_) * LDT + ppc * 8) = ph[0][i_]; *(LAS u32x4*)(h0l + (64 + prow + 32 * i_) * LDT + ppc * 8) = ph[1][i_]; } } while (0)
    unsigned long long qa_ = 0; if ((SPINMASK >> 14) & 1) qa_ = wall_clock64();
    float ssq = 0.f;
    M3_LOADHEAD(0);
    __syncthreads();
    for (int i = F.tid; i < 128 * 12; i += 512) { const int l = i / 12, hd = i % 12; s_dt[hd * 128 + l] = WSP(float, WS_DTV)[(size_t)(r0 + l) * 12 + hd]; s_ac[hd * 128 + l] = WSP(float, WS_ACUM)[(size_t)(r0 + l) * 12 + hd]; }
    for (int g = 0; g < 2; ++g) {
        bf16x8 cf[4];
#pragma unroll
        for (int kt = 0; kt < 4; ++kt) cf[kt] = *(const bf16x8*)(U + (size_t)(r0 + 16 * w + r) * CONV_DIM + 640 + g * 128 + kt * 32 + 8 * gq);
        { u32x4 pb[4];
#pragma unroll
          for (int i = 0; i < 4; ++i) { const int id = F.tid + 512 * i; pb[i] = *(const u32x4*)(U + (size_t)(r0 + (id >> 4)) * CONV_DIM + 384 + g * 128 + (id & 15) * 8); }
          if (g) __syncthreads();
#pragma unroll
          for (int i = 0; i < 4; ++i) { const int id = F.tid + 512 * i; *(LAS u32x4*)(bN + (id >> 4) * LDT + (id & 15) * 8) = pb[i]; } }
        for (int hl = 0; hl < 3; ++hl) {
            const int h = g * 3 + hl;
            M3_STOREHEAD();
            __syncthreads();
            if (h < 5) M3_LOADHEAD(h + 1);
            const int erow = r0 + 16 * w + (F.lane >> 2), ecol = 16 * (F.lane & 3);
            const u32x4 zq0 = *(const u32x4*)(WSP(bf16_t, WS_P) + (size_t)erow * LDP + PC_Z + h * 64 + ecol), zq1 = *(const u32x4*)(WSP(bf16_t, WS_P) + (size_t)erow * LDP + PC_Z + h * 64 + ecol + 8);
            const u32x4 xq0 = *(const u32x4*)(U + (size_t)erow * CONV_DIM + h * 64 + ecol), xq1 = *(const u32x4*)(U + (size_t)erow * CONV_DIM + h * 64 + ecol + 8);
            f32x4 G[8];
#pragma unroll
            for (int st = 0; st < 8; ++st) { f32x4 acc = {0.f, 0.f, 0.f, 0.f};
#pragma unroll
                for (int kt = 0; kt < 4; ++kt) acc = MFMA16(lds_frag(bN, LDT, st * 16, kt * 32, F.lane), cf[kt], acc);
                G[st] = acc; }
            bf16x8 gf[2][4]; float eal[2][4];
#pragma unroll
            for (int dir = 0; dir < 2; ++dir) {
                const int hd = dir * 6 + h;
#pragma unroll
                for (int j = 0; j < 4; ++j) eal[dir][j] = __expf(s_ac[hd * 128 + 16 * w + 4 * gq + j]);
                const int l = 16 * w + r; const float acl = s_ac[hd * 128 + l];
#pragma unroll
                for (int st = 0; st < 8; ++st) { const int s0 = 16 * st + 4 * gq;
                    const f32x4 acs = *(const LAS f32x4*)(s_ac + hd * 128 + s0), dts = *(const LAS f32x4*)(s_dt + hd * 128 + s0);
                    float v[4];
#pragma unroll
                    for (int j = 0; j < 4; ++j) { const bool ok = dir == 0 ? (s0 + j <= l) : (s0 + j >= l); v[j] = ok ? G[st][j] * __expf(acl - acs[j]) * dts[j] : 0.f; }
                    u32x2 pw; pw.x = pk_bf16(v[0], v[1]); pw.y = pk_bf16(v[2], v[3]);
                    *(LAS u32x2*)(gdw + r * LDT + s0) = pw; }
                asm volatile("s_waitcnt lgkmcnt(0)" ::: "memory");
#pragma unroll
                for (int kt = 0; kt < 4; ++kt) gf[dir][kt] = lds_frag(gdw, LDT, 0, kt * 32, F.lane);
                asm volatile("s_waitcnt lgkmcnt(0)" ::: "memory");
            }
            const float dsk = A_->in[I_DSKIP][li * 6 + h];
#pragma unroll
            for (int pt = 0; pt < 4; ++pt) {
                f32x4 yv = {0.f, 0.f, 0.f, 0.f}, t0 = {0.f, 0.f, 0.f, 0.f}, t1 = {0.f, 0.f, 0.f, 0.f};
#pragma unroll
                for (int kt = 0; kt < 4; ++kt) { const bf16x8 xf = lds_frag(xTl, LDT, pt * 16, kt * 32, F.lane);
                    yv = MFMA16(gf[0][kt], xf, yv); yv = MFMA16(gf[1][kt], xf, yv);
                    t0 = MFMA16(cf[kt], lds_frag(h0l, LDT, pt * 16, kt * 32, F.lane), t0); t1 = MFMA16(cf[kt], lds_frag(h0l + 64 * LDT, LDT, pt * 16, kt * 32, F.lane), t1); }
#pragma unroll
                for (int j = 0; j < 4; ++j) ((LAS float*)gdw)[(4 * gq + j) * 68 + pt * 16 + r] = yv[j] + eal[0][j] * t0[j] + eal[1][j] * t1[j];
            }
            asm volatile("s_waitcnt lgkmcnt(0)" ::: "memory");
            {
                const LAS float* yr = (const LAS float*)gdw + (F.lane >> 2) * 68 + ecol;
                const unsigned zz[8] = {zq0.x, zq0.y, zq0.z, zq0.w, zq1.x, zq1.y, zq1.z, zq1.w}, xx[8] = {xq0.x, xq0.y, xq0.z, xq0.w, xq1.x, xq1.y, xq1.z, xq1.w};
                float o[16];
#pragma unroll
                for (int q4 = 0; q4 < 4; ++q4) { const f32x4 yq = *(const LAS f32x4*)(yr + 4 * q4); const f32x4 nw = *(const f32x4*)(A_->in[I_SSMNW] + li * D_INNER + h * 64 + ecol + 4 * q4);
#pragma unroll
                    for (int e = 0; e < 4; ++e) { const int c = 4 * q4 + e; const unsigned zw = zz[c >> 1], xw = xx[c >> 1];
                        const float zv = (c & 1) ? __uint_as_float(zw & 0xffff0000u) : __uint_as_float(zw << 16), xv = (c & 1) ? __uint_as_float(xw & 0xffff0000u) : __uint_as_float(xw << 16);
                        const float gv = (yq[e] + dsk * xv) * silu_f(zv); ssq += gv * gv; o[c] = gv * nw[e]; } }
                u32x4 w0, w1; w0.x = pk_bf16(o[0], o[1]); w0.y = pk_bf16(o[2], o[3]); w0.z = pk_bf16(o[4], o[5]); w0.w = pk_bf16(o[6], o[7]); w1.x = pk_bf16(o[8], o[9]); w1.y = pk_bf16(o[10], o[11]); w1.z = pk_bf16(o[12], o[13]); w1.w = pk_bf16(o[14], o[15]);
                bf16_t* mp = WSP(bf16_t, WS_MIX) + (size_t)erow * D + 384 + h * 64 + ecol;
                *(u32x4*)mp = w0; *(u32x4*)(mp + 8) = w1;
            }
            __syncthreads();
        }
    }
#undef M3_LOADHEAD
#undef M3_STOREHEAD
    if ((SPINMASK >> 14) & 1) { const unsigned long long q1_ = wall_clock64(), qd_ = q1_ - qa_; while (wall_clock64() - q1_ < qd_) __builtin_amdgcn_s_sleep(8); }
    unsigned long long qb_ = 0; if ((SPINMASK >> 15) & 1) qb_ = wall_clock64();
    asm volatile("s_waitcnt vmcnt(0)" ::: "memory");
    { ssq += __shfl_xor(ssq, 1); ssq += __shfl_xor(ssq, 2);
      const float rstd = rsqrtf(ssq * (1.0f / 384.0f) + LN_EPS);
      bf16_t* mp = WSP(bf16_t, WS_MIX) + (size_t)(r0 + 16 * w + (F.lane >> 2)) * D + 384 + 16 * (F.lane & 3);
      u32x4 q[12];
#pragma unroll
      for (int hh = 0; hh < 6; ++hh) { q[2 * hh] = *(const u32x4*)(mp + hh * 64); q[2 * hh + 1] = *(const u32x4*)(mp + hh * 64 + 8); }
#pragma unroll
      for (int i = 0; i < 12; ++i) { u32x4 v = q[i]; unsigned* vp = (unsigned*)&v;
#pragma unroll
          for (int e = 0; e < 4; ++e) vp[e] = pk_bf16(__uint_as_float(vp[e] << 16) * rstd, __uint_as_float(vp[e] & 0xffff0000u) * rstd);
          *(u32x4*)(mp + (i >> 1) * 64 + (i & 1) * 8) = v; } }
    if ((SPINMASK >> 15) & 1) { asm volatile("s_waitcnt vmcnt(0)" ::: "memory"); const unsigned long long q1_ = wall_clock64(), qd_ = q1_ - qb_; while (wall_clock64() - q1_ < qd_) __builtin_amdgcn_s_sleep(8); }
}

#ifndef ONE_LAUNCH
#define ONE_LAUNCH 1
#endif
constexpr int PH_PER_LAYER = 9, PH_TOTAL = 2 + DEPTH * PH_PER_LAYER;
constexpr int ZCOL_TILE = 3;
constexpr int NC3 = 89;

__global__ void __launch_bounds__(512, 2) hybrid_fwd(Args args) {
    extern __shared__ __attribute__((aligned(16))) unsigned char lds_raw[];
    volatile LAS unsigned* bst = (volatile LAS unsigned*)((LAS unsigned char*)lds_raw + LDS_BYTES - 16);
    if (threadIdx.x < 4) bst[threadIdx.x] = 0u;
    __syncthreads();
    XcdBarrier bar; bar.bar = (unsigned*)(args.ws + WS_CTL); bar.x = 0; bar.st = bst;
    if (args.use_bar) bar = xcd_barrier_post((unsigned*)(args.ws + WS_CTL), bst);
    const int lo = args.ph_lo, hi = args.ph_hi;
#ifndef PMASK
#define PMASK 0xFFFF
#endif
#define PM(b) ((PMASK >> (b)) & 1)
#ifndef DBLMASK
#define DBLMASK 0
#endif
#define REPS(b) (((DBLMASK >> (b)) & 1) ? 2 : 1)
#define IN(k) (lo <= (k) && (k) < hi)
#ifndef SPINMASK
#define SPINMASK 0
#endif
#ifndef DBLBAR
#define DBLBAR 0
#endif
#define PT0(b) unsigned long long pt0_ = 0; if ((SPINMASK >> (b)) & 1) pt0_ = wall_clock64()
#define PT1(b) do { if ((SPINMASK >> (b)) & 1) { const unsigned long long pt1_ = wall_clock64(), ptd_ = pt1_ - pt0_; while (wall_clock64() - pt1_ < ptd_) __builtin_amdgcn_s_sleep(8); } } while (0)
#define SEAM(k) do { if (args.use_bar && (k) + 1 < hi) { xcd_barrier(bar); if (DBLBAR) xcd_barrier(bar); } else __syncthreads(); } while (0)
    LAS unsigned char* glds = (LAS unsigned char*)lds_raw;
    volatile LAS int* qslot = (volatile LAS int*)((LAS unsigned char*)lds_raw + LDS_BYTES - 32);
#define MKFRAME() Frame F; { int t_ = threadIdx.x; asm volatile("" : "+v"(t_)); F.lds = (LAS unsigned char*)lds_raw; F.tid = t_; F.lane = t_ & 63; F.wave = __builtin_amdgcn_readfirstlane(t_ >> 6); \
        F.G = gridDim.x; F.bid = blockIdx.x; F.ka = (KArgs)__builtin_amdgcn_kernarg_segment_ptr(); }

    if (PM(0) && IN(0)) { PT0(0); MKFRAME(); for (int rep_ = 0; rep_ < REPS(0); ++rep_) { if (rep_) __syncthreads(); phase_pre_a(F); } PT1(0); SEAM(0); }
    if (PM(1) && IN(1)) { PT0(1); MKFRAME(); phase_pre_b(F); PT1(1); SEAM(1); }

    for (int li = 0; li < DEPTH; ++li) {
        const int pb = 2 + li * PH_PER_LAYER; const bool moe = li & 1; const int jm = li >> 1; const bool last = li == DEPTH - 1;
        if (PM(2) && IN(pb + 0)) { PT0(2);
            MKFRAME(); PH_ARGS();
            pg8::Gemm g{WSP(bf16_t, WS_H), WSP(bf16_t, WS_WIN) + (size_t)li * LDP * D, T, LDP, D / 2};     pg8::StaticOrder S; S.init(T, LDP - 256, F.G, F.bid, 0, ZCOL_TILE);
            const float* rp = WSP(float, WS_ROPE);
            pg8::EpiInProj E{WSP(bf16_t, WS_P), WSP(float, WS_DT), rp, rp + 2048 * 32, rp + 2 * 2048 * 32, rp + 2 * 2048 * 32 + 2048 * 16, WSP(bf16_t, WS_VTA), WSP(bf16_t, WS_VTC), WSP(float, WS_RSC), WSP(float, WS_WSC) + (size_t)18 * 2 * DFF + (size_t)li * LDP};
            for (int rep_ = 0; rep_ < REPS(2); ++rep_) pg8::gemm_phase<pg8::EpiInProj, pg8::StaticOrder, 2>(glds, g, S, E, nullptr);
            PT1(2); SEAM(pb + 0);
        }
        const int nC = last ? NB * 4 * 8 : NB * 4 * 9;
        if (PM(3) && IN(pb + 1)) { PT0(3);
            unsigned* qh = (unsigned*)(args.ws + WS_CTL + CTL_Q_OFF) + (li * 2 + 0) * 64;
            const int e0 = NC3, e1 = e0 + T / 256, e2 = e1 + 2 * NB * NCH, e3 = e2 + NB * 6 * NCH / 2;
            for (;;) {
                __syncthreads(); if (threadIdx.x == 0) *qslot = (int)atomicAdd(qh, 1u); __syncthreads();
                const int it = *qslot;
                if (it >= e3) break;
                MKFRAME(); PH_ARGS();
                if (it < e0) attn_c2_unit(F, li, it);
                else if (it < e1) {
                    pg8::Gemm g{WSP(bf16_t, WS_H), WSP(bf16_t, WS_WIN) + (size_t)li * LDP * D, T, LDP, D / 2};     pg8::OneUnit S{it - e0, ZCOL_TILE};
                    const float* rp = WSP(float, WS_ROPE);
                    pg8::EpiInProj E{WSP(bf16_t, WS_P), WSP(float, WS_DT), rp, rp + 2048 * 32, rp + 2 * 2048 * 32, rp + 2 * 2048 * 32 + 2048 * 16, WSP(bf16_t, WS_VTA), WSP(bf16_t, WS_VTC), WSP(float, WS_RSC), WSP(float, WS_WSC) + (size_t)18 * 2 * DFF + (size_t)li * LDP};
                    pg8::gemm_phase<pg8::EpiInProj, pg8::OneUnit, 2>(glds, g, S, E, nullptr);
                }
                else if (it < e2) ssd_m1g_item(F, li, it - e1);
                else { const int ia = 2 * (it - e2);
                    if (!(last && (ia % NCH) < 2)) attn_a2_unit(F, li, ia);
                    if (!(last && ((ia + 1) % NCH) < 2)) attn_a2_unit(F, li, ia + 1); }
            }
            PT1(3); SEAM(pb + 1);
        }
        if (PM(4) && IN(pb + 2)) { PT0(4);
            MKFRAME();
            phase_ssd_scan2(F);
            PT1(4); SEAM(pb + 2);
        }
        if (PM(5) && IN(pb + 3)) { PT0(5);
            unsigned* qh = (unsigned*)(args.ws + WS_CTL + CTL_Q_OFF) + (li * 2 + 1) * 64;
            const int e0 = nC - NC3, e1 = e0 + NB * NCH;
            for (;;) {
                __syncthreads(); if (threadIdx.x == 0) *qslot = (int)atomicAdd(qh, 1u); __syncthreads();
                const int it = *qslot;
                if (it >= e1) break;
                MKFRAME(); PH_ARGS();
                if (it < e0) attn_c2_unit(F, li, NC3 + it);
                else { const int im = it - e0; if (!(last && (im % NCH) < 2)) ssd_m3w_item(F, li, im); }
            }
            PT1(5); SEAM(pb + 3);
        }
        if (PM(6) && IN(pb + 4)) { PT0(6);
            MKFRAME(); PH_ARGS();
            pg8::Gemm g{WSP(bf16_t, WS_MIX), WSP(bf16_t, WS_WOUT) + (size_t)li * D * D, T, D, D}; pg8::StaticOrder S; S.init(last ? NB * SEQ : T, D, F.G, F.bid, last ? 1 : 0);
            pg8::EpiBf16 E{WSP(bf16_t, WS_O), D, 1.0f};
            for (int rep_ = 0; rep_ < REPS(6); ++rep_) pg8::gemm_phase<pg8::EpiBf16, pg8::StaticOrder>(glds, g, S, E, nullptr);
            PT1(6); SEAM(pb + 4);
        }
        if (PM(7) && IN(pb + 5)) { PT0(7); MKFRAME(); phase_post_mixer(F, li); PT1(7); SEAM(pb + 5); }
        if (PM(8) && IN(pb + 6)) { PT0(8); unsigned long long pg_ = 0; if ((SPINMASK >> (moe ? 16 : 17)) & 1) pg_ = wall_clock64();
            MKFRAME(); PH_ARGS();
            if (!moe) {
                pg8::EpiSwiGLUI8 E{WSP(unsigned char, WS_ACT), WSP(float, WS_RSC), WSP(float, WS_WSC) + (size_t)jm * 2 * DFF};
                pg8::Gemm g{WSP(bf16_t, WS_H), WSP(bf16_t, WS_WGU) + (size_t)jm * 2 * DFF * D, T, 2 * DFF, D / 2}; pg8::StaticOrder S; S.init(T, 2 * DFF, F.G, F.bid);
                for (int rep_ = 0; rep_ < REPS(8); ++rep_) pg8::gemm_phase<pg8::EpiSwiGLUI8, pg8::StaticOrder, 2>(glds, g, S, E, nullptr);
            } else {
                pg8::EpiSwiGLUI8 E{WSP(unsigned char, WS_ACT), WSP(float, WS_HPS), WSP(float, WS_WSC) + (size_t)(2 + jm * 8) * 2 * DFF};
                const unsigned* cnt = (const unsigned*)(ws_ + WS_CTL + CTL_CNT_OFF) + jm * 8 * 64;
                pg8::GroupedOrder<0> S; int acc = 0;
                acc += ((int)cnt[0 * 64] + 255) >> 8; S.t1 = acc; acc += ((int)cnt[1 * 64] + 255) >> 8; S.t2 = acc; acc += ((int)cnt[2 * 64] + 255) >> 8; S.t3 = acc; acc += ((int)cnt[3 * 64] + 255) >> 8; S.t4 = acc;
                acc += ((int)cnt[4 * 64] + 255) >> 8; S.t5 = acc; acc += ((int)cnt[5 * 64] + 255) >> 8; S.t6 = acc; acc += ((int)cnt[6 * 64] + 255) >> 8; S.t7 = acc; acc += ((int)cnt[7 * 64] + 255) >> 8; S.t8 = acc;
                S.nN = 2 * DFF / 256; S.capTiles = MOE_CAP / 256; S.G = F.G; S.c = F.bid;
                pg8::Gemm g{WSP(bf16_t, WS_HP), WSP(bf16_t, WS_WGUE) + (size_t)jm * 8 * 2 * DFF * D, NEXP * MOE_CAP, NEXP * 2 * DFF, D / 2};
                for (int rep_ = 0; rep_ < REPS(8); ++rep_) pg8::gemm_phase<pg8::EpiSwiGLUI8, pg8::GroupedOrder<0>, 2>(glds, g, S, E, nullptr);
            }
            if ((SPINMASK >> (moe ? 16 : 17)) & 1) { const unsigned long long q1_ = wall_clock64(), qd_ = q1_ - pg_; while (wall_clock64() - q1_ < qd_) __builtin_amdgcn_s_sleep(8); }
            PT1(8); SEAM(pb + 6);
        }
        if (PM(9) && IN(pb + 7)) { PT0(9); unsigned long long pd_ = 0; if ((SPINMASK >> (moe ? 18 : 19)) & 1) pd_ = wall_clock64();
            MKFRAME(); PH_ARGS();
            if (!moe) {
                pg8::Gemm g{WSP(bf16_t, WS_ACT), WSP(bf16_t, WS_WD) + (size_t)jm * D * DFF, T, D, DFF / 2}; pg8::StaticOrder S; S.init(T, D, F.G, F.bid);
                pg8::EpiBf16 E{WSP(bf16_t, WS_O), D, 0.015625f};
                for (int rep_ = 0; rep_ < REPS(9); ++rep_) pg8::gemm_phase<pg8::EpiBf16, pg8::StaticOrder, true>(glds, g, S, E, nullptr);
            } else {
                const unsigned* cnt = (const unsigned*)(ws_ + WS_CTL + CTL_CNT_OFF) + jm * 8 * 64;
                pg8::GroupedOrder<1> S; int acc = 0;
                acc += ((int)cnt[0 * 64] + 255) >> 8; S.t1 = acc; acc += ((int)cnt[1 * 64] + 255) >> 8; S.t2 = acc; acc += ((int)cnt[2 * 64] + 255) >> 8; S.t3 = acc; acc += ((int)cnt[3 * 64] + 255) >> 8; S.t4 = acc;
                acc += ((int)cnt[4 * 64] + 255) >> 8; S.t5 = acc; acc += ((int)cnt[5 * 64] + 255) >> 8; S.t6 = acc; acc += ((int)cnt[6 * 64] + 255) >> 8; S.t7 = acc; acc += ((int)cnt[7 * 64] + 255) >> 8; S.t8 = acc;
                S.nN = D / 256; S.capTiles = MOE_CAP / 256; S.G = F.G; S.c = F.bid;
                pg8::Gemm g{WSP(bf16_t, WS_ACT), WSP(bf16_t, WS_WDE) + (size_t)jm * 8 * D * DFF, MAX_SLOT_ROWS, NEXP * D, DFF / 2};
                pg8::EpiBf16 E{WSP(bf16_t, WS_HP), D, 0.015625f};
                for (int rep_ = 0; rep_ < REPS(9); ++rep_) pg8::gemm_phase<pg8::EpiBf16, pg8::GroupedOrder<1>, true>(glds, g, S, E, nullptr);
            }
            if ((SPINMASK >> (moe ? 18 : 19)) & 1) { const unsigned long long q1_ = wall_clock64(), qd_ = q1_ - pd_; while (wall_clock64() - q1_ < qd_) __builtin_amdgcn_s_sleep(8); }
            PT1(9); SEAM(pb + 7);
        }
        if (PM(10) && IN(pb + 8)) { PT0(10); MKFRAME(); phase_post_ffn(F, li); PT1(10); SEAM(pb + 8); }
    }
#undef IN
#undef SEAM
}

extern "C" void kernel_launch(void* const* d_in, const int* in_sizes, int n_in, void* d_out, int out_size, void* d_ws, size_t ws_size, hipStream_t stream) {
    static int grid = 0;
    if (grid == 0) {
        if (n_in != 28 || out_size != NB * SEQ * D || ws_size < WS_END) { fprintf(stderr, "kernel_launch: unexpected shapes (n_in %d, out %d, ws %zu, need %zu); nothing launched\n", n_in, out_size, ws_size, (size_t)WS_END); grid = -1; return; }
        int dev = 0, cus = 0, per_cu = 0;
        if (hipGetDevice(&dev) != hipSuccess || hipDeviceGetAttribute(&cus, hipDeviceAttributeMultiprocessorCount, dev) != hipSuccess) { grid = -1; return; }
        if (hipFuncSetAttribute((const void*)hybrid_fwd, hipFuncAttributeMaxDynamicSharedMemorySize, LDS_BYTES) != hipSuccess) { fprintf(stderr, "kernel_launch: hipFuncSetAttribute failed\n"); grid = -1; return; }
        if (hipOccupancyMaxActiveBlocksPerMultiprocessor(&per_cu, (const void*)hybrid_fwd, 512, LDS_BYTES) != hipSuccess || per_cu < 1) { fprintf(stderr, "kernel_launch: occupancy query says %d blocks per CU\n", per_cu); per_cu = 1; }
        (void)hipGetLastError();
        grid = cus;
    }
    if (grid < 0) return;
    (void)hipMemsetAsync((char*)d_ws + WS_CTL, 0, CTL_BYTES, stream);
    Args a{};
    for (int i = 0; i < 28; ++i) a.in[i] = (const float*)d_in[i];
    a.out = (float*)d_out; a.ws = (unsigned char*)d_ws; a.pad = 0;
#if ONE_LAUNCH
    a.ph_lo = 0; a.ph_hi = PH_TOTAL; a.use_bar = 1;
    hipLaunchKernelGGL(hybrid_fwd, dim3(grid), dim3(512), LDS_BYTES, stream, a);
#else
    for (int p = 0; p < PH_TOTAL; ++p) { a.ph_lo = p; a.ph_hi = p + 1; a.use_bar = 0; hipLaunchKernelGGL(hybrid_fwd, dim3(grid), dim3(512), LDS_BYTES, stream, a); }
#endif
}
```
